# Optimizing an MI355X kernel written in HIP

```python
import jax, jax.numpy as jnp
from jax import lax
import numpy as np

D_MODEL = 2048
BATCH = 4
SEQ = 4096
DEPTH = 1

EPS = 1e-6
CONV_A_WIDTH = D_MODEL
CONV_A_K = 3
SSM_EXPAND = 2
SSM_D_INNER = SSM_EXPAND * D_MODEL
SSM_HEAD_DIM = 64
SSM_HEADS = SSM_D_INNER // SSM_HEAD_DIM
SSM_GROUPS = 8
SSM_STATE = 128
SSM_CONV_K = 4
SSM_CONV_DIM = SSM_D_INNER + 2 * SSM_GROUPS * SSM_STATE
SSM_CHUNK = 128
SSM_NORM_GROUP = SSM_D_INNER // SSM_GROUPS
D_FF = -(-(8 * D_MODEL) // (3 * 256)) * 256

OFF_GATE_A = 0
OFF_GATE_B = D_MODEL
OFF_A = 2 * D_MODEL
OFF_Z = OFF_A + 3 * CONV_A_WIDTH
OFF_XBC = OFF_Z + SSM_D_INNER
OFF_DT = OFF_XBC + SSM_CONV_DIM
IN_COLS = OFF_DT + SSM_HEADS

kernel_name = "hybrid_shortconv_ssd_gated_block"


def rms_norm(x, g):
    xf = x.astype(jnp.float32)
    y = xf * lax.rsqrt(jnp.mean(xf * xf, axis=-1, keepdims=True) + EPS)
    return (y * g.astype(jnp.float32)).astype(x.dtype)


def causal_depthwise_conv(u, w):
    k = w.shape[0]
    t = u.shape[1]
    up = jnp.pad(u, ((0, 0), (k - 1, 0), (0, 0)))
    out = up[:, 0:t] * w[0]
    for j in range(1, k):
        out = out + up[:, j:j + t] * w[j]
    return out


def short_gated_conv_mixer(u_a, conv_w, w_out):
    b_gate, c_gate, h = jnp.split(u_a, 3, axis=-1)
    y = b_gate * causal_depthwise_conv(c_gate * h, conv_w)
    return y @ w_out


def ssd_chunked(xs, dt, a, b_ssm, c_ssm):
    bsz, t, h, p = xs.shape
    g, n = b_ssm.shape[2], b_ssm.shape[3]
    r = h // g
    q = SSM_CHUNK
    nc = t // q
    x_c = xs.reshape(bsz, nc, q, g, r, p)
    dt_c = dt.reshape(bsz, nc, q, g, r)
    b_c = b_ssm.reshape(bsz, nc, q, g, n)
    c_c = c_ssm.reshape(bsz, nc, q, g, n)
    xdt = x_c * dt_c[..., None]
    log_a = (dt_c * a.reshape(g, r)).transpose(0, 1, 3, 4, 2)
    cs = jnp.cumsum(log_a, axis=-1)
    causal = jnp.tril(jnp.ones((q, q), dtype=bool))
    seg = jnp.where(causal, cs[..., :, None] - cs[..., None, :], -jnp.inf)
    decay_in = jnp.exp(seg)
    cb = jnp.einsum('bclgn,bcsgn->bcgls', c_c, b_c)
    y_diag = jnp.einsum('bcgrls,bcsgrp->bclgrp', cb[:, :, :, None] * decay_in, xdt)
    decay_to_end = jnp.exp(cs[..., -1:] - cs)
    chunk_states = jnp.einsum('bclgn,bcgrl,bclgrp->bcgrpn', b_c, decay_to_end, xdt)
    chunk_decay = jnp.exp(cs[..., -1])

    def step(state, inp):
        s_new, dec = inp
        return dec[..., None, None] * state + s_new, state

    states_t = jnp.moveaxis(chunk_states, 1, 0)
    decay_t = jnp.moveaxis(chunk_decay, 1, 0)
    _, prev = lax.scan(step, jnp.zeros_like(states_t[0]), (states_t, decay_t))
    prev_states = jnp.moveaxis(prev, 0, 1)
    y_off = jnp.einsum('bclgn,bcgrpn,bcgrl->bclgrp', c_c, prev_states, jnp.exp(cs))
    return (y_diag + y_off).reshape(bsz, t, h, p)


def mamba2_mixer(z, xbc, dt_raw, conv_w, conv_b, dt_bias, a_log, d_skip, norm_g, w_out):
    bsz, t, _ = z.shape
    xbc = jax.nn.silu(causal_depthwise_conv(xbc, conv_w) + conv_b)
    xs = xbc[..., :SSM_D_INNER].reshape(bsz, t, SSM_HEADS, SSM_HEAD_DIM)
    b_ssm = xbc[..., SSM_D_INNER:SSM_D_INNER + SSM_GROUPS * SSM_STATE].reshape(bsz, t, SSM_GROUPS, SSM_STATE)
    c_ssm = xbc[..., SSM_D_INNER + SSM_GROUPS * SSM_STATE:].reshape(bsz, t, SSM_GROUPS, SSM_STATE)
    dt = jax.nn.softplus(dt_raw.astype(jnp.float32) + dt_bias.astype(jnp.float32))
    a = -jnp.exp(a_log.astype(jnp.float32))
    y = ssd_chunked(xs, dt, a, b_ssm, c_ssm)
    y = y + d_skip.astype(jnp.float32)[:, None] * xs
    yz = (y.reshape(bsz, t, SSM_D_INNER) * jax.nn.silu(z.astype(jnp.float32)))
    yz = yz.reshape(bsz, t, SSM_GROUPS, SSM_NORM_GROUP)
    yz = yz * lax.rsqrt(jnp.mean(yz * yz, axis=-1, keepdims=True) + EPS)
    yz = yz.reshape(bsz, t, SSM_D_INNER) * norm_g.astype(jnp.float32)
    return yz.astype(z.dtype) @ w_out


def swiglu(u, w_gate, w_up, w_down):
    return (jax.nn.silu(u @ w_gate) * (u @ w_up)) @ w_down


def setup_inputs(seed: int = 0) -> dict:
    key = jax.random.key(seed)
    ks = jax.random.split(key, 20)
    L, D = DEPTH, D_MODEL
    f32 = jnp.float32

    def nrm(k, shape, fan_in):
        return jax.random.normal(k, shape, f32) * (fan_in ** -0.5)

    def gain(k, shape):
        return 1.0 + 0.02 * jax.random.normal(k, shape, f32)

    dt0 = jnp.exp(jax.random.uniform(ks[7], (L, SSM_HEADS), f32) * (np.log(0.1) - np.log(0.001)) + np.log(0.001))
    dt_bias = dt0 + jnp.log(-jnp.expm1(-dt0))
    a_log = jnp.log(jax.random.uniform(ks[8], (L, SSM_HEADS), f32, 1.0, 16.0))
    return {
        "x": jax.random.normal(ks[0], (BATCH, SEQ, D), f32),
        "norm_mix_g": gain(ks[1], (L, D)),
        "w_in": nrm(ks[2], (L, D, IN_COLS), D),
        "conv_a_w": nrm(ks[3], (L, CONV_A_K, CONV_A_WIDTH), CONV_A_K),
        "w_out_a": nrm(ks[4], (L, CONV_A_WIDTH, D), CONV_A_WIDTH),
        "ssm_conv_w": nrm(ks[5], (L, SSM_CONV_K, SSM_CONV_DIM), SSM_CONV_K),
        "ssm_conv_b": 0.02 * jax.random.normal(ks[6], (L, SSM_CONV_DIM), f32),
        "dt_bias": dt_bias,
        "a_log": a_log,
        "d_skip": gain(ks[9], (L, SSM_HEADS)),
        "ssm_norm_g": gain(ks[10], (L, SSM_D_INNER)),
        "w_out_ssm": nrm(ks[11], (L, SSM_D_INNER, D), SSM_D_INNER),
        "w_o": nrm(ks[12], (L, D, D), D),
        "norm_ffn_g": gain(ks[13], (L, D)),
        "w_ffn_gate": nrm(ks[14], (L, D, D_FF), D),
        "w_ffn_up": nrm(ks[15], (L, D, D_FF), D),
        "w_ffn_down": nrm(ks[16], (L, D_FF, D), D_FF),
        "norm_final_g": gain(ks[17], (D,)),
    }


def reference(x, norm_mix_g, w_in, conv_a_w, w_out_a, ssm_conv_w, ssm_conv_b, dt_bias, a_log,
              d_skip, ssm_norm_g, w_out_ssm, w_o, norm_ffn_g, w_ffn_gate, w_ffn_up, w_ffn_down,
              norm_final_g):
    h = x
    for i in range(DEPTH):
        u = rms_norm(h, norm_mix_g[i])
        proj = u @ w_in[i]
        gate_a = jax.nn.sigmoid(proj[..., OFF_GATE_A:OFF_GATE_B])
        gate_b = jax.nn.sigmoid(proj[..., OFF_GATE_B:OFF_A])
        y_a = short_gated_conv_mixer(proj[..., OFF_A:OFF_Z], conv_a_w[i], w_out_a[i])
        y_b = mamba2_mixer(proj[..., OFF_Z:OFF_XBC], proj[..., OFF_XBC:OFF_DT], proj[..., OFF_DT:IN_COLS],
                           ssm_conv_w[i], ssm_conv_b[i], dt_bias[i], a_log[i], d_skip[i],
                           ssm_norm_g[i], w_out_ssm[i])
        h = h + (gate_a * y_a + gate_b * y_b) @ w_o[i]
        h = h + swiglu(rms_norm(h, norm_ffn_g[i]), w_ffn_gate[i], w_ffn_up[i], w_ffn_down[i])
    return rms_norm(h, norm_final_g)
```

```cpp
#include <hip/hip_runtime.h>
#include <hip/hip_cooperative_groups.h>
#include <cstdio>
namespace cg = cooperative_groups;

#ifndef MEGA
#define MEGA 0
#endif

#define LAS __attribute__((address_space(3)))
typedef unsigned short bf16_t;
typedef short bf16x8 __attribute__((ext_vector_type(8)));
typedef float f32x4 __attribute__((ext_vector_type(4)));
typedef unsigned u32x4 __attribute__((ext_vector_type(4)));
typedef unsigned u32x2 __attribute__((ext_vector_type(2)));

constexpr int DM = 2048, NTOK = 16384, SEQ = 4096;
constexpr int IN_COLS = 20544, IN_TILES = 81;
constexpr int DI = 4096, NH = 64, HD = 64, NG = 8, NST = 128, CONVD = 6144;
constexpr int DFF = 5632;
constexpr float EPS = 1e-6f;

constexpr size_t MiB = 1024ull * 1024ull;
constexpr size_t OFF_WIN = 0;
constexpr size_t OFF_WOA = 81 * MiB;
constexpr size_t OFF_WOS = 89 * MiB;
constexpr size_t OFF_WO  = 105 * MiB;
constexpr size_t OFF_WGU = 113 * MiB;
constexpr size_t OFF_WDN = 157 * MiB;
constexpr size_t OFF_ZS  = 179 * MiB;
constexpr size_t OFF_U   = 307 * MiB;
constexpr size_t OFF_XBC = 371 * MiB;
constexpr size_t OFF_BB  = 371 * MiB, OFF_BC = 435 * MiB, OFF_BH = 499 * MiB;
constexpr size_t OFF_DT  = 563 * MiB;
constexpr size_t OFF_SSQH = 567 * MiB;
constexpr size_t OFF_SSQ1 = 571 * MiB;
constexpr size_t OFF_SSQ2 = 571 * MiB + 65536;
constexpr size_t OFF_BCS = 572 * MiB;
constexpr size_t WS_END = 636 * MiB;

struct Params {
    const float *x, *norm_mix_g, *w_in, *conv_a_w, *w_out_a, *ssm_conv_w, *ssm_conv_b, *dt_bias, *a_log, *d_skip, *ssm_norm_g, *w_out_ssm, *w_o, *norm_ffn_g, *w_ffn_gate, *w_ffn_up,
        *w_ffn_down, *norm_final_g;
    float* out; unsigned char* ws;
};

__device__ __forceinline__ unsigned f2bf(float f) { unsigned u = __builtin_bit_cast(unsigned, f); return (u + 0x7fffu + ((u >> 16) & 1u)) >> 16; }
__device__ __forceinline__ unsigned pk2(float lo, float hi) { return f2bf(lo) | (f2bf(hi) << 16); }
__device__ __forceinline__ float bflo(unsigned w) { return __builtin_bit_cast(float, w << 16); }
__device__ __forceinline__ float bfhi(unsigned w) { return __builtin_bit_cast(float, w & 0xffff0000u); }
__device__ __forceinline__ float bf2f(bf16_t v) { return __builtin_bit_cast(float, ((unsigned)v) << 16); }
__device__ __forceinline__ float sigmoidf_(float v) { return __builtin_amdgcn_rcpf(1.0f + __expf(-v)); }
__device__ __forceinline__ float siluf_(float v) { return v * sigmoidf_(v); }
__device__ __forceinline__ float softplusf_(float v) { return fmaxf(v, 0.f) + log1pf(__expf(-fabsf(v))); }
__device__ __forceinline__ u32x4 pack8(const f32x4& a, const f32x4& b) { u32x4 w; w.x = pk2(a[0], a[1]); w.y = pk2(a[2], a[3]); w.z = pk2(b[0], b[1]); w.w = pk2(b[2], b[3]); return w; }
__device__ __forceinline__ void unpack8(const u32x4& w, f32x4& a, f32x4& b) { a[0] = bflo(w.x); a[1] = bfhi(w.x); a[2] = bflo(w.y); a[3] = bfhi(w.y); b[0] = bflo(w.z); b[1] = bfhi(w.z); b[2] = bflo(w.w); b[3] = bfhi(w.w); }

namespace pg8 {
constexpr int BM = 256, BK = 64, HALF = 128, HTB = HALF * BK * 2, STAGE_BYTES = 8 * HTB, NXCD = 8, WGM = 8;
__host__ __device__ __forceinline__ int lds_byte(int r, int c) { const int st = (r >> 4) * 2 + (c >> 5), rr = r & 15, cc = c & 31, ob = rr * 64 + cc * 2; return st * 1024 + (ob ^ (((ob >> 9) & 1) << 5)); }
__host__ __device__ __forceinline__ void stage_rc(int b, int& R, int& C) { const int st = b / 1024, sb = b % 1024, swz = sb ^ (((sb >> 9) & 1) << 5); R = (st >> 1) * 16 + swz / 64; C = (st & 1) * 32 + (swz % 64) / 2; }
__host__ __device__ __forceinline__ int perm32(int rho) { const int n = rho >> 4, i = rho & 15; return 8 * (i >> 2) + 4 * n + (i & 3); }
struct Unit { int pm, pn; };
struct Gemm { const bf16_t* A; const bf16_t* Bt; int M, N, K; };
struct StaticOrder {
    int nM, nN, nwg, G, c;
    __host__ __device__ void init(int M, int N, int G_, int c_) { nM = M / BM; nN = N / BM; nwg = nM * nN; G = G_; c = c_; }
    __host__ __device__ bool next(int i, Unit& u) const {
        const long L = (long)i * G + c; if (L >= nwg) return false;
        int wgid = (int)L; { const int q = nwg / NXCD, r = nwg % NXCD, xcd = wgid % NXCD, off = wgid / NXCD; wgid = (xcd < r ? xcd * (q + 1) : r * (q + 1) + (xcd - r) * q) + off; }
        const int nig = WGM * nN, gid = wgid / nig, fm = gid * WGM, gsz = (nM - fm) < WGM ? (nM - fm) : WGM;
        u.pm = fm + ((wgid % nig) % gsz); u.pn = (wgid % nig) / gsz; return true;
    }
};

template <class Epi>
__device__ __forceinline__ void gemm_phase(LAS unsigned char* lds, const Gemm g, const StaticOrder& S, const Epi& E) {
    const int tid = threadIdx.x, wid = __builtin_amdgcn_readfirstlane(tid >> 6), lane = tid & 63, wr = wid >> 2, wc = wid & 3, fr = lane & 15, fq = lane >> 4;
    const int K = g.K, nt = K / BK;
    unsigned voffA[2];
#pragma unroll
    for (int i = 0; i < 2; ++i) { int R, C; stage_rc(tid * 16 + i * 8192, R, C); voffA[i] = (unsigned)(R * K + C) * 2u; }
    const size_t kstep = (size_t)(BK * 2);
    const size_t hstep = (size_t)HALF * K * 2;
    const size_t tstep = 2 * hstep;
    const unsigned ldsw = (unsigned)wid * 1024u;
    const int aoff = lds_byte(wr * 64 + fr, fq * 8), boff = lds_byte(wc * 32 + fr, fq * 8);
#define PG8_SA(b, h) (((b) * 2 + (h)) * HTB)
#define PG8_SB(b, h) ((4 + (b) * 2 + (h)) * HTB)
#define PG8_STAGE(bufoff, gbase, voff) do { _Pragma("unroll") for (int _i = 0; _i < 2; ++_i) \
        __builtin_amdgcn_global_load_lds((const unsigned*)((const char*)(gbase) + (voff)[_i]), (LAS unsigned*)(lds + (bufoff) + ldsw + _i * 8192), 16, 0, 0); } while (0)
#define PG8_LDA(dst, b, h) do { _Pragma("unroll") for (int m = 0; m < 4; ++m) _Pragma("unroll") for (int k = 0; k < 2; ++k) dst[m][k] = *(const LAS bf16x8*)(lds + PG8_SA(b, h) + aoff + m * 2048 + k * 1024); } while (0)
#define PG8_LDB(dst, b, h) do { _Pragma("unroll") for (int n = 0; n < 2; ++n) _Pragma("unroll") for (int k = 0; k < 2; ++k) dst[n][k] = *(const LAS bf16x8*)(lds + PG8_SB(b, h) + boff + n * 2048 + k * 1024); } while (0)
#define PG8_MMA(ai, bj, At, Bt) do { __builtin_amdgcn_s_setprio(1); _Pragma("unroll") for (int m = 0; m < 4; ++m) _Pragma("unroll") for (int n = 0; n < 2; ++n) _Pragma("unroll") for (int k = 0; k < 2; ++k) \
        acc[ai][bj][m][n] = __builtin_amdgcn_mfma_f32_16x16x32_bf16(Bt[n][k], At[m][k], acc[ai][bj][m][n], 0, 0, 0); __builtin_amdgcn_s_setprio(0); } while (0)
#define PG8_WAIT_V(n) asm volatile("s_waitcnt vmcnt(" #n ")" ::: "memory")
#define PG8_WAIT_L(n) asm volatile("s_waitcnt lgkmcnt(" #n ")" ::: "memory")
#define PG8_BAR __builtin_amdgcn_s_barrier()
#define PG8_SCHED __builtin_amdgcn_sched_barrier(0)
    Unit cur, nxt; int ui = 0;
    if (!S.next(0, cur)) return;
    f32x4 acc[2][2][4][2];
#pragma unroll
    for (int a = 0; a < 2; ++a)
#pragma unroll
        for (int b = 0; b < 2; ++b)
#pragma unroll
            for (int m = 0; m < 4; ++m)
#pragma unroll
                for (int n = 0; n < 2; ++n) acc[a][b][m][n] = (f32x4){0.f, 0.f, 0.f, 0.f};
    bf16x8 At[4][2], B0[2][2], B1[2][2];
    const char* cA = (const char*)g.A + (size_t)cur.pm * tstep; const char* cB = (const char*)g.Bt + (size_t)cur.pn * tstep;
    PG8_STAGE(PG8_SB(0, 0), cB, voffA); PG8_STAGE(PG8_SA(0, 0), cA, voffA); PG8_STAGE(PG8_SB(0, 1), cB + hstep, voffA); PG8_STAGE(PG8_SA(0, 1), cA + hstep, voffA);
    if (wr == 1) PG8_BAR;
    PG8_WAIT_V(4); PG8_BAR;
    PG8_STAGE(PG8_SB(1, 0), cB + kstep, voffA); PG8_STAGE(PG8_SA(1, 0), cA + kstep, voffA); PG8_STAGE(PG8_SB(1, 1), cB + hstep + kstep, voffA);
    PG8_WAIT_V(6); PG8_BAR;
    for (;;) {
        const bool has_next = S.next(ui + 1, nxt);
        const char* nA = has_next ? (const char*)g.A + (size_t)nxt.pm * tstep : cA; const char* nB = has_next ? (const char*)g.Bt + (size_t)nxt.pn * tstep : cB;
        for (int t = 0; t < nt; t += 2) {
            const bool last = (t == nt - 2);
            const char* a1 = cA + (size_t)(t + 1) * kstep;
            const char* a2 = last ? nA : cA + (size_t)(t + 2) * kstep; const char* b2 = last ? nB : cB + (size_t)(t + 2) * kstep;
            const char* a3 = a2 + kstep; const char* b3 = b2 + kstep;
            PG8_LDB(B0, 0, 0); PG8_SCHED; PG8_LDA(At, 0, 0); PG8_STAGE(PG8_SA(1, 1), a1 + hstep, voffA);
            PG8_WAIT_L(8); PG8_BAR; PG8_WAIT_L(0); PG8_MMA(0, 0, At, B0); PG8_BAR; PG8_SCHED;
            PG8_LDB(B1, 0, 1); PG8_STAGE(PG8_SB(0, 0), b2, voffA);
            PG8_BAR; PG8_WAIT_L(0); PG8_MMA(0, 1, At, B1); PG8_BAR;
            PG8_LDA(At, 0, 1); PG8_STAGE(PG8_SA(0, 0), a2, voffA);
            PG8_BAR; PG8_WAIT_L(0); PG8_MMA(1, 0, At, B0); PG8_BAR; PG8_SCHED;
            PG8_STAGE(PG8_SB(0, 1), b2 + hstep, voffA);
            PG8_WAIT_V(6); PG8_BAR; PG8_MMA(1, 1, At, B1); PG8_BAR;
            PG8_LDB(B0, 1, 0); PG8_SCHED; PG8_LDA(At, 1, 0); PG8_STAGE(PG8_SA(0, 1), a2 + hstep, voffA);
            PG8_WAIT_L(8); PG8_BAR; PG8_WAIT_L(0); PG8_MMA(0, 0, At, B0); PG8_BAR; PG8_SCHED;
            PG8_LDB(B1, 1, 1); PG8_STAGE(PG8_SB(1, 0), b3, voffA);
            PG8_BAR; PG8_WAIT_L(0); PG8_MMA(0, 1, At, B1); PG8_BAR;
            PG8_LDA(At, 1, 1); PG8_STAGE(PG8_SA(1, 0), a3, voffA);
            PG8_BAR; PG8_WAIT_L(0); PG8_MMA(1, 0, At, B0); PG8_BAR; PG8_SCHED;
            PG8_STAGE(PG8_SB(1, 1), b3 + hstep, voffA);
            PG8_WAIT_V(6); PG8_BAR; PG8_MMA(1, 1, At, B1); PG8_BAR;
        }
        E(acc, cur, wr, wc, fr, fq);
        if (!has_next) break;
#pragma unroll
        for (int a = 0; a < 2; ++a)
#pragma unroll
            for (int b = 0; b < 2; ++b)
#pragma unroll
                for (int m = 0; m < 4; ++m)
#pragma unroll
                    for (int n = 0; n < 2; ++n) acc[a][b][m][n] = (f32x4){0.f, 0.f, 0.f, 0.f};
        cur = nxt; cA = nA; cB = nB; ++ui;
    }
    PG8_WAIT_V(0);
    if (wr == 0) PG8_BAR;
    PG8_BAR;
#undef PG8_SA
#undef PG8_SB
#undef PG8_STAGE
#undef PG8_LDA
#undef PG8_LDB
#undef PG8_MMA
#undef PG8_WAIT_V
#undef PG8_WAIT_L
#undef PG8_BAR
#undef PG8_SCHED
}
}
using pg8::Unit;

struct EpiRoute {
    bf16_t *GA, *GB, *BB, *BC, *BH, *ZS, *XBC; float* DT; const float* dt_bias; int tile0;
    __device__ __forceinline__ void operator()(const f32x4 (&acc)[2][2][4][2], const Unit& u, int wr, int wc, int fr, int fq) const {
        const int gt = u.pn + tile0; const int row0 = u.pm * 256 + wr * 64 + fr;
        if (gt < 80) {
            bf16_t* base; int ldc, cb, act;
            if (gt < 40) { const int r = gt >> 3; base = (r == 0 ? GA : r == 1 ? GB : r == 2 ? BB : r == 3 ? BC : BH); ldc = DM; cb = (gt & 7) * 256; act = r < 2 ? 1 : 0; }
            else if (gt < 56) { base = ZS; ldc = DI; cb = (gt - 40) * 256; act = 2; }
            else { base = XBC; ldc = CONVD; cb = (gt - 56) * 256; act = 0; }
            const int col0 = cb + wc * 32 + 8 * fq;
#pragma unroll
            for (int ai = 0; ai < 2; ++ai)
#pragma unroll
                for (int m = 0; m < 4; ++m) { bf16_t* rowp = base + (size_t)(row0 + ai * 128 + m * 16) * ldc + col0;
#pragma unroll
                    for (int bj = 0; bj < 2; ++bj) { f32x4 v0 = acc[ai][bj][m][0], v1 = acc[ai][bj][m][1];
                        if (act == 1) {
#pragma unroll
                            for (int j = 0; j < 4; ++j) { v0[j] = sigmoidf_(v0[j]); v1[j] = sigmoidf_(v1[j]); } }
                        else if (act == 2) {
#pragma unroll
                            for (int j = 0; j < 4; ++j) { v0[j] = siluf_(v0[j]); v1[j] = siluf_(v1[j]); } }
                        *(u32x4*)(rowp + bj * 128) = pack8(v0, v1); } }
        } else if (wc < 2) {
            const int c0 = wc * 32 + 8 * fq;
            f32x4 b0 = *(const f32x4*)(dt_bias + c0), b1 = *(const f32x4*)(dt_bias + c0 + 4);
#pragma unroll
            for (int ai = 0; ai < 2; ++ai)
#pragma unroll
                for (int m = 0; m < 4; ++m) { float* rowp = DT + (size_t)(row0 + ai * 128 + m * 16) * NH + c0;
                    f32x4 v0 = acc[ai][0][m][0] + b0, v1 = acc[ai][0][m][1] + b1;
#pragma unroll
                    for (int j = 0; j < 4; ++j) { v0[j] = softplusf_(v0[j]); v1[j] = softplusf_(v1[j]); }
                    *(f32x4*)rowp = v0; *(f32x4*)(rowp + 4) = v1; }
        }
    }
};
template <bool ADD> struct EpiGate {
    const bf16_t* GATE; const bf16_t* PREV; bf16_t* O;
    __device__ __forceinline__ void operator()(const f32x4 (&acc)[2][2][4][2], const Unit& u, int wr, int wc, int fr, int fq) const {
        const int row0 = u.pm * 256 + wr * 64 + fr, col0 = u.pn * 256 + wc * 32 + 8 * fq;
#pragma unroll
        for (int ai = 0; ai < 2; ++ai)
#pragma unroll
            for (int m = 0; m < 4; ++m) { const size_t ro = (size_t)(row0 + ai * 128 + m * 16) * DM + col0;
#pragma unroll
                for (int bj = 0; bj < 2; ++bj) { const size_t idx = ro + bj * 128;
                    f32x4 g0, g1; unpack8(*(const u32x4*)(GATE + idx), g0, g1);
                    f32x4 v0 = g0 * acc[ai][bj][m][0], v1 = g1 * acc[ai][bj][m][1];
                    if (ADD) { f32x4 p0, p1; unpack8(*(const u32x4*)(PREV + idx), p0, p1); v0 += p0; v1 += p1; }
                    *(u32x4*)(O + idx) = pack8(v0, v1); } }
    }
};
template <bool WBF> struct EpiRes {
    const float* X; float* H; bf16_t* HBF; float* ssq;
    __device__ __forceinline__ void operator()(const f32x4 (&acc)[2][2][4][2], const Unit& u, int wr, int wc, int fr, int fq) const {
        const int row0 = u.pm * 256 + wr * 64 + fr, col0 = u.pn * 256 + wc * 32 + 8 * fq;
#pragma unroll
        for (int ai = 0; ai < 2; ++ai)
#pragma unroll
            for (int m = 0; m < 4; ++m) { const int row = row0 + ai * 128 + m * 16; const size_t ro = (size_t)row * DM + col0; float s = 0.f;
#pragma unroll
                for (int bj = 0; bj < 2; ++bj) { const size_t idx = ro + bj * 128;
                    f32x4 h0 = *(const f32x4*)(X + idx) + acc[ai][bj][m][0], h1 = *(const f32x4*)(X + idx + 4) + acc[ai][bj][m][1];
                    *(f32x4*)(H + idx) = h0; *(f32x4*)(H + idx + 4) = h1;
                    if (WBF) *(u32x4*)(HBF + idx) = pack8(h0, h1);
#pragma unroll
                    for (int j = 0; j < 4; ++j) s += h0[j] * h0[j] + h1[j] * h1[j]; }
                s += __shfl_xor(s, 16); s += __shfl_xor(s, 32);
                if (fq == 0) atomicAdd(ssq + row, s); }
    }
};
struct EpiSwiglu {
    const float* ssq; bf16_t* ACT;
    __device__ __forceinline__ void operator()(const f32x4 (&acc)[2][2][4][2], const Unit& u, int wr, int wc, int fr, int fq) const {
        const int row0 = u.pm * 256 + wr * 64 + fr, ch0 = u.pn * 128 + wc * 32 + 8 * fq;
#pragma unroll
        for (int ai = 0; ai < 2; ++ai)
#pragma unroll
            for (int m = 0; m < 4; ++m) { const int row = row0 + ai * 128 + m * 16; const float r = rsqrtf(ssq[row] * (1.0f / DM) + EPS);
                f32x4 v0, v1;
#pragma unroll
                for (int j = 0; j < 4; ++j) { v0[j] = siluf_(acc[ai][0][m][0][j] * r) * (acc[ai][1][m][0][j] * r); v1[j] = siluf_(acc[ai][0][m][1][j] * r) * (acc[ai][1][m][1][j] * r); }
                *(u32x4*)(ACT + (size_t)row * DFF + ch0) = pack8(v0, v1); }
    }
};

__device__ __forceinline__ int slot2lc(int slot) { return (slot & ~31) + pg8::perm32(slot & 31); }
__device__ __forceinline__ void conv_tile(LAS float* tile, const float* src0, const float* src1, int ldsrc, int nvalid, int K, bf16_t* dst, const float* kscale, int mode, int nt, int kt) {
    const int tid = threadIdx.x;
    { const int j = tid & 63, i0 = tid >> 6; const int nrow = nt * 64 + j, t256 = nrow >> 8, lc = slot2lc(nrow & 255);
      const float* s; int col; bool valid;
      if (mode == 0) { col = t256 * 256 + lc; s = src0; valid = col < nvalid; } else { col = t256 * 128 + (lc & 127); s = (lc >> 7) ? src1 : src0; valid = true; }
#pragma unroll
      for (int ii = 0; ii < 8; ++ii) { const int kl = i0 + 8 * ii, k = kt * 64 + kl; float v = valid ? s[(size_t)k * ldsrc + col] : 0.f; if (kscale) v *= kscale[k]; tile[j * 65 + kl] = v; } }
    __syncthreads();
    { const int kk = (tid & 31) * 2, j0 = tid >> 5;
#pragma unroll
      for (int it = 0; it < 4; ++it) { const int j = j0 + 16 * it; *(unsigned*)(dst + (size_t)(nt * 64 + j) * K + kt * 64 + kk) = pk2(tile[j * 65 + kk], tile[j * 65 + kk + 1]); } }
    __syncthreads();
}

__device__ __forceinline__ void phase_prep(const Params& p, LAS unsigned char* lds) {
    LAS float* tile = (LAS float*)lds; unsigned char* ws = p.ws;
    constexpr int N0 = 324 * 32, N1 = N0 + 32 * 32, N2 = N1 + 32 * 64, N3 = N2 + 32 * 32, N4 = N3 + 176 * 32, N5 = N4 + 32 * 88;
    for (int it = blockIdx.x; it < N5; it += gridDim.x) {
        if (it < N0)      { const int i = it;      conv_tile(tile, p.w_in, nullptr, IN_COLS, IN_COLS, DM, (bf16_t*)(ws + OFF_WIN), nullptr, 0, i / 32, i % 32); }
        else if (it < N1) { const int i = it - N0; conv_tile(tile, p.w_out_a, nullptr, DM, DM, DM, (bf16_t*)(ws + OFF_WOA), nullptr, 0, i / 32, i % 32); }
        else if (it < N2) { const int i = it - N1; conv_tile(tile, p.w_out_ssm, nullptr, DM, DM, DI, (bf16_t*)(ws + OFF_WOS), nullptr, 0, i / 64, i % 64); }
        else if (it < N3) { const int i = it - N2; conv_tile(tile, p.w_o, nullptr, DM, DM, DM, (bf16_t*)(ws + OFF_WO), nullptr, 0, i / 32, i % 32); }
        else if (it < N4) { const int i = it - N3; conv_tile(tile, p.w_ffn_gate, p.w_ffn_up, DFF, DFF, DM, (bf16_t*)(ws + OFF_WGU), p.norm_ffn_g, 1, i / 32, i % 32); }
        else              { const int i = it - N4; conv_tile(tile, p.w_ffn_down, nullptr, DM, DM, DFF, (bf16_t*)(ws + OFF_WDN), nullptr, 0, i / 88, i % 88); }
    }
    { float* s1 = (float*)(ws + OFF_SSQ1); for (int i = blockIdx.x * 512 + threadIdx.x; i < 2 * NTOK; i += gridDim.x * 512) s1[i] = 0.f; }
    { const int wave = threadIdx.x >> 6, lane = threadIdx.x & 63; bf16_t* U = (bf16_t*)(ws + OFF_U);
      for (int row = blockIdx.x * 8 + wave; row < NTOK; row += gridDim.x * 8) {
          const f32x4* xr = (const f32x4*)(p.x + (size_t)row * DM); f32x4 v[8]; float ss = 0.f;
#pragma unroll
          for (int i = 0; i < 8; ++i) { v[i] = xr[lane + 64 * i]; ss += v[i][0] * v[i][0] + v[i][1] * v[i][1] + v[i][2] * v[i][2] + v[i][3] * v[i][3]; }
#pragma unroll
          for (int o = 32; o >= 1; o >>= 1) ss += __shfl_xor(ss, o);
          const float r = rsqrtf(ss * (1.0f / DM) + EPS);
#pragma unroll
          for (int i = 0; i < 8; ++i) { const f32x4 gg = ((const f32x4*)p.norm_mix_g)[lane + 64 * i]; u32x2 w; w.x = pk2(v[i][0] * r * gg[0], v[i][1] * r * gg[1]); w.y = pk2(v[i][2] * r * gg[2], v[i][3] * r * gg[3]);
              *(u32x2*)(U + (size_t)row * DM + (lane + 64 * i) * 4) = w; } } }
}

__device__ __forceinline__ void phase_ssmconv(const Params& p) {
    const bf16_t* XBC = (const bf16_t*)(p.ws + OFF_XBC); bf16_t* XS = (bf16_t*)p.out; bf16_t* BCS = (bf16_t*)(p.ws + OFF_BCS);
    const size_t total = (size_t)NTOK * 768;
    for (size_t idx = (size_t)blockIdx.x * 512 + threadIdx.x; idx < total; idx += (size_t)gridDim.x * 512) {
        const int t = (int)(idx / 768), c = (int)(idx % 768) * 8, tl = t & (SEQ - 1);
        f32x4 a0 = *(const f32x4*)(p.ssm_conv_b + c), a1 = *(const f32x4*)(p.ssm_conv_b + c + 4);
#pragma unroll
        for (int j = 0; j < 4; ++j) { if (tl - 3 + j >= 0) { f32x4 r0, r1; unpack8(*(const u32x4*)(XBC + (size_t)(t - 3 + j) * CONVD + c), r0, r1);
                a0 += *(const f32x4*)(p.ssm_conv_w + j * CONVD + c) * r0; a1 += *(const f32x4*)(p.ssm_conv_w + j * CONVD + c + 4) * r1; } }
#pragma unroll
        for (int j = 0; j < 4; ++j) { a0[j] = siluf_(a0[j]); a1[j] = siluf_(a1[j]); }
        if (c < DI) *(u32x4*)(XS + (size_t)t * DI + c) = pack8(a0, a1); else *(u32x4*)(BCS + (size_t)t * 2048 + (c - DI)) = pack8(a0, a1);
    }
}

__device__ __forceinline__ void phase_ssd_seq(const Params& p, LAS unsigned char* lds) {
    LAS float* part = (LAS float*)lds;
    const int tid = threadIdx.x, pp = tid >> 3, ng = tid & 7, wave = tid >> 6, lane = tid & 63;
    const bf16_t* XS = (const bf16_t*)p.out; const bf16_t* BCS = (const bf16_t*)(p.ws + OFF_BCS); bf16_t* ZS = (bf16_t*)(p.ws + OFF_ZS);
    const float* DT = (const float*)(p.ws + OFF_DT); float* SSQH = (float*)(p.ws + OFF_SSQH);
    for (int item = blockIdx.x; item < 256; item += gridDim.x) {
        const int b = item >> 6, h = item & 63, g = h >> 3;
        const float a = -__expf(p.a_log[h]), Dk = p.d_skip[h];
        const bf16_t* xs = XS + (size_t)b * SEQ * DI + h * 64 + pp;
        const bf16_t* Bs = BCS + (size_t)b * SEQ * 2048 + g * 128 + ng * 16;
        const bf16_t* Cs = Bs + 1024;
        bf16_t* zs = ZS + (size_t)b * SEQ * DI + h * 64 + pp;
        const float* dt = DT + (size_t)b * SEQ * NH + h;
        float st[16];
#pragma unroll
        for (int i = 0; i < 16; ++i) st[i] = 0.f;
        for (int t0 = 0; t0 < SEQ; t0 += 64) {
#pragma unroll 4
            for (int tt = 0; tt < 64; ++tt) {
                const int t = t0 + tt;
                const float dtv = dt[(size_t)t * NH], xv = bf2f(xs[(size_t)t * DI]), zv = bf2f(zs[(size_t)t * DI]);
                f32x4 B0, B1, B2, B3, C0, C1, C2, C3;
                unpack8(*(const u32x4*)(Bs + (size_t)t * 2048), B0, B1); unpack8(*(const u32x4*)(Bs + (size_t)t * 2048 + 8), B2, B3);
                unpack8(*(const u32x4*)(Cs + (size_t)t * 2048), C0, C1); unpack8(*(const u32x4*)(Cs + (size_t)t * 2048 + 8), C2, C3);
                const float dA = __expf(dtv * a), xdt = xv * dtv; float y = 0.f;
#pragma unroll
                for (int i = 0; i < 4; ++i) {
                    st[i] = dA * st[i] + xdt * B0[i]; y += C0[i] * st[i];
                    st[4 + i] = dA * st[4 + i] + xdt * B1[i]; y += C1[i] * st[4 + i];
                    st[8 + i] = dA * st[8 + i] + xdt * B2[i]; y += C2[i] * st[8 + i];
                    st[12 + i] = dA * st[12 + i] + xdt * B3[i]; y += C3[i] * st[12 + i]; }
                y += __shfl_xor(y, 1); y += __shfl_xor(y, 2); y += __shfl_xor(y, 4);
                y += Dk * xv;
                const float yz = y * zv;
                if (ng == 0) zs[(size_t)t * DI] = (bf16_t)f2bf(yz);
                float sq = (ng == 0) ? yz * yz : 0.f;
                sq += __shfl_xor(sq, 8); sq += __shfl_xor(sq, 16); sq += __shfl_xor(sq, 32);
                if (lane == 0) part[tt * 8 + wave] = sq;
            }
            __syncthreads();
            if (tid < 64) { float s = 0.f;
#pragma unroll
                for (int w = 0; w < 8; ++w) s += part[tid * 8 + w];
                SSQH[(size_t)(b * SEQ + t0 + tid) * NH + h] = s; }
            __syncthreads();
        }
    }
}

__device__ __forceinline__ void phase_gnorm(const Params& p) {
    bf16_t* ZS = (bf16_t*)(p.ws + OFF_ZS); const float* SSQH = (const float*)(p.ws + OFF_SSQH);
    const size_t total = (size_t)NTOK * 512;
    for (size_t idx = (size_t)blockIdx.x * 512 + threadIdx.x; idx < total; idx += (size_t)gridDim.x * 512) {
        const int t = (int)(idx >> 9), cg8 = (int)(idx & 511), c = cg8 * 8, g = cg8 >> 6;
        const f32x4 s0 = *(const f32x4*)(SSQH + (size_t)t * NH + g * 8), s1 = *(const f32x4*)(SSQH + (size_t)t * NH + g * 8 + 4);
        const float ss = s0[0] + s0[1] + s0[2] + s0[3] + s1[0] + s1[1] + s1[2] + s1[3];
        const float r = rsqrtf(ss * (1.0f / 512.0f) + EPS);
        f32x4 v0, v1; unpack8(*(const u32x4*)(ZS + (size_t)t * DI + c), v0, v1);
        v0 = v0 * r * *(const f32x4*)(p.ssm_norm_g + c); v1 = v1 * r * *(const f32x4*)(p.ssm_norm_g + c + 4);
        *(u32x4*)(ZS + (size_t)t * DI + c) = pack8(v0, v1);
    }
}

__device__ __forceinline__ void phase_mixa(const Params& p) {
    const bf16_t* BB = (const bf16_t*)(p.ws + OFF_BB); const bf16_t* BC = (const bf16_t*)(p.ws + OFF_BC); const bf16_t* BH = (const bf16_t*)(p.ws + OFF_BH); bf16_t* YA = (bf16_t*)(p.ws + OFF_U);
    const size_t total = (size_t)NTOK * 256;
    for (size_t idx = (size_t)blockIdx.x * 512 + threadIdx.x; idx < total; idx += (size_t)gridDim.x * 512) {
        const int t = (int)(idx >> 8), c = (int)(idx & 255) * 8, tl = t & (SEQ - 1);
        f32x4 a0 = {0.f, 0.f, 0.f, 0.f}, a1 = {0.f, 0.f, 0.f, 0.f};
#pragma unroll
        for (int j = 0; j < 3; ++j) { if (tl - 2 + j >= 0) { const size_t o = (size_t)(t - 2 + j) * DM + c; f32x4 c0, c1, h0, h1; unpack8(*(const u32x4*)(BC + o), c0, c1); unpack8(*(const u32x4*)(BH + o), h0, h1);
                a0 += *(const f32x4*)(p.conv_a_w + j * DM + c) * (c0 * h0); a1 += *(const f32x4*)(p.conv_a_w + j * DM + c + 4) * (c1 * h1); } }
        f32x4 b0, b1; unpack8(*(const u32x4*)(BB + (size_t)t * DM + c), b0, b1);
        *(u32x4*)(YA + (size_t)t * DM + c) = pack8(a0 * b0, a1 * b1);
    }
}

__device__ __forceinline__ void phase_final(const Params& p) {
    const float* SSQ2 = (const float*)(p.ws + OFF_SSQ2);
    const size_t total = (size_t)NTOK * 512;
    for (size_t idx = (size_t)blockIdx.x * 512 + threadIdx.x; idx < total; idx += (size_t)gridDim.x * 512) {
        const int t = (int)(idx >> 9), c = (int)(idx & 511) * 4;
        const float r = rsqrtf(SSQ2[t] * (1.0f / DM) + EPS);
        f32x4 v = *(const f32x4*)(p.out + (size_t)t * DM + c);
        *(f32x4*)(p.out + (size_t)t * DM + c) = v * r * *(const f32x4*)(p.norm_final_g + c);
    }
}

constexpr int NPHASE = 11;
template <int PH> __device__ __forceinline__ void run_phase(const Params& p, LAS unsigned char* lds) {
    unsigned char* ws = p.ws;
    pg8::StaticOrder S; pg8::Gemm g;
    if constexpr (PH == 0) { phase_prep(p, lds); }
    else if constexpr (PH == 1) {
        g.A = (const bf16_t*)(ws + OFF_U); g.Bt = (const bf16_t*)(ws + OFF_WIN) + (size_t)40 * 256 * DM; g.M = NTOK; g.N = 41 * 256; g.K = DM; S.init(g.M, g.N, gridDim.x, blockIdx.x);
        EpiRoute E{(bf16_t*)p.out, (bf16_t*)p.out + (size_t)NTOK * DM, (bf16_t*)(ws + OFF_BB), (bf16_t*)(ws + OFF_BC), (bf16_t*)(ws + OFF_BH), (bf16_t*)(ws + OFF_ZS), (bf16_t*)(ws + OFF_XBC), (float*)(ws + OFF_DT), p.dt_bias, 40};
        pg8::gemm_phase(lds, g, S, E); }
    else if constexpr (PH == 2) { phase_ssmconv(p); }
    else if constexpr (PH == 3) { phase_ssd_seq(p, lds); }
    else if constexpr (PH == 4) {
        g.A = (const bf16_t*)(ws + OFF_U); g.Bt = (const bf16_t*)(ws + OFF_WIN); g.M = NTOK; g.N = 40 * 256; g.K = DM; S.init(g.M, g.N, gridDim.x, blockIdx.x);
        EpiRoute E{(bf16_t*)p.out, (bf16_t*)p.out + (size_t)NTOK * DM, (bf16_t*)(ws + OFF_BB), (bf16_t*)(ws + OFF_BC), (bf16_t*)(ws + OFF_BH), (bf16_t*)(ws + OFF_ZS), (bf16_t*)(ws + OFF_XBC), (float*)(ws + OFF_DT), p.dt_bias, 0};
        pg8::gemm_phase(lds, g, S, E);
        phase_gnorm(p); }
    else if constexpr (PH == 5) { phase_mixa(p); }
    else if constexpr (PH == 6) {
        g.A = (const bf16_t*)(ws + OFF_U); g.Bt = (const bf16_t*)(ws + OFF_WOA); g.M = NTOK; g.N = DM; g.K = DM; S.init(g.M, g.N, gridDim.x, blockIdx.x);
        EpiGate<false> Ea{(const bf16_t*)p.out, nullptr, (bf16_t*)(ws + OFF_BB)};
        pg8::gemm_phase(lds, g, S, Ea);
        g.A = (const bf16_t*)(ws + OFF_ZS); g.Bt = (const bf16_t*)(ws + OFF_WOS); g.K = DI;
        EpiGate<true> Eb{(const bf16_t*)p.out + (size_t)NTOK * DM, (const bf16_t*)(ws + OFF_BB), (bf16_t*)(ws + OFF_BC)};
        pg8::gemm_phase(lds, g, S, Eb); }
    else if constexpr (PH == 7) {
        g.A = (const bf16_t*)(ws + OFF_BC); g.Bt = (const bf16_t*)(ws + OFF_WO); g.M = NTOK; g.N = DM; g.K = DM; S.init(g.M, g.N, gridDim.x, blockIdx.x);
        EpiRes<true> E{p.x, p.out, (bf16_t*)(ws + OFF_BH), (float*)(ws + OFF_SSQ1)};
        pg8::gemm_phase(lds, g, S, E); }
    else if constexpr (PH == 8) {
        g.A = (const bf16_t*)(ws + OFF_BH); g.Bt = (const bf16_t*)(ws + OFF_WGU); g.M = NTOK; g.N = 2 * DFF; g.K = DM; S.init(g.M, g.N, gridDim.x, blockIdx.x);
        EpiSwiglu E{(const float*)(ws + OFF_SSQ1), (bf16_t*)(ws + OFF_ZS)};
        pg8::gemm_phase(lds, g, S, E); }
    else if constexpr (PH == 9) {
        g.A = (const bf16_t*)(ws + OFF_ZS); g.Bt = (const bf16_t*)(ws + OFF_WDN); g.M = NTOK; g.N = DM; g.K = DFF; S.init(g.M, g.N, gridDim.x, blockIdx.x);
        EpiRes<false> E{p.out, p.out, nullptr, (float*)(ws + OFF_SSQ2)};
        pg8::gemm_phase(lds, g, S, E); }
    else if constexpr (PH == 10) { phase_final(p); }
}

template <int PH> __global__ void __launch_bounds__(512, 2) k_one(Params p) {
    extern __shared__ __attribute__((aligned(16))) unsigned char lds_raw[];
    run_phase<PH>(p, (LAS unsigned char*)lds_raw);
}

__global__ void __launch_bounds__(512, 2) k_mega(Params p) {
    extern __shared__ __attribute__((aligned(16))) unsigned char lds_raw[];
    LAS unsigned char* lds = (LAS unsigned char*)lds_raw;
    cg::grid_group grid = cg::this_grid();
    run_phase<0>(p, lds); grid.sync();
    run_phase<1>(p, lds); grid.sync();
    run_phase<2>(p, lds); grid.sync();
    run_phase<3>(p, lds); grid.sync();
    run_phase<4>(p, lds); grid.sync();
    run_phase<5>(p, lds); grid.sync();
    run_phase<6>(p, lds); grid.sync();
    run_phase<7>(p, lds); grid.sync();
    run_phase<8>(p, lds); grid.sync();
    run_phase<9>(p, lds); grid.sync();
    run_phase<10>(p, lds);
}

constexpr int LDS_BYTES = pg8::STAGE_BYTES;

template <int PH> static void launch_one(const Params& p, int grid, hipStream_t stream) {
    static bool attr = false;
    if (!attr) { (void)hipFuncSetAttribute((const void*)k_one<PH>, hipFuncAttributeMaxDynamicSharedMemorySize, LDS_BYTES); attr = true; }
    hipLaunchKernelGGL(k_one<PH>, dim3(grid), dim3(512), LDS_BYTES, stream, p);
}

extern "C" void kernel_launch(void* const* d_in, const int* in_sizes, int n_in, void* d_out, int out_size, void* d_ws, size_t ws_size, hipStream_t stream) {
    static int grid = 0;
    if (grid == 0) {
        if (n_in != 18 || out_size != NTOK * DM || ws_size < WS_END) { fprintf(stderr, "kernel_launch: unexpected shapes: n_in %d out %d ws %zu (need %zu)\n", n_in, out_size, ws_size, (size_t)WS_END); grid = -1; return; }
        int dev = 0, cus = 0, per_cu = 0;
        (void)hipGetDevice(&dev); (void)hipDeviceGetAttribute(&cus, hipDeviceAttributeMultiprocessorCount, dev);
        (void)hipFuncSetAttribute((const void*)k_mega, hipFuncAttributeMaxDynamicSharedMemorySize, LDS_BYTES);
        (void)hipOccupancyMaxActiveBlocksPerMultiprocessor(&per_cu, (const void*)k_mega, 512, LDS_BYTES);
        if (per_cu < 1) { fprintf(stderr, "kernel_launch: occupancy query says %d blocks per CU\n", per_cu); per_cu = 1; }
        (void)hipGetLastError();
        grid = cus * per_cu;
        fprintf(stderr, "kernel_launch: cus %d per_cu %d grid %d ws %zu\n", cus, per_cu, grid, ws_size);
    }
    if (grid < 0) return;
    Params p{};
    const float** pp = (const float**)&p;
    for (int i = 0; i < 18; ++i) pp[i] = (const float*)d_in[i];
    p.out = (float*)d_out; p.ws = (unsigned char*)d_ws;
#if MEGA
    void* args[] = {&p};
    hipError_t e = hipLaunchCooperativeKernel((const void*)k_mega, dim3(grid), dim3(512), args, LDS_BYTES, stream);
    if (e != hipSuccess) fprintf(stderr, "cooperative launch failed: %s (grid %d)\n", hipGetErrorString(e), grid);
#else
    launch_one<0>(p, grid, stream); launch_one<1>(p, grid, stream); launch_one<2>(p, grid, stream); launch_one<3>(p, grid, stream); launch_one<4>(p, grid, stream); launch_one<5>(p, grid, stream);
    launch_one<6>(p, grid, stream); launch_one<7>(p, grid, stream); launch_one<8>(p, grid, stream); launch_one<9>(p, grid, stream); launch_one<10>(p, grid, stream);
#endif
}
```

```cpp
#include <hip/hip_runtime.h>
#include <hip/hip_cooperative_groups.h>
#include <cstdio>
namespace cg = cooperative_groups;

#ifndef MEGA
#define MEGA 1
#endif

#define LAS __attribute__((address_space(3)))
typedef unsigned short bf16_t;
typedef short bf16x8 __attribute__((ext_vector_type(8)));
typedef float f32x4 __attribute__((ext_vector_type(4)));
typedef unsigned u32x4 __attribute__((ext_vector_type(4)));
typedef unsigned u32x2 __attribute__((ext_vector_type(2)));

constexpr int DM = 2048, NTOK = 16384, SEQ = 4096;
constexpr int IN_COLS = 20544, IN_TILES = 81;
constexpr int DI = 4096, NH = 64, HD = 64, NG = 8, NST = 128, CONVD = 6144;
constexpr int DFF = 5632;
constexpr float EPS = 1e-6f;

constexpr size_t MiB = 1024ull * 1024ull;
constexpr size_t OFF_WIN = 0;
constexpr size_t OFF_WOA = 81 * MiB;
constexpr size_t OFF_WOS = 89 * MiB;
constexpr size_t OFF_WO  = 105 * MiB;
constexpr size_t OFF_WGU = 113 * MiB;
constexpr size_t OFF_WDN = 157 * MiB;
constexpr size_t OFF_ZS  = 179 * MiB;
constexpr size_t OFF_U   = 307 * MiB;
constexpr size_t OFF_XBC = 371 * MiB;
constexpr size_t OFF_BB  = 371 * MiB, OFF_BC = 435 * MiB, OFF_BH = 499 * MiB;
constexpr size_t OFF_DT  = 563 * MiB;
constexpr size_t OFF_SSQH = 567 * MiB;
constexpr size_t OFF_SSQ1 = 571 * MiB;
constexpr size_t OFF_SSQ2 = 571 * MiB + 65536;
constexpr size_t OFF_BCS = 572 * MiB;
constexpr size_t WS_END = 636 * MiB;

struct Params {
    const float *x, *norm_mix_g, *w_in, *conv_a_w, *w_out_a, *ssm_conv_w, *ssm_conv_b, *dt_bias, *a_log, *d_skip, *ssm_norm_g, *w_out_ssm, *w_o, *norm_ffn_g, *w_ffn_gate, *w_ffn_up,
        *w_ffn_down, *norm_final_g;
    float* out; unsigned char* ws;
};

__device__ __forceinline__ unsigned f2bf(float f) { unsigned u = __builtin_bit_cast(unsigned, f); return (u + 0x7fffu + ((u >> 16) & 1u)) >> 16; }
__device__ __forceinline__ unsigned pk2(float lo, float hi) { return f2bf(lo) | (f2bf(hi) << 16); }
__device__ __forceinline__ float bflo(unsigned w) { return __builtin_bit_cast(float, w << 16); }
__device__ __forceinline__ float bfhi(unsigned w) { return __builtin_bit_cast(float, w & 0xffff0000u); }
__device__ __forceinline__ float bf2f(bf16_t v) { return __builtin_bit_cast(float, ((unsigned)v) << 16); }
__device__ __forceinline__ float sigmoidf_(float v) { return __builtin_amdgcn_rcpf(1.0f + __expf(-v)); }
__device__ __forceinline__ float siluf_(float v) { return v * sigmoidf_(v); }
__device__ __forceinline__ float softplusf_(float v) { return fmaxf(v, 0.f) + log1pf(__expf(-fabsf(v))); }
__device__ __forceinline__ u32x4 pack8(const f32x4& a, const f32x4& b) { u32x4 w; w.x = pk2(a[0], a[1]); w.y = pk2(a[2], a[3]); w.z = pk2(b[0], b[1]); w.w = pk2(b[2], b[3]); return w; }
__device__ __forceinline__ void unpack8(const u32x4& w, f32x4& a, f32x4& b) { a[0] = bflo(w.x); a[1] = bfhi(w.x); a[2] = bflo(w.y); a[3] = bfhi(w.y); b[0] = bflo(w.z); b[1] = bfhi(w.z); b[2] = bflo(w.w); b[3] = bfhi(w.w); }

namespace pg8 {
constexpr int BM = 256, BK = 64, HALF = 128, HTB = HALF * BK * 2, STAGE_BYTES = 8 * HTB, NXCD = 8, WGM = 8;
__host__ __device__ __forceinline__ int lds_byte(int r, int c) { const int st = (r >> 4) * 2 + (c >> 5), rr = r & 15, cc = c & 31, ob = rr * 64 + cc * 2; return st * 1024 + (ob ^ (((ob >> 9) & 1) << 5)); }
__host__ __device__ __forceinline__ void stage_rc(int b, int& R, int& C) { const int st = b / 1024, sb = b % 1024, swz = sb ^ (((sb >> 9) & 1) << 5); R = (st >> 1) * 16 + swz / 64; C = (st & 1) * 32 + (swz % 64) / 2; }
__host__ __device__ __forceinline__ int perm32(int rho) { const int n = rho >> 4, i = rho & 15; return 8 * (i >> 2) + 4 * n + (i & 3); }
struct Unit { int pm, pn; };
struct Gemm { const bf16_t* A; const bf16_t* Bt; int M, N, K; };
struct StaticOrder {
    int nM, nN, nwg, G, c;
    __host__ __device__ void init(int M, int N, int G_, int c_) { nM = M / BM; nN = N / BM; nwg = nM * nN; G = G_; c = c_; }
    __host__ __device__ bool next(int i, Unit& u) const {
        const long L = (long)i * G + c; if (L >= nwg) return false;
        int wgid = (int)L; { const int q = nwg / NXCD, r = nwg % NXCD, xcd = wgid % NXCD, off = wgid / NXCD; wgid = (xcd < r ? xcd * (q + 1) : r * (q + 1) + (xcd - r) * q) + off; }
        const int nig = WGM * nN, gid = wgid / nig, fm = gid * WGM, gsz = (nM - fm) < WGM ? (nM - fm) : WGM;
        u.pm = fm + ((wgid % nig) % gsz); u.pn = (wgid % nig) / gsz; return true;
    }
};

template <class Epi>
__device__ __forceinline__ void gemm_phase(LAS unsigned char* lds, const Gemm g, const StaticOrder& S, const Epi& E) {
    const int tid = threadIdx.x, wid = __builtin_amdgcn_readfirstlane(tid >> 6), lane = tid & 63, wr = wid >> 2, wc = wid & 3, fr = lane & 15, fq = lane >> 4;
    const int K = g.K, nt = K / BK;
    unsigned voffA[2];
#pragma unroll
    for (int i = 0; i < 2; ++i) { int R, C; stage_rc(tid * 16 + i * 8192, R, C); voffA[i] = (unsigned)(R * K + C) * 2u; }
    const size_t kstep = (size_t)(BK * 2);
    const size_t hstep = (size_t)HALF * K * 2;
    const size_t tstep = 2 * hstep;
    const unsigned ldsw = (unsigned)wid * 1024u;
    const int aoff = lds_byte(wr * 64 + fr, fq * 8), boff = lds_byte(wc * 32 + fr, fq * 8);
#define PG8_SA(b, h) (((b) * 2 + (h)) * HTB)
#define PG8_SB(b, h) ((4 + (b) * 2 + (h)) * HTB)
#define PG8_STAGE(bufoff, gbase, voff) do { _Pragma("unroll") for (int _i = 0; _i < 2; ++_i) \
        __builtin_amdgcn_global_load_lds((const unsigned*)((const char*)(gbase) + (voff)[_i]), (LAS unsigned*)(lds + (bufoff) + ldsw + _i * 8192), 16, 0, 0); } while (0)
#define PG8_LDA(dst, b, h) do { _Pragma("unroll") for (int m = 0; m < 4; ++m) _Pragma("unroll") for (int k = 0; k < 2; ++k) dst[m][k] = *(const LAS bf16x8*)(lds + PG8_SA(b, h) + aoff + m * 2048 + k * 1024); } while (0)
#define PG8_LDB(dst, b, h) do { _Pragma("unroll") for (int n = 0; n < 2; ++n) _Pragma("unroll") for (int k = 0; k < 2; ++k) dst[n][k] = *(const LAS bf16x8*)(lds + PG8_SB(b, h) + boff + n * 2048 + k * 1024); } while (0)
#define PG8_MMA(ai, bj, At, Bt) do { __builtin_amdgcn_s_setprio(1); _Pragma("unroll") for (int m = 0; m < 4; ++m) _Pragma("unroll") for (int n = 0; n < 2; ++n) _Pragma("unroll") for (int k = 0; k < 2; ++k) \
        acc[ai][bj][m][n] = __builtin_amdgcn_mfma_f32_16x16x32_bf16(Bt[n][k], At[m][k], acc[ai][bj][m][n], 0, 0, 0); __builtin_amdgcn_s_setprio(0); } while (0)
#define PG8_WAIT_V(n) asm volatile("s_waitcnt vmcnt(" #n ")" ::: "memory")
#define PG8_WAIT_L(n) asm volatile("s_waitcnt lgkmcnt(" #n ")" ::: "memory")
#define PG8_BAR __builtin_amdgcn_s_barrier()
#define PG8_SCHED __builtin_amdgcn_sched_barrier(0)
    Unit cur, nxt; int ui = 0;
    if (!S.next(0, cur)) return;
    f32x4 acc[2][2][4][2];
#pragma unroll
    for (int a = 0; a < 2; ++a)
#pragma unroll
        for (int b = 0; b < 2; ++b)
#pragma unroll
            for (int m = 0; m < 4; ++m)
#pragma unroll
                for (int n = 0; n < 2; ++n) acc[a][b][m][n] = (f32x4){0.f, 0.f, 0.f, 0.f};
    bf16x8 At[4][2], B0[2][2], B1[2][2];
    const char* cA = (const char*)g.A + (size_t)cur.pm * tstep; const char* cB = (const char*)g.Bt + (size_t)cur.pn * tstep;
    PG8_STAGE(PG8_SB(0, 0), cB, voffA); PG8_STAGE(PG8_SA(0, 0), cA, voffA); PG8_STAGE(PG8_SB(0, 1), cB + hstep, voffA); PG8_STAGE(PG8_SA(0, 1), cA + hstep, voffA);
    if (wr == 1) PG8_BAR;
    PG8_WAIT_V(4); PG8_BAR;
    PG8_STAGE(PG8_SB(1, 0), cB + kstep, voffA); PG8_STAGE(PG8_SA(1, 0), cA + kstep, voffA); PG8_STAGE(PG8_SB(1, 1), cB + hstep + kstep, voffA);
    PG8_WAIT_V(6); PG8_BAR;
    for (;;) {
        const bool has_next = S.next(ui + 1, nxt);
        const char* nA = has_next ? (const char*)g.A + (size_t)nxt.pm * tstep : cA; const char* nB = has_next ? (const char*)g.Bt + (size_t)nxt.pn * tstep : cB;
        for (int t = 0; t < nt; t += 2) {
            const bool last = (t == nt - 2);
            const char* a1 = cA + (size_t)(t + 1) * kstep;
            const char* a2 = last ? nA : cA + (size_t)(t + 2) * kstep; const char* b2 = last ? nB : cB + (size_t)(t + 2) * kstep;
            const char* a3 = a2 + kstep; const char* b3 = b2 + kstep;
            PG8_LDB(B0, 0, 0); PG8_SCHED; PG8_LDA(At, 0, 0); PG8_STAGE(PG8_SA(1, 1), a1 + hstep, voffA);
            PG8_WAIT_L(8); PG8_BAR; PG8_WAIT_L(0); PG8_MMA(0, 0, At, B0); PG8_BAR; PG8_SCHED;
            PG8_LDB(B1, 0, 1); PG8_STAGE(PG8_SB(0, 0), b2, voffA);
            PG8_BAR; PG8_WAIT_L(0); PG8_MMA(0, 1, At, B1); PG8_BAR;
            PG8_LDA(At, 0, 1); PG8_STAGE(PG8_SA(0, 0), a2, voffA);
            PG8_BAR; PG8_WAIT_L(0); PG8_MMA(1, 0, At, B0); PG8_BAR; PG8_SCHED;
            PG8_STAGE(PG8_SB(0, 1), b2 + hstep, voffA);
            PG8_WAIT_V(6); PG8_BAR; PG8_MMA(1, 1, At, B1); PG8_BAR;
            PG8_LDB(B0, 1, 0); PG8_SCHED; PG8_LDA(At, 1, 0); PG8_STAGE(PG8_SA(0, 1), a2 + hstep, voffA);
            PG8_WAIT_L(8); PG8_BAR; PG8_WAIT_L(0); PG8_MMA(0, 0, At, B0); PG8_BAR; PG8_SCHED;
            PG8_LDB(B1, 1, 1); PG8_STAGE(PG8_SB(1, 0), b3, voffA);
            PG8_BAR; PG8_WAIT_L(0); PG8_MMA(0, 1, At, B1); PG8_BAR;
            PG8_LDA(At, 1, 1); PG8_STAGE(PG8_SA(1, 0), a3, voffA);
            PG8_BAR; PG8_WAIT_L(0); PG8_MMA(1, 0, At, B0); PG8_BAR; PG8_SCHED;
            PG8_STAGE(PG8_SB(1, 1), b3 + hstep, voffA);
            PG8_WAIT_V(6); PG8_BAR; PG8_MMA(1, 1, At, B1); PG8_BAR;
        }
        E(acc, cur, wr, wc, fr, fq);
        if (!has_next) break;
#pragma unroll
        for (int a = 0; a < 2; ++a)
#pragma unroll
            for (int b = 0; b < 2; ++b)
#pragma unroll
                for (int m = 0; m < 4; ++m)
#pragma unroll
                    for (int n = 0; n < 2; ++n) acc[a][b][m][n] = (f32x4){0.f, 0.f, 0.f, 0.f};
        cur = nxt; cA = nA; cB = nB; ++ui;
    }
    PG8_WAIT_V(0);
    if (wr == 0) PG8_BAR;
    PG8_BAR;
#undef PG8_SA
#undef PG8_SB
#undef PG8_STAGE
#undef PG8_LDA
#undef PG8_LDB
#undef PG8_MMA
#undef PG8_WAIT_V
#undef PG8_WAIT_L
#undef PG8_BAR
#undef PG8_SCHED
}
}
using pg8::Unit;

struct EpiRoute {
    bf16_t *GA, *GB, *BB, *BC, *BH, *ZS, *XBC; float* DT; const float* dt_bias; int tile0;
    __device__ __forceinline__ void operator()(const f32x4 (&acc)[2][2][4][2], const Unit& u, int wr, int wc, int fr, int fq) const {
        const int gt = u.pn + tile0; const int row0 = u.pm * 256 + wr * 64 + fr;
        if (gt < 80) {
            bf16_t* base; int ldc, cb, act;
            if (gt < 40) { const int r = gt >> 3; base = (r == 0 ? GA : r == 1 ? GB : r == 2 ? BB : r == 3 ? BC : BH); ldc = DM; cb = (gt & 7) * 256; act = r < 2 ? 1 : 0; }
            else if (gt < 56) { base = ZS; ldc = DI; cb = (gt - 40) * 256; act = 2; }
            else { base = XBC; ldc = CONVD; cb = (gt - 56) * 256; act = 0; }
            const int col0 = cb + wc * 32 + 8 * fq;
#pragma unroll
            for (int ai = 0; ai < 2; ++ai)
#pragma unroll
                for (int m = 0; m < 4; ++m) { bf16_t* rowp = base + (size_t)(row0 + ai * 128 + m * 16) * ldc + col0;
#pragma unroll
                    for (int bj = 0; bj < 2; ++bj) { f32x4 v0 = acc[ai][bj][m][0], v1 = acc[ai][bj][m][1];
                        if (act == 1) {
#pragma unroll
                            for (int j = 0; j < 4; ++j) { v0[j] = sigmoidf_(v0[j]); v1[j] = sigmoidf_(v1[j]); } }
                        else if (act == 2) {
#pragma unroll
                            for (int j = 0; j < 4; ++j) { v0[j] = siluf_(v0[j]); v1[j] = siluf_(v1[j]); } }
                        *(u32x4*)(rowp + bj * 128) = pack8(v0, v1); } }
        } else if (wc < 2) {
            const int c0 = wc * 32 + 8 * fq;
            f32x4 b0 = *(const f32x4*)(dt_bias + c0), b1 = *(const f32x4*)(dt_bias + c0 + 4);
#pragma unroll
            for (int ai = 0; ai < 2; ++ai)
#pragma unroll
                for (int m = 0; m < 4; ++m) { float* rowp = DT + (size_t)(row0 + ai * 128 + m * 16) * NH + c0;
                    f32x4 v0 = acc[ai][0][m][0] + b0, v1 = acc[ai][0][m][1] + b1;
#pragma unroll
                    for (int j = 0; j < 4; ++j) { v0[j] = softplusf_(v0[j]); v1[j] = softplusf_(v1[j]); }
                    *(f32x4*)rowp = v0; *(f32x4*)(rowp + 4) = v1; }
        }
    }
};
template <bool ADD> struct EpiGate {
    const bf16_t* GATE; const bf16_t* PREV; bf16_t* O;
    __device__ __forceinline__ void operator()(const f32x4 (&acc)[2][2][4][2], const Unit& u, int wr, int wc, int fr, int fq) const {
        const int row0 = u.pm * 256 + wr * 64 + fr, col0 = u.pn * 256 + wc * 32 + 8 * fq;
#pragma unroll
        for (int ai = 0; ai < 2; ++ai)
#pragma unroll
            for (int m = 0; m < 4; ++m) { const size_t ro = (size_t)(row0 + ai * 128 + m * 16) * DM + col0;
#pragma unroll
                for (int bj = 0; bj < 2; ++bj) { const size_t idx = ro + bj * 128;
                    f32x4 g0, g1; unpack8(*(const u32x4*)(GATE + idx), g0, g1);
                    f32x4 v0 = g0 * acc[ai][bj][m][0], v1 = g1 * acc[ai][bj][m][1];
                    if (ADD) { f32x4 p0, p1; unpack8(*(const u32x4*)(PREV + idx), p0, p1); v0 += p0; v1 += p1; }
                    *(u32x4*)(O + idx) = pack8(v0, v1); } }
    }
};
template <bool WBF> struct EpiRes {
    const float* X; float* H; bf16_t* HBF; float* ssq;
    __device__ __forceinline__ void operator()(const f32x4 (&acc)[2][2][4][2], const Unit& u, int wr, int wc, int fr, int fq) const {
        const int row0 = u.pm * 256 + wr * 64 + fr, col0 = u.pn * 256 + wc * 32 + 8 * fq;
#pragma unroll
        for (int ai = 0; ai < 2; ++ai)
#pragma unroll
            for (int m = 0; m < 4; ++m) { const int row = row0 + ai * 128 + m * 16; const size_t ro = (size_t)row * DM + col0; float s = 0.f;
#pragma unroll
                for (int bj = 0; bj < 2; ++bj) { const size_t idx = ro + bj * 128;
                    f32x4 h0 = *(const f32x4*)(X + idx) + acc[ai][bj][m][0], h1 = *(const f32x4*)(X + idx + 4) + acc[ai][bj][m][1];
                    *(f32x4*)(H + idx) = h0; *(f32x4*)(H + idx + 4) = h1;
                    if (WBF) *(u32x4*)(HBF + idx) = pack8(h0, h1);
#pragma unroll
                    for (int j = 0; j < 4; ++j) s += h0[j] * h0[j] + h1[j] * h1[j]; }
                s += __shfl_xor(s, 16); s += __shfl_xor(s, 32);
                if (fq == 0) atomicAdd(ssq + row, s); }
    }
};
struct EpiSwiglu {
    const float* ssq; bf16_t* ACT;
    __device__ __forceinline__ void operator()(const f32x4 (&acc)[2][2][4][2], const Unit& u, int wr, int wc, int fr, int fq) const {
        const int row0 = u.pm * 256 + wr * 64 + fr, ch0 = u.pn * 128 + wc * 32 + 8 * fq;
#pragma unroll
        for (int ai = 0; ai < 2; ++ai)
#pragma unroll
            for (int m = 0; m < 4; ++m) { const int row = row0 + ai * 128 + m * 16; const float r = rsqrtf(ssq[row] * (1.0f / DM) + EPS);
                f32x4 v0, v1;
#pragma unroll
                for (int j = 0; j < 4; ++j) { v0[j] = siluf_(acc[ai][0][m][0][j] * r) * (acc[ai][1][m][0][j] * r); v1[j] = siluf_(acc[ai][0][m][1][j] * r) * (acc[ai][1][m][1][j] * r); }
                *(u32x4*)(ACT + (size_t)row * DFF + ch0) = pack8(v0, v1); }
    }
};

__device__ __forceinline__ int slot2lc(int slot) { return (slot & ~31) + pg8::perm32(slot & 31); }
__device__ __forceinline__ void conv_tile(LAS float* tile, const float* src0, const float* src1, int ldsrc, int nvalid, int K, bf16_t* dst, const float* kscale, int mode, int nt, int kt) {
    const int tid = threadIdx.x;
    { const int j = tid & 63, i0 = tid >> 6; const int nrow = nt * 64 + j, t256 = nrow >> 8, lc = slot2lc(nrow & 255);
      const float* s; int col; bool valid;
      if (mode == 0) { col = t256 * 256 + lc; s = src0; valid = col < nvalid; } else { col = t256 * 128 + (lc & 127); s = (lc >> 7) ? src1 : src0; valid = true; }
#pragma unroll
      for (int ii = 0; ii < 8; ++ii) { const int kl = i0 + 8 * ii, k = kt * 64 + kl; float v = valid ? s[(size_t)k * ldsrc + col] : 0.f; if (kscale) v *= kscale[k]; tile[j * 65 + kl] = v; } }
    __syncthreads();
    { const int kk = (tid & 31) * 2, j0 = tid >> 5;
#pragma unroll
      for (int it = 0; it < 4; ++it) { const int j = j0 + 16 * it; *(unsigned*)(dst + (size_t)(nt * 64 + j) * K + kt * 64 + kk) = pk2(tile[j * 65 + kk], tile[j * 65 + kk + 1]); } }
    __syncthreads();
}

__device__ __forceinline__ void phase_prep(const Params& p, LAS unsigned char* lds) {
    LAS float* tile = (LAS float*)lds; unsigned char* ws = p.ws;
    constexpr int N0 = 324 * 32, N1 = N0 + 32 * 32, N2 = N1 + 32 * 64, N3 = N2 + 32 * 32, N4 = N3 + 176 * 32, N5 = N4 + 32 * 88;
    for (int it = blockIdx.x; it < N5; it += gridDim.x) {
        if (it < N0)      { const int i = it;      conv_tile(tile, p.w_in, nullptr, IN_COLS, IN_COLS, DM, (bf16_t*)(ws + OFF_WIN), nullptr, 0, i / 32, i % 32); }
        else if (it < N1) { const int i = it - N0; conv_tile(tile, p.w_out_a, nullptr, DM, DM, DM, (bf16_t*)(ws + OFF_WOA), nullptr, 0, i / 32, i % 32); }
        else if (it < N2) { const int i = it - N1; conv_tile(tile, p.w_out_ssm, nullptr, DM, DM, DI, (bf16_t*)(ws + OFF_WOS), nullptr, 0, i / 64, i % 64); }
        else if (it < N3) { const int i = it - N2; conv_tile(tile, p.w_o, nullptr, DM, DM, DM, (bf16_t*)(ws + OFF_WO), nullptr, 0, i / 32, i % 32); }
        else if (it < N4) { const int i = it - N3; conv_tile(tile, p.w_ffn_gate, p.w_ffn_up, DFF, DFF, DM, (bf16_t*)(ws + OFF_WGU), p.norm_ffn_g, 1, i / 32, i % 32); }
        else              { const int i = it - N4; conv_tile(tile, p.w_ffn_down, nullptr, DM, DM, DFF, (bf16_t*)(ws + OFF_WDN), nullptr, 0, i / 88, i % 88); }
    }
    { float* s1 = (float*)(ws + OFF_SSQ1); for (int i = blockIdx.x * 512 + threadIdx.x; i < 2 * NTOK; i += gridDim.x * 512) s1[i] = 0.f; }
    { const int wave = threadIdx.x >> 6, lane = threadIdx.x & 63; bf16_t* U = (bf16_t*)(ws + OFF_U);
      for (int row = blockIdx.x * 8 + wave; row < NTOK; row += gridDim.x * 8) {
          const f32x4* xr = (const f32x4*)(p.x + (size_t)row * DM); f32x4 v[8]; float ss = 0.f;
#pragma unroll
          for (int i = 0; i < 8; ++i) { v[i] = xr[lane + 64 * i]; ss += v[i][0] * v[i][0] + v[i][1] * v[i][1] + v[i][2] * v[i][2] + v[i][3] * v[i][3]; }
#pragma unroll
          for (int o = 32; o >= 1; o >>= 1) ss += __shfl_xor(ss, o);
          const float r = rsqrtf(ss * (1.0f / DM) + EPS);
#pragma unroll
          for (int i = 0; i < 8; ++i) { const f32x4 gg = ((const f32x4*)p.norm_mix_g)[lane + 64 * i]; u32x2 w; w.x = pk2(v[i][0] * r * gg[0], v[i][1] * r * gg[1]); w.y = pk2(v[i][2] * r * gg[2], v[i][3] * r * gg[3]);
              *(u32x2*)(U + (size_t)row * DM + (lane + 64 * i) * 4) = w; } } }
}

__device__ __forceinline__ void phase_ssmconv(const Params& p) {
    const bf16_t* XBC = (const bf16_t*)(p.ws + OFF_XBC); bf16_t* XS = (bf16_t*)p.out; bf16_t* BCS = (bf16_t*)(p.ws + OFF_BCS);
    const size_t total = (size_t)NTOK * 768;
    for (size_t idx = (size_t)blockIdx.x * 512 + threadIdx.x; idx < total; idx += (size_t)gridDim.x * 512) {
        const int t = (int)(idx / 768), c = (int)(idx % 768) * 8, tl = t & (SEQ - 1);
        f32x4 a0 = *(const f32x4*)(p.ssm_conv_b + c), a1 = *(const f32x4*)(p.ssm_conv_b + c + 4);
#pragma unroll
        for (int j = 0; j < 4; ++j) { if (tl - 3 + j >= 0) { f32x4 r0, r1; unpack8(*(const u32x4*)(XBC + (size_t)(t - 3 + j) * CONVD + c), r0, r1);
                a0 += *(const f32x4*)(p.ssm_conv_w + j * CONVD + c) * r0; a1 += *(const f32x4*)(p.ssm_conv_w + j * CONVD + c + 4) * r1; } }
#pragma unroll
        for (int j = 0; j < 4; ++j) { a0[j] = siluf_(a0[j]); a1[j] = siluf_(a1[j]); }
        if (c < DI) *(u32x4*)(XS + (size_t)t * DI + c) = pack8(a0, a1); else *(u32x4*)(BCS + (size_t)t * 2048 + (c - DI)) = pack8(a0, a1);
    }
}

__device__ __forceinline__ void phase_ssd_seq(const Params& p, LAS unsigned char* lds) {
    LAS float* part = (LAS float*)lds;
    const int tid = threadIdx.x, pp = tid >> 3, ng = tid & 7, wave = tid >> 6, lane = tid & 63;
    const bf16_t* XS = (const bf16_t*)p.out; const bf16_t* BCS = (const bf16_t*)(p.ws + OFF_BCS); bf16_t* ZS = (bf16_t*)(p.ws + OFF_ZS);
    const float* DT = (const float*)(p.ws + OFF_DT); float* SSQH = (float*)(p.ws + OFF_SSQH);
    for (int item = blockIdx.x; item < 256; item += gridDim.x) {
        const int b = item >> 6, h = item & 63, g = h >> 3;
        const float a = -__expf(p.a_log[h]), Dk = p.d_skip[h];
        const bf16_t* xs = XS + (size_t)b * SEQ * DI + h * 64 + pp;
        const bf16_t* Bs = BCS + (size_t)b * SEQ * 2048 + g * 128 + ng * 16;
        const bf16_t* Cs = Bs + 1024;
        bf16_t* zs = ZS + (size_t)b * SEQ * DI + h * 64 + pp;
        const float* dt = DT + (size_t)b * SEQ * NH + h;
        float st[16];
#pragma unroll
        for (int i = 0; i < 16; ++i) st[i] = 0.f;
        for (int t0 = 0; t0 < SEQ; t0 += 64) {
#pragma unroll 4
            for (int tt = 0; tt < 64; ++tt) {
                const int t = t0 + tt;
                const float dtv = dt[(size_t)t * NH], xv = bf2f(xs[(size_t)t * DI]), zv = bf2f(zs[(size_t)t * DI]);
                f32x4 B0, B1, B2, B3, C0, C1, C2, C3;
                unpack8(*(const u32x4*)(Bs + (size_t)t * 2048), B0, B1); unpack8(*(const u32x4*)(Bs + (size_t)t * 2048 + 8), B2, B3);
                unpack8(*(const u32x4*)(Cs + (size_t)t * 2048), C0, C1); unpack8(*(const u32x4*)(Cs + (size_t)t * 2048 + 8), C2, C3);
                const float dA = __expf(dtv * a), xdt = xv * dtv; float y = 0.f;
#pragma unroll
                for (int i = 0; i < 4; ++i) {
                    st[i] = dA * st[i] + xdt * B0[i]; y += C0[i] * st[i];
                    st[4 + i] = dA * st[4 + i] + xdt * B1[i]; y += C1[i] * st[4 + i];
                    st[8 + i] = dA * st[8 + i] + xdt * B2[i]; y += C2[i] * st[8 + i];
                    st[12 + i] = dA * st[12 + i] + xdt * B3[i]; y += C3[i] * st[12 + i]; }
                y += __shfl_xor(y, 1); y += __shfl_xor(y, 2); y += __shfl_xor(y, 4);
                y += Dk * xv;
                const float yz = y * zv;
                if (ng == 0) zs[(size_t)t * DI] = (bf16_t)f2bf(yz);
                float sq = (ng == 0) ? yz * yz : 0.f;
                sq += __shfl_xor(sq, 8); sq += __shfl_xor(sq, 16); sq += __shfl_xor(sq, 32);
                if (lane == 0) part[tt * 8 + wave] = sq;
            }
            __syncthreads();
            if (tid < 64) { float s = 0.f;
#pragma unroll
                for (int w = 0; w < 8; ++w) s += part[tid * 8 + w];
                SSQH[(size_t)(b * SEQ + t0 + tid) * NH + h] = s; }
            __syncthreads();
        }
    }
}

__device__ __forceinline__ void phase_gnorm(const Params& p) {
    bf16_t* ZS = (bf16_t*)(p.ws + OFF_ZS); const float* SSQH = (const float*)(p.ws + OFF_SSQH);
    const size_t total = (size_t)NTOK * 512;
    for (size_t idx = (size_t)blockIdx.x * 512 + threadIdx.x; idx < total; idx += (size_t)gridDim.x * 512) {
        const int t = (int)(idx >> 9), cg8 = (int)(idx & 511), c = cg8 * 8, g = cg8 >> 6;
        const f32x4 s0 = *(const f32x4*)(SSQH + (size_t)t * NH + g * 8), s1 = *(const f32x4*)(SSQH + (size_t)t * NH + g * 8 + 4);
        const float ss = s0[0] + s0[1] + s0[2] + s0[3] + s1[0] + s1[1] + s1[2] + s1[3];
        const float r = rsqrtf(ss * (1.0f / 512.0f) + EPS);
        f32x4 v0, v1; unpack8(*(const u32x4*)(ZS + (size_t)t * DI + c), v0, v1);
        v0 = v0 * r * *(const f32x4*)(p.ssm_norm_g + c); v1 = v1 * r * *(const f32x4*)(p.ssm_norm_g + c + 4);
        *(u32x4*)(ZS + (size_t)t * DI + c) = pack8(v0, v1);
    }
}

__device__ __forceinline__ void phase_mixa(const Params& p) {
    const bf16_t* BB = (const bf16_t*)(p.ws + OFF_BB); const bf16_t* BC = (const bf16_t*)(p.ws + OFF_BC); const bf16_t* BH = (const bf16_t*)(p.ws + OFF_BH); bf16_t* YA = (bf16_t*)(p.ws + OFF_U);
    const size_t total = (size_t)NTOK * 256;
    for (size_t idx = (size_t)blockIdx.x * 512 + threadIdx.x; idx < total; idx += (size_t)gridDim.x * 512) {
        const int t = (int)(idx >> 8), c = (int)(idx & 255) * 8, tl = t & (SEQ - 1);
        f32x4 a0 = {0.f, 0.f, 0.f, 0.f}, a1 = {0.f, 0.f, 0.f, 0.f};
#pragma unroll
        for (int j = 0; j < 3; ++j) { if (tl - 2 + j >= 0) { const size_t o = (size_t)(t - 2 + j) * DM + c; f32x4 c0, c1, h0, h1; unpack8(*(const u32x4*)(BC + o), c0, c1); unpack8(*(const u32x4*)(BH + o), h0, h1);
                a0 += *(const f32x4*)(p.conv_a_w + j * DM + c) * (c0 * h0); a1 += *(const f32x4*)(p.conv_a_w + j * DM + c + 4) * (c1 * h1); } }
        f32x4 b0, b1; unpack8(*(const u32x4*)(BB + (size_t)t * DM + c), b0, b1);
        *(u32x4*)(YA + (size_t)t * DM + c) = pack8(a0 * b0, a1 * b1);
    }
}

__device__ __forceinline__ void phase_final(const Params& p) {
    const float* SSQ2 = (const float*)(p.ws + OFF_SSQ2);
    const size_t total = (size_t)NTOK * 512;
    for (size_t idx = (size_t)blockIdx.x * 512 + threadIdx.x; idx < total; idx += (size_t)gridDim.x * 512) {
        const int t = (int)(idx >> 9), c = (int)(idx & 511) * 4;
        const float r = rsqrtf(SSQ2[t] * (1.0f / DM) + EPS);
        f32x4 v = *(const f32x4*)(p.out + (size_t)t * DM + c);
        *(f32x4*)(p.out + (size_t)t * DM + c) = v * r * *(const f32x4*)(p.norm_final_g + c);
    }
}

constexpr int NPHASE = 11;
template <int PH> __device__ __forceinline__ void run_phase(const Params& p, LAS unsigned char* lds) {
    unsigned char* ws = p.ws;
    pg8::StaticOrder S; pg8::Gemm g;
    if constexpr (PH == 0) { phase_prep(p, lds); }
    else if constexpr (PH == 1) {
        g.A = (const bf16_t*)(ws + OFF_U); g.Bt = (const bf16_t*)(ws + OFF_WIN) + (size_t)40 * 256 * DM; g.M = NTOK; g.N = 41 * 256; g.K = DM; S.init(g.M, g.N, gridDim.x, blockIdx.x);
        EpiRoute E{(bf16_t*)p.out, (bf16_t*)p.out + (size_t)NTOK * DM, (bf16_t*)(ws + OFF_BB), (bf16_t*)(ws + OFF_BC), (bf16_t*)(ws + OFF_BH), (bf16_t*)(ws + OFF_ZS), (bf16_t*)(ws + OFF_XBC), (float*)(ws + OFF_DT), p.dt_bias, 40};
        pg8::gemm_phase(lds, g, S, E); }
    else if constexpr (PH == 2) { phase_ssmconv(p); }
    else if constexpr (PH == 3) { phase_ssd_seq(p, lds); }
    else if constexpr (PH == 4) {
        g.A = (const bf16_t*)(ws + OFF_U); g.Bt = (const bf16_t*)(ws + OFF_WIN); g.M = NTOK; g.N = 40 * 256; g.K = DM; S.init(g.M, g.N, gridDim.x, blockIdx.x);
        EpiRoute E{(bf16_t*)p.out, (bf16_t*)p.out + (size_t)NTOK * DM, (bf16_t*)(ws + OFF_BB), (bf16_t*)(ws + OFF_BC), (bf16_t*)(ws + OFF_BH), (bf16_t*)(ws + OFF_ZS), (bf16_t*)(ws + OFF_XBC), (float*)(ws + OFF_DT), p.dt_bias, 0};
        pg8::gemm_phase(lds, g, S, E);
        phase_gnorm(p); }
    else if constexpr (PH == 5) { phase_mixa(p); }
    else if constexpr (PH == 6) {
        g.A = (const bf16_t*)(ws + OFF_U); g.Bt = (const bf16_t*)(ws + OFF_WOA); g.M = NTOK; g.N = DM; g.K = DM; S.init(g.M, g.N, gridDim.x, blockIdx.x);
        EpiGate<false> Ea{(const bf16_t*)p.out, nullptr, (bf16_t*)(ws + OFF_BB)};
        pg8::gemm_phase(lds, g, S, Ea);
        g.A = (const bf16_t*)(ws + OFF_ZS); g.Bt = (const bf16_t*)(ws + OFF_WOS); g.K = DI;
        EpiGate<true> Eb{(const bf16_t*)p.out + (size_t)NTOK * DM, (const bf16_t*)(ws + OFF_BB), (bf16_t*)(ws + OFF_BC)};
        pg8::gemm_phase(lds, g, S, Eb); }
    else if constexpr (PH == 7) {
        g.A = (const bf16_t*)(ws + OFF_BC); g.Bt = (const bf16_t*)(ws + OFF_WO); g.M = NTOK; g.N = DM; g.K = DM; S.init(g.M, g.N, gridDim.x, blockIdx.x);
        EpiRes<true> E{p.x, p.out, (bf16_t*)(ws + OFF_BH), (float*)(ws + OFF_SSQ1)};
        pg8::gemm_phase(lds, g, S, E); }
    else if constexpr (PH == 8) {
        g.A = (const bf16_t*)(ws + OFF_BH); g.Bt = (const bf16_t*)(ws + OFF_WGU); g.M = NTOK; g.N = 2 * DFF; g.K = DM; S.init(g.M, g.N, gridDim.x, blockIdx.x);
        EpiSwiglu E{(const float*)(ws + OFF_SSQ1), (bf16_t*)(ws + OFF_ZS)};
        pg8::gemm_phase(lds, g, S, E); }
    else if constexpr (PH == 9) {
        g.A = (const bf16_t*)(ws + OFF_ZS); g.Bt = (const bf16_t*)(ws + OFF_WDN); g.M = NTOK; g.N = DM; g.K = DFF; S.init(g.M, g.N, gridDim.x, blockIdx.x);
        EpiRes<false> E{p.out, p.out, nullptr, (float*)(ws + OFF_SSQ2)};
        pg8::gemm_phase(lds, g, S, E); }
    else if constexpr (PH == 10) { phase_final(p); }
}

template <int PH> __global__ void __launch_bounds__(512, 2) k_one(Params p) {
    extern __shared__ __attribute__((aligned(16))) unsigned char lds_raw[];
    run_phase<PH>(p, (LAS unsigned char*)lds_raw);
}

__global__ void __launch_bounds__(512, 2) k_mega(Params p) {
    extern __shared__ __attribute__((aligned(16))) unsigned char lds_raw[];
    LAS unsigned char* lds = (LAS unsigned char*)lds_raw;
    cg::grid_group grid = cg::this_grid();
    run_phase<0>(p, lds); grid.sync();
    run_phase<1>(p, lds); grid.sync();
    run_phase<2>(p, lds); grid.sync();
    run_phase<3>(p, lds); grid.sync();
    run_phase<4>(p, lds); grid.sync();
    run_phase<5>(p, lds); grid.sync();
    run_phase<6>(p, lds); grid.sync();
    run_phase<7>(p, lds); grid.sync();
    run_phase<8>(p, lds); grid.sync();
    run_phase<9>(p, lds); grid.sync();
    run_phase<10>(p, lds);
}

constexpr int LDS_BYTES = pg8::STAGE_BYTES;

template <int PH> static void launch_one(const Params& p, int grid, hipStream_t stream) {
    static bool attr = false;
    if (!attr) { (void)hipFuncSetAttribute((const void*)k_one<PH>, hipFuncAttributeMaxDynamicSharedMemorySize, LDS_BYTES); attr = true; }
    hipLaunchKernelGGL(k_one<PH>, dim3(grid), dim3(512), LDS_BYTES, stream, p);
}

extern "C" void kernel_launch(void* const* d_in, const int* in_sizes, int n_in, void* d_out, int out_size, void* d_ws, size_t ws_size, hipStream_t stream) {
    static int grid = 0;
    if (grid == 0) {
        if (n_in != 18 || out_size != NTOK * DM || ws_size < WS_END) { fprintf(stderr, "kernel_launch: unexpected shapes: n_in %d out %d ws %zu (need %zu)\n", n_in, out_size, ws_size, (size_t)WS_END); grid = -1; return; }
        int dev = 0, cus = 0, per_cu = 0;
        (void)hipGetDevice(&dev); (void)hipDeviceGetAttribute(&cus, hipDeviceAttributeMultiprocessorCount, dev);
        (void)hipFuncSetAttribute((const void*)k_mega, hipFuncAttributeMaxDynamicSharedMemorySize, LDS_BYTES);
        (void)hipOccupancyMaxActiveBlocksPerMultiprocessor(&per_cu, (const void*)k_mega, 512, LDS_BYTES);
        if (per_cu < 1) { fprintf(stderr, "kernel_launch: occupancy query says %d blocks per CU\n", per_cu); per_cu = 1; }
        (void)hipGetLastError();
        grid = cus * per_cu;
        fprintf(stderr, "kernel_launch: cus %d per_cu %d grid %d ws %zu\n", cus, per_cu, grid, ws_size);
    }
    if (grid < 0) return;
    Params p{};
    const float** pp = (const float**)&p;
    for (int i = 0; i < 18; ++i) pp[i] = (const float*)d_in[i];
    p.out = (float*)d_out; p.ws = (unsigned char*)d_ws;
#if MEGA
    void* args[] = {&p};
    hipError_t e = hipLaunchCooperativeKernel((const void*)k_mega, dim3(grid), dim3(512), args, LDS_BYTES, stream);
    if (e != hipSuccess) fprintf(stderr, "cooperative launch failed: %s (grid %d)\n", hipGetErrorString(e), grid);
#else
    launch_one<0>(p, grid, stream); launch_one<1>(p, grid, stream); launch_one<2>(p, grid, stream); launch_one<3>(p, grid, stream); launch_one<4>(p, grid, stream); launch_one<5>(p, grid, stream);
    launch_one<6>(p, grid, stream); launch_one<7>(p, grid, stream); launch_one<8>(p, grid, stream); launch_one<9>(p, grid, stream); launch_one<10>(p, grid, stream);
#endif
}
```

```cpp
#include <hip/hip_runtime.h>
#include <hip/hip_cooperative_groups.h>
#include <cstdio>
namespace cg = cooperative_groups;

#ifndef MEGA
#define MEGA 1
#endif

#define LAS __attribute__((address_space(3)))
typedef unsigned short bf16_t;
typedef short bf16x8 __attribute__((ext_vector_type(8)));
typedef float f32x4 __attribute__((ext_vector_type(4)));
typedef unsigned u32x4 __attribute__((ext_vector_type(4)));
typedef unsigned u32x2 __attribute__((ext_vector_type(2)));

constexpr int DM = 2048, NTOK = 16384, SEQ = 4096;
constexpr int IN_COLS = 20544, IN_TILES = 81;
constexpr int DI = 4096, NH = 64, HD = 64, NG = 8, NST = 128, CONVD = 6144;
constexpr int DFF = 5632;
constexpr float EPS = 1e-6f;

constexpr size_t MiB = 1024ull * 1024ull;
constexpr size_t OFF_WIN = 0;
constexpr size_t OFF_WOA = 81 * MiB;
constexpr size_t OFF_WOS = 89 * MiB;
constexpr size_t OFF_WO  = 105 * MiB;
constexpr size_t OFF_WGU = 113 * MiB;
constexpr size_t OFF_WDN = 157 * MiB;
constexpr size_t OFF_ZS  = 179 * MiB;
constexpr size_t OFF_U   = 307 * MiB;
constexpr size_t OFF_XBC = 371 * MiB;
constexpr size_t OFF_BB  = 371 * MiB, OFF_BC = 435 * MiB, OFF_BH = 499 * MiB;
constexpr size_t OFF_DT  = 563 * MiB;
constexpr size_t OFF_SSQH = 567 * MiB;
constexpr size_t OFF_SSQ1 = 571 * MiB;
constexpr size_t OFF_SSQ2 = 571 * MiB + 65536;
constexpr size_t OFF_BCS = 572 * MiB;
constexpr size_t WS_END = 636 * MiB;

struct Params {
    const float *x, *norm_mix_g, *w_in, *conv_a_w, *w_out_a, *ssm_conv_w, *ssm_conv_b, *dt_bias, *a_log, *d_skip, *ssm_norm_g, *w_out_ssm, *w_o, *norm_ffn_g, *w_ffn_gate, *w_ffn_up,
        *w_ffn_down, *norm_final_g;
    float* out; unsigned char* ws;
};

__device__ __forceinline__ unsigned f2bf(float f) { unsigned u = __builtin_bit_cast(unsigned, f); return (u + 0x7fffu + ((u >> 16) & 1u)) >> 16; }
__device__ __forceinline__ unsigned pk2(float lo, float hi) { return f2bf(lo) | (f2bf(hi) << 16); }
__device__ __forceinline__ float bflo(unsigned w) { return __builtin_bit_cast(float, w << 16); }
__device__ __forceinline__ float bfhi(unsigned w) { return __builtin_bit_cast(float, w & 0xffff0000u); }
__device__ __forceinline__ float bf2f(bf16_t v) { return __builtin_bit_cast(float, ((unsigned)v) << 16); }
__device__ __forceinline__ float sigmoidf_(float v) { return __builtin_amdgcn_rcpf(1.0f + __expf(-v)); }
__device__ __forceinline__ float siluf_(float v) { return v * sigmoidf_(v); }
__device__ __forceinline__ float softplusf_(float v) { return fmaxf(v, 0.f) + log1pf(__expf(-fabsf(v))); }
__device__ __forceinline__ u32x4 pack8(const f32x4& a, const f32x4& b) { u32x4 w; w.x = pk2(a[0], a[1]); w.y = pk2(a[2], a[3]); w.z = pk2(b[0], b[1]); w.w = pk2(b[2], b[3]); return w; }
__device__ __forceinline__ void unpack8(const u32x4& w, f32x4& a, f32x4& b) { a[0] = bflo(w.x); a[1] = bfhi(w.x); a[2] = bflo(w.y); a[3] = bfhi(w.y); b[0] = bflo(w.z); b[1] = bfhi(w.z); b[2] = bflo(w.w); b[3] = bfhi(w.w); }

namespace pg8 {
constexpr int BM = 256, BK = 64, HALF = 128, HTB = HALF * BK * 2, STAGE_BYTES = 8 * HTB, NXCD = 8, WGM = 8;
__host__ __device__ __forceinline__ int lds_byte(int r, int c) { const int st = (r >> 4) * 2 + (c >> 5), rr = r & 15, cc = c & 31, ob = rr * 64 + cc * 2; return st * 1024 + (ob ^ (((ob >> 9) & 1) << 5)); }
__host__ __device__ __forceinline__ void stage_rc(int b, int& R, int& C) { const int st = b / 1024, sb = b % 1024, swz = sb ^ (((sb >> 9) & 1) << 5); R = (st >> 1) * 16 + swz / 64; C = (st & 1) * 32 + (swz % 64) / 2; }
__host__ __device__ __forceinline__ int perm32(int rho) { const int n = rho >> 4, i = rho & 15; return 8 * (i >> 2) + 4 * n + (i & 3); }
struct Unit { int pm, pn; };
struct Gemm { const bf16_t* A; const bf16_t* Bt; int M, N, K; };
struct StaticOrder {
    int nM, nN, nwg, G, c;
    __host__ __device__ void init(int M, int N, int G_, int c_) { nM = M / BM; nN = N / BM; nwg = nM * nN; G = G_; c = c_; }
    __host__ __device__ bool next(int i, Unit& u) const {
        const long L = (long)i * G + c; if (L >= nwg) return false;
        int wgid = (int)L; { const int q = nwg / NXCD, r = nwg % NXCD, xcd = wgid % NXCD, off = wgid / NXCD; wgid = (xcd < r ? xcd * (q + 1) : r * (q + 1) + (xcd - r) * q) + off; }
        const int nig = WGM * nN, gid = wgid / nig, fm = gid * WGM, gsz = (nM - fm) < WGM ? (nM - fm) : WGM;
        u.pm = fm + ((wgid % nig) % gsz); u.pn = (wgid % nig) / gsz; return true;
    }
};

template <class Epi>
__device__ __forceinline__ void gemm_phase(LAS unsigned char* lds, const Gemm g, const StaticOrder& S, const Epi& E) {
    const int tid = threadIdx.x, wid = __builtin_amdgcn_readfirstlane(tid >> 6), lane = tid & 63, wr = wid >> 2, wc = wid & 3, fr = lane & 15, fq = lane >> 4;
    const int K = g.K, nt = K / BK;
    unsigned voffA[2];
#pragma unroll
    for (int i = 0; i < 2; ++i) { int R, C; stage_rc(tid * 16 + i * 8192, R, C); voffA[i] = (unsigned)(R * K + C) * 2u; }
    const size_t kstep = (size_t)(BK * 2);
    const size_t hstep = (size_t)HALF * K * 2;
    const size_t tstep = 2 * hstep;
    const unsigned ldsw = (unsigned)wid * 1024u;
    const int aoff = lds_byte(wr * 64 + fr, fq * 8), boff = lds_byte(wc * 32 + fr, fq * 8);
#define PG8_SA(b, h) (((b) * 2 + (h)) * HTB)
#define PG8_SB(b, h) ((4 + (b) * 2 + (h)) * HTB)
#define PG8_STAGE(bufoff, gbase, voff) do { _Pragma("unroll") for (int _i = 0; _i < 2; ++_i) \
        __builtin_amdgcn_global_load_lds((const unsigned*)((const char*)(gbase) + (voff)[_i]), (LAS unsigned*)(lds + (bufoff) + ldsw + _i * 8192), 16, 0, 0); } while (0)
#define PG8_LDA(dst, b, h) do { _Pragma("unroll") for (int m = 0; m < 4; ++m) _Pragma("unroll") for (int k = 0; k < 2; ++k) dst[m][k] = *(const LAS bf16x8*)(lds + PG8_SA(b, h) + aoff + m * 2048 + k * 1024); } while (0)
#define PG8_LDB(dst, b, h) do { _Pragma("unroll") for (int n = 0; n < 2; ++n) _Pragma("unroll") for (int k = 0; k < 2; ++k) dst[n][k] = *(const LAS bf16x8*)(lds + PG8_SB(b, h) + boff + n * 2048 + k * 1024); } while (0)
#define PG8_MMA(ai, bj, At, Bt) do { __builtin_amdgcn_s_setprio(1); _Pragma("unroll") for (int m = 0; m < 4; ++m) _Pragma("unroll") for (int n = 0; n < 2; ++n) _Pragma("unroll") for (int k = 0; k < 2; ++k) \
        acc[ai][bj][m][n] = __builtin_amdgcn_mfma_f32_16x16x32_bf16(Bt[n][k], At[m][k], acc[ai][bj][m][n], 0, 0, 0); __builtin_amdgcn_s_setprio(0); } while (0)
#define PG8_WAIT_V(n) asm volatile("s_waitcnt vmcnt(" #n ")" ::: "memory")
#define PG8_WAIT_L(n) asm volatile("s_waitcnt lgkmcnt(" #n ")" ::: "memory")
#define PG8_BAR __builtin_amdgcn_s_barrier()
#define PG8_SCHED __builtin_amdgcn_sched_barrier(0)
    Unit cur, nxt; int ui = 0;
    if (!S.next(0, cur)) return;
    f32x4 acc[2][2][4][2];
#pragma unroll
    for (int a = 0; a < 2; ++a)
#pragma unroll
        for (int b = 0; b < 2; ++b)
#pragma unroll
            for (int m = 0; m < 4; ++m)
#pragma unroll
                for (int n = 0; n < 2; ++n) acc[a][b][m][n] = (f32x4){0.f, 0.f, 0.f, 0.f};
    bf16x8 At[4][2], B0[2][2], B1[2][2];
    const char* cA = (const char*)g.A + (size_t)cur.pm * tstep; const char* cB = (const char*)g.Bt + (size_t)cur.pn * tstep;
    PG8_STAGE(PG8_SB(0, 0), cB, voffA); PG8_STAGE(PG8_SA(0, 0), cA, voffA); PG8_STAGE(PG8_SB(0, 1), cB + hstep, voffA); PG8_STAGE(PG8_SA(0, 1), cA + hstep, voffA);
    if (wr == 1) PG8_BAR;
    PG8_WAIT_V(4); PG8_BAR;
    PG8_STAGE(PG8_SB(1, 0), cB + kstep, voffA); PG8_STAGE(PG8_SA(1, 0), cA + kstep, voffA); PG8_STAGE(PG8_SB(1, 1), cB + hstep + kstep, voffA);
    PG8_WAIT_V(6); PG8_BAR;
    for (;;) {
        const bool has_next = S.next(ui + 1, nxt);
        const char* nA = has_next ? (const char*)g.A + (size_t)nxt.pm * tstep : cA; const char* nB = has_next ? (const char*)g.Bt + (size_t)nxt.pn * tstep : cB;
        for (int t = 0; t < nt; t += 2) {
            const bool last = (t == nt - 2);
            const char* a1 = cA + (size_t)(t + 1) * kstep;
            const char* a2 = last ? nA : cA + (size_t)(t + 2) * kstep; const char* b2 = last ? nB : cB + (size_t)(t + 2) * kstep;
            const char* a3 = a2 + kstep; const char* b3 = b2 + kstep;
            PG8_LDB(B0, 0, 0); PG8_SCHED; PG8_LDA(At, 0, 0); PG8_STAGE(PG8_SA(1, 1), a1 + hstep, voffA);
            PG8_WAIT_L(8); PG8_BAR; PG8_WAIT_L(0); PG8_MMA(0, 0, At, B0); PG8_BAR; PG8_SCHED;
            PG8_LDB(B1, 0, 1); PG8_STAGE(PG8_SB(0, 0), b2, voffA);
            PG8_BAR; PG8_WAIT_L(0); PG8_MMA(0, 1, At, B1); PG8_BAR;
            PG8_LDA(At, 0, 1); PG8_STAGE(PG8_SA(0, 0), a2, voffA);
            PG8_BAR; PG8_WAIT_L(0); PG8_MMA(1, 0, At, B0); PG8_BAR; PG8_SCHED;
            PG8_STAGE(PG8_SB(0, 1), b2 + hstep, voffA);
            PG8_WAIT_V(6); PG8_BAR; PG8_MMA(1, 1, At, B1); PG8_BAR;
            PG8_LDB(B0, 1, 0); PG8_SCHED; PG8_LDA(At, 1, 0); PG8_STAGE(PG8_SA(0, 1), a2 + hstep, voffA);
            PG8_WAIT_L(8); PG8_BAR; PG8_WAIT_L(0); PG8_MMA(0, 0, At, B0); PG8_BAR; PG8_SCHED;
            PG8_LDB(B1, 1, 1); PG8_STAGE(PG8_SB(1, 0), b3, voffA);
            PG8_BAR; PG8_WAIT_L(0); PG8_MMA(0, 1, At, B1); PG8_BAR;
            PG8_LDA(At, 1, 1); PG8_STAGE(PG8_SA(1, 0), a3, voffA);
            PG8_BAR; PG8_WAIT_L(0); PG8_MMA(1, 0, At, B0); PG8_BAR; PG8_SCHED;
            PG8_STAGE(PG8_SB(1, 1), b3 + hstep, voffA);
            PG8_WAIT_V(6); PG8_BAR; PG8_MMA(1, 1, At, B1); PG8_BAR;
        }
        E(acc, cur, wr, wc, fr, fq);
        if (!has_next) break;
#pragma unroll
        for (int a = 0; a < 2; ++a)
#pragma unroll
            for (int b = 0; b < 2; ++b)
#pragma unroll
                for (int m = 0; m < 4; ++m)
#pragma unroll
                    for (int n = 0; n < 2; ++n) acc[a][b][m][n] = (f32x4){0.f, 0.f, 0.f, 0.f};
        cur = nxt; cA = nA; cB = nB; ++ui;
    }
    PG8_WAIT_V(0);
    if (wr == 0) PG8_BAR;
    PG8_BAR;
#undef PG8_SA
#undef PG8_SB
#undef PG8_STAGE
#undef PG8_LDA
#undef PG8_LDB
#undef PG8_MMA
#undef PG8_WAIT_V
#undef PG8_WAIT_L
#undef PG8_BAR
#undef PG8_SCHED
}
}
using pg8::Unit;

struct EpiRoute {
    bf16_t *GA, *GB, *BB, *BC, *BH, *ZS, *XBC; float* DT; const float* dt_bias; int tile0;
    __device__ __forceinline__ void operator()(const f32x4 (&acc)[2][2][4][2], const Unit& u, int wr, int wc, int fr, int fq) const {
        const int gt = u.pn + tile0; const int row0 = u.pm * 256 + wr * 64 + fr;
        if (gt < 80) {
            bf16_t* base; int ldc, cb, act;
            if (gt < 40) { const int r = gt >> 3; base = (r == 0 ? GA : r == 1 ? GB : r == 2 ? BB : r == 3 ? BC : BH); ldc = DM; cb = (gt & 7) * 256; act = r < 2 ? 1 : 0; }
            else if (gt < 56) { base = ZS; ldc = DI; cb = (gt - 40) * 256; act = 2; }
            else { base = XBC; ldc = CONVD; cb = (gt - 56) * 256; act = 0; }
            const int col0 = cb + wc * 32 + 8 * fq;
#pragma unroll
            for (int ai = 0; ai < 2; ++ai)
#pragma unroll
                for (int m = 0; m < 4; ++m) { bf16_t* rowp = base + (size_t)(row0 + ai * 128 + m * 16) * ldc + col0;
#pragma unroll
                    for (int bj = 0; bj < 2; ++bj) { f32x4 v0 = acc[ai][bj][m][0], v1 = acc[ai][bj][m][1];
                        if (act == 1) {
#pragma unroll
                            for (int j = 0; j < 4; ++j) { v0[j] = sigmoidf_(v0[j]); v1[j] = sigmoidf_(v1[j]); } }
                        else if (act == 2) {
#pragma unroll
                            for (int j = 0; j < 4; ++j) { v0[j] = siluf_(v0[j]); v1[j] = siluf_(v1[j]); } }
                        *(u32x4*)(rowp + bj * 128) = pack8(v0, v1); } }
        } else if (wc < 2) {
            const int c0 = wc * 32 + 8 * fq;
            f32x4 b0 = *(const f32x4*)(dt_bias + c0), b1 = *(const f32x4*)(dt_bias + c0 + 4);
#pragma unroll
            for (int ai = 0; ai < 2; ++ai)
#pragma unroll
                for (int m = 0; m < 4; ++m) { float* rowp = DT + (size_t)(row0 + ai * 128 + m * 16) * NH + c0;
                    f32x4 v0 = acc[ai][0][m][0] + b0, v1 = acc[ai][0][m][1] + b1;
#pragma unroll
                    for (int j = 0; j < 4; ++j) { v0[j] = softplusf_(v0[j]); v1[j] = softplusf_(v1[j]); }
                    *(f32x4*)rowp = v0; *(f32x4*)(rowp + 4) = v1; }
        }
    }
};
template <bool ADD> struct EpiGate {
    const bf16_t* GATE; const bf16_t* PREV; bf16_t* O;
    __device__ __forceinline__ void operator()(const f32x4 (&acc)[2][2][4][2], const Unit& u, int wr, int wc, int fr, int fq) const {
        const int row0 = u.pm * 256 + wr * 64 + fr, col0 = u.pn * 256 + wc * 32 + 8 * fq;
#pragma unroll
        for (int ai = 0; ai < 2; ++ai)
#pragma unroll
            for (int m = 0; m < 4; ++m) { const size_t ro = (size_t)(row0 + ai * 128 + m * 16) * DM + col0;
#pragma unroll
                for (int bj = 0; bj < 2; ++bj) { const size_t idx = ro + bj * 128;
                    f32x4 g0, g1; unpack8(*(const u32x4*)(GATE + idx), g0, g1);
                    f32x4 v0 = g0 * acc[ai][bj][m][0], v1 = g1 * acc[ai][bj][m][1];
                    if (ADD) { f32x4 p0, p1; unpack8(*(const u32x4*)(PREV + idx), p0, p1); v0 += p0; v1 += p1; }
                    *(u32x4*)(O + idx) = pack8(v0, v1); } }
    }
};
template <bool WBF> struct EpiRes {
    const float* X; float* H; bf16_t* HBF; float* ssq;
    __device__ __forceinline__ void operator()(const f32x4 (&acc)[2][2][4][2], const Unit& u, int wr, int wc, int fr, int fq) const {
        const int row0 = u.pm * 256 + wr * 64 + fr, col0 = u.pn * 256 + wc * 32 + 8 * fq;
#pragma unroll
        for (int ai = 0; ai < 2; ++ai)
#pragma unroll
            for (int m = 0; m < 4; ++m) { const int row = row0 + ai * 128 + m * 16; const size_t ro = (size_t)row * DM + col0; float s = 0.f;
#pragma unroll
                for (int bj = 0; bj < 2; ++bj) { const size_t idx = ro + bj * 128;
                    f32x4 h0 = *(const f32x4*)(X + idx) + acc[ai][bj][m][0], h1 = *(const f32x4*)(X + idx + 4) + acc[ai][bj][m][1];
                    *(f32x4*)(H + idx) = h0; *(f32x4*)(H + idx + 4) = h1;
                    if (WBF) *(u32x4*)(HBF + idx) = pack8(h0, h1);
#pragma unroll
                    for (int j = 0; j < 4; ++j) s += h0[j] * h0[j] + h1[j] * h1[j]; }
                s += __shfl_xor(s, 16); s += __shfl_xor(s, 32);
                if (fq == 0) atomicAdd(ssq + row, s); }
    }
};
struct EpiSwiglu {
    const float* ssq; bf16_t* ACT;
    __device__ __forceinline__ void operator()(const f32x4 (&acc)[2][2][4][2], const Unit& u, int wr, int wc, int fr, int fq) const {
        const int row0 = u.pm * 256 + wr * 64 + fr, ch0 = u.pn * 128 + wc * 32 + 8 * fq;
#pragma unroll
        for (int ai = 0; ai < 2; ++ai)
#pragma unroll
            for (int m = 0; m < 4; ++m) { const int row = row0 + ai * 128 + m * 16; const float r = rsqrtf(ssq[row] * (1.0f / DM) + EPS);
                f32x4 v0, v1;
#pragma unroll
                for (int j = 0; j < 4; ++j) { v0[j] = siluf_(acc[ai][0][m][0][j] * r) * (acc[ai][1][m][0][j] * r); v1[j] = siluf_(acc[ai][0][m][1][j] * r) * (acc[ai][1][m][1][j] * r); }
                *(u32x4*)(ACT + (size_t)row * DFF + ch0) = pack8(v0, v1); }
    }
};

__device__ __forceinline__ int slot2lc(int slot) { return (slot & ~31) + pg8::perm32(slot & 31); }
__device__ __forceinline__ void conv_tile(LAS float* tile, const float* src0, const float* src1, int ldsrc, int nvalid, int K, bf16_t* dst, const float* kscale, int mode, int nt, int kt) {
    const int tid = threadIdx.x;
    { const int j = tid & 63, i0 = tid >> 6; const int nrow = nt * 64 + j, t256 = nrow >> 8, lc = slot2lc(nrow & 255);
      const float* s; int col; bool valid;
      if (mode == 0) { col = t256 * 256 + lc; s = src0; valid = col < nvalid; } else { col = t256 * 128 + (lc & 127); s = (lc >> 7) ? src1 : src0; valid = true; }
#pragma unroll
      for (int ii = 0; ii < 8; ++ii) { const int kl = i0 + 8 * ii, k = kt * 64 + kl; float v = valid ? s[(size_t)k * ldsrc + col] : 0.f; if (kscale) v *= kscale[k]; tile[j * 65 + kl] = v; } }
    __syncthreads();
    { const int kk = (tid & 31) * 2, j0 = tid >> 5;
#pragma unroll
      for (int it = 0; it < 4; ++it) { const int j = j0 + 16 * it; *(unsigned*)(dst + (size_t)(nt * 64 + j) * K + kt * 64 + kk) = pk2(tile[j * 65 + kk], tile[j * 65 + kk + 1]); } }
    __syncthreads();
}

__device__ __forceinline__ void phase_prep(const Params& p, LAS unsigned char* lds) {
    LAS float* tile = (LAS float*)lds; unsigned char* ws = p.ws;
    constexpr int N0 = 324 * 32, N1 = N0 + 32 * 32, N2 = N1 + 32 * 64, N3 = N2 + 32 * 32, N4 = N3 + 176 * 32, N5 = N4 + 32 * 88;
    for (int it = blockIdx.x; it < N5; it += gridDim.x) {
        if (it < N0)      { const int i = it;      conv_tile(tile, p.w_in, nullptr, IN_COLS, IN_COLS, DM, (bf16_t*)(ws + OFF_WIN), nullptr, 0, i / 32, i % 32); }
        else if (it < N1) { const int i = it - N0; conv_tile(tile, p.w_out_a, nullptr, DM, DM, DM, (bf16_t*)(ws + OFF_WOA), nullptr, 0, i / 32, i % 32); }
        else if (it < N2) { const int i = it - N1; conv_tile(tile, p.w_out_ssm, nullptr, DM, DM, DI, (bf16_t*)(ws + OFF_WOS), nullptr, 0, i / 64, i % 64); }
        else if (it < N3) { const int i = it - N2; conv_tile(tile, p.w_o, nullptr, DM, DM, DM, (bf16_t*)(ws + OFF_WO), nullptr, 0, i / 32, i % 32); }
        else if (it < N4) { const int i = it - N3; conv_tile(tile, p.w_ffn_gate, p.w_ffn_up, DFF, DFF, DM, (bf16_t*)(ws + OFF_WGU), p.norm_ffn_g, 1, i / 32, i % 32); }
        else              { const int i = it - N4; conv_tile(tile, p.w_ffn_down, nullptr, DM, DM, DFF, (bf16_t*)(ws + OFF_WDN), nullptr, 0, i / 88, i % 88); }
    }
    { float* s1 = (float*)(ws + OFF_SSQ1); for (int i = blockIdx.x * 512 + threadIdx.x; i < 2 * NTOK; i += gridDim.x * 512) s1[i] = 0.f; }
    { const int wave = threadIdx.x >> 6, lane = threadIdx.x & 63; bf16_t* U = (bf16_t*)(ws + OFF_U);
      for (int row = blockIdx.x * 8 + wave; row < NTOK; row += gridDim.x * 8) {
          const f32x4* xr = (const f32x4*)(p.x + (size_t)row * DM); f32x4 v[8]; float ss = 0.f;
#pragma unroll
          for (int i = 0; i < 8; ++i) { v[i] = xr[lane + 64 * i]; ss += v[i][0] * v[i][0] + v[i][1] * v[i][1] + v[i][2] * v[i][2] + v[i][3] * v[i][3]; }
#pragma unroll
          for (int o = 32; o >= 1; o >>= 1) ss += __shfl_xor(ss, o);
          const float r = rsqrtf(ss * (1.0f / DM) + EPS);
#pragma unroll
          for (int i = 0; i < 8; ++i) { const f32x4 gg = ((const f32x4*)p.norm_mix_g)[lane + 64 * i]; u32x2 w; w.x = pk2(v[i][0] * r * gg[0], v[i][1] * r * gg[1]); w.y = pk2(v[i][2] * r * gg[2], v[i][3] * r * gg[3]);
              *(u32x2*)(U + (size_t)row * DM + (lane + 64 * i) * 4) = w; } } }
}

__device__ __forceinline__ void phase_ssmconv(const Params& p) {
    const bf16_t* XBC = (const bf16_t*)(p.ws + OFF_XBC); bf16_t* XS = (bf16_t*)p.out; bf16_t* BCS = (bf16_t*)(p.ws + OFF_BCS);
    const size_t total = (size_t)NTOK * 768;
    for (size_t idx = (size_t)blockIdx.x * 512 + threadIdx.x; idx < total; idx += (size_t)gridDim.x * 512) {
        const int t = (int)(idx / 768), c = (int)(idx % 768) * 8, tl = t & (SEQ - 1);
        f32x4 a0 = *(const f32x4*)(p.ssm_conv_b + c), a1 = *(const f32x4*)(p.ssm_conv_b + c + 4);
#pragma unroll
        for (int j = 0; j < 4; ++j) { if (tl - 3 + j >= 0) { f32x4 r0, r1; unpack8(*(const u32x4*)(XBC + (size_t)(t - 3 + j) * CONVD + c), r0, r1);
                a0 += *(const f32x4*)(p.ssm_conv_w + j * CONVD + c) * r0; a1 += *(const f32x4*)(p.ssm_conv_w + j * CONVD + c + 4) * r1; } }
#pragma unroll
        for (int j = 0; j < 4; ++j) { a0[j] = siluf_(a0[j]); a1[j] = siluf_(a1[j]); }
        if (c < DI) *(u32x4*)(XS + (size_t)t * DI + c) = pack8(a0, a1); else *(u32x4*)(BCS + (size_t)t * 2048 + (c - DI)) = pack8(a0, a1);
    }
}

__device__ __forceinline__ void phase_ssd_seq(const Params& p, LAS unsigned char* lds) {
    LAS float* part = (LAS float*)lds;
    const int tid = threadIdx.x, pp = tid >> 3, ng = tid & 7, wave = tid >> 6, lane = tid & 63;
    const bf16_t* XS = (const bf16_t*)p.out; const bf16_t* BCS = (const bf16_t*)(p.ws + OFF_BCS); bf16_t* ZS = (bf16_t*)(p.ws + OFF_ZS);
    const float* DT = (const float*)(p.ws + OFF_DT); float* SSQH = (float*)(p.ws + OFF_SSQH);
    for (int item = blockIdx.x; item < 256; item += gridDim.x) {
        const int b = item >> 6, h = item & 63, g = h >> 3;
        const float a = -__expf(p.a_log[h]), Dk = p.d_skip[h];
        const bf16_t* xs = XS + (size_t)b * SEQ * DI + h * 64 + pp;
        const bf16_t* Bs = BCS + (size_t)b * SEQ * 2048 + g * 128 + ng * 16;
        const bf16_t* Cs = Bs + 1024;
        bf16_t* zs = ZS + (size_t)b * SEQ * DI + h * 64 + pp;
        const float* dt = DT + (size_t)b * SEQ * NH + h;
        float st[16];
#pragma unroll
        for (int i = 0; i < 16; ++i) st[i] = 0.f;
        for (int t0 = 0; t0 < SEQ; t0 += 64) {
#pragma unroll 4
            for (int tt = 0; tt < 64; ++tt) {
                const int t = t0 + tt;
                const float dtv = dt[(size_t)t * NH], xv = bf2f(xs[(size_t)t * DI]), zv = bf2f(zs[(size_t)t * DI]);
                f32x4 B0, B1, B2, B3, C0, C1, C2, C3;
                unpack8(*(const u32x4*)(Bs + (size_t)t * 2048), B0, B1); unpack8(*(const u32x4*)(Bs + (size_t)t * 2048 + 8), B2, B3);
                unpack8(*(const u32x4*)(Cs + (size_t)t * 2048), C0, C1); unpack8(*(const u32x4*)(Cs + (size_t)t * 2048 + 8), C2, C3);
                const float dA = __expf(dtv * a), xdt = xv * dtv; float y = 0.f;
#pragma unroll
                for (int i = 0; i < 4; ++i) {
                    st[i] = dA * st[i] + xdt * B0[i]; y += C0[i] * st[i];
                    st[4 + i] = dA * st[4 + i] + xdt * B1[i]; y += C1[i] * st[4 + i];
                    st[8 + i] = dA * st[8 + i] + xdt * B2[i]; y += C2[i] * st[8 + i];
                    st[12 + i] = dA * st[12 + i] + xdt * B3[i]; y += C3[i] * st[12 + i]; }
                y += __shfl_xor(y, 1); y += __shfl_xor(y, 2); y += __shfl_xor(y, 4);
                y += Dk * xv;
                const float yz = y * zv;
                if (ng == 0) zs[(size_t)t * DI] = (bf16_t)f2bf(yz);
                float sq = (ng == 0) ? yz * yz : 0.f;
                sq += __shfl_xor(sq, 8); sq += __shfl_xor(sq, 16); sq += __shfl_xor(sq, 32);
                if (lane == 0) part[tt * 8 + wave] = sq;
            }
            __syncthreads();
            if (tid < 64) { float s = 0.f;
#pragma unroll
                for (int w = 0; w < 8; ++w) s += part[tid * 8 + w];
                SSQH[(size_t)(b * SEQ + t0 + tid) * NH + h] = s; }
            __syncthreads();
        }
    }
}

typedef short s16x4 __attribute__((ext_vector_type(4)));
constexpr int SS_RSB = 272, SS_RSX = 144;
constexpr int SS_C = 0, SS_B = 34816, SS_X = 69632, SS_XW = 88064, SS_S = 106496, SS_SC = 123904;
__device__ __forceinline__ bf16x8 tr_frag(LAS unsigned char* lds, int addr, int step) {
    const s16x4 lo = __builtin_amdgcn_ds_read_tr16_b64_v4i16((LAS s16x4*)(lds + addr));
    const s16x4 hi = __builtin_amdgcn_ds_read_tr16_b64_v4i16((LAS s16x4*)(lds + addr + step));
    return __builtin_shufflevector(lo, hi, 0, 1, 2, 3, 4, 5, 6, 7);
}
#define MFMA16(a, b, c) __builtin_amdgcn_mfma_f32_16x16x32_bf16(a, b, c, 0, 0, 0)
__device__ __forceinline__ void phase_ssd_chunk(const Params& p, LAS unsigned char* lds) {
    const int tid = threadIdx.x, w = __builtin_amdgcn_readfirstlane(tid >> 6), lane = tid & 63, fr = lane & 15, g4 = lane >> 4, q = fr >> 2, pq = fr & 3;
    const bf16_t* XS = (const bf16_t*)p.out; const bf16_t* BCS = (const bf16_t*)(p.ws + OFF_BCS); bf16_t* ZS = (bf16_t*)(p.ws + OFF_ZS);
    const float* DT = (const float*)(p.ws + OFF_DT); float* SSQH = (float*)(p.ws + OFF_SSQH);
    LAS float* csA = (LAS float*)(lds + SS_SC); LAS float* dtA = csA + 128;
    for (int item = blockIdx.x; item < 256; item += gridDim.x) {
        const int b = item >> 6, h = item & 63, grp = h >> 3;
        const float a = -__expf(p.a_log[h]), Dk = p.d_skip[h];
        f32x4 accS[4];
#pragma unroll
        for (int i = 0; i < 4; ++i) accS[i] = (f32x4){0.f, 0.f, 0.f, 0.f};
        for (int i = tid; i < 64 * SS_RSB / 16; i += 512) *(LAS u32x4*)(lds + SS_S + i * 16) = (u32x4){0u, 0u, 0u, 0u};
        for (int c = 0; c < 32; ++c) {
            const int tok0 = b * SEQ + c * 128;
            if (w == 0) {
                const float d0 = DT[(size_t)(tok0 + lane) * NH + h], d1 = DT[(size_t)(tok0 + 64 + lane) * NH + h];
                float s0 = d0 * a, s1 = d1 * a;
#pragma unroll
                for (int o = 1; o < 64; o <<= 1) { const float t0 = __shfl_up(s0, o), t1 = __shfl_up(s1, o); if (lane >= o) { s0 += t0; s1 += t1; } }
                s1 += __shfl(s0, 63);
                csA[lane] = s0; csA[64 + lane] = s1; dtA[lane] = d0; dtA[64 + lane] = d1;
            }
            u32x4 xr[2];
#pragma unroll
            for (int i = 0; i < 4; ++i) { const int idx = tid + 512 * i, row = idx >> 4, ch = idx & 15; const bf16_t* src = BCS + (size_t)(tok0 + row) * 2048 + grp * 128 + ch * 8;
                const u32x4 vb = *(const u32x4*)src, vc = *(const u32x4*)(src + 1024);
                *(LAS u32x4*)(lds + SS_B + row * SS_RSB + ch * 16) = vb; *(LAS u32x4*)(lds + SS_C + row * SS_RSB + ch * 16) = vc; }
#pragma unroll
            for (int i = 0; i < 2; ++i) { const int idx = tid + 512 * i, row = idx >> 3, ch = idx & 7; xr[i] = *(const u32x4*)(XS + (size_t)(tok0 + row) * DI + h * 64 + ch * 8);
                *(LAS u32x4*)(lds + SS_X + row * SS_RSX + ch * 16) = xr[i]; }
            __syncthreads();
            const float csend = csA[127];
#pragma unroll
            for (int i = 0; i < 2; ++i) { const int idx = tid + 512 * i, row = idx >> 3, ch = idx & 7; const float wl = __expf(csend - csA[row]) * dtA[row];
                f32x4 v0, v1; unpack8(xr[i], v0, v1); v0 *= wl; v1 *= wl; *(LAS u32x4*)(lds + SS_XW + row * SS_RSX + ch * 16) = pack8(v0, v1); }
            __syncthreads();
            const int l = 16 * w + fr;
            bf16x8 cf[4];
#pragma unroll
            for (int ks = 0; ks < 4; ++ks) cf[ks] = *(const LAS bf16x8*)(lds + SS_C + l * SS_RSB + (4 * ks + g4) * 16);
            f32x4 acc1[8], accY[4];
#pragma unroll
            for (int st = 0; st < 8; ++st) { acc1[st] = (f32x4){0.f, 0.f, 0.f, 0.f};
#pragma unroll
                for (int ks = 0; ks < 4; ++ks) { const bf16x8 bf = *(const LAS bf16x8*)(lds + SS_B + (16 * st + fr) * SS_RSB + (4 * ks + g4) * 16); acc1[st] = MFMA16(bf, cf[ks], acc1[st]); } }
#pragma unroll
            for (int pt = 0; pt < 4; ++pt) { accY[pt] = (f32x4){0.f, 0.f, 0.f, 0.f};
#pragma unroll
                for (int ks = 0; ks < 4; ++ks) { const bf16x8 sf = *(const LAS bf16x8*)(lds + SS_S + (16 * pt + fr) * SS_RSB + (4 * ks + g4) * 16); accY[pt] = MFMA16(sf, cf[ks], accY[pt]); } }
            { const float dec = __expf(csend);
#pragma unroll
              for (int pt = 0; pt < 4; ++pt) accS[pt] *= dec;
#pragma unroll
              for (int ks = 0; ks < 4; ++ks) { const bf16x8 btf = tr_frag(lds, SS_B + (32 * ks + 8 * g4 + q) * SS_RSB + (16 * w + 4 * pq) * 2, 4 * SS_RSB);
#pragma unroll
                  for (int pt = 0; pt < 4; ++pt) { const bf16x8 xwf = tr_frag(lds, SS_XW + (32 * ks + 8 * g4 + q) * SS_RSX + (16 * pt + 4 * pq) * 2, 4 * SS_RSX); accS[pt] = MFMA16(btf, xwf, accS[pt]); } } }
            __syncthreads();
            const float csl = csA[l];
#pragma unroll
            for (int st = 0; st < 8; ++st) { const f32x4 cs4 = *(const LAS f32x4*)(csA + 16 * st + 4 * g4), dt4 = *(const LAS f32x4*)(dtA + 16 * st + 4 * g4); float v[4];
#pragma unroll
                for (int r = 0; r < 4; ++r) { const int s = 16 * st + 4 * g4 + r; v[r] = (s <= l) ? acc1[st][r] * __expf(fminf(csl - cs4[r], 0.f)) * dt4[r] : 0.f; }
                u32x2 pk; pk.x = pk2(v[0], v[1]); pk.y = pk2(v[2], v[3]); *(LAS u32x2*)(lds + SS_C + l * SS_RSB + (16 * st + 4 * g4) * 2) = pk; }
#pragma unroll
            for (int pt = 0; pt < 4; ++pt) { u32x2 pk; pk.x = pk2(accS[pt][0], accS[pt][1]); pk.y = pk2(accS[pt][2], accS[pt][3]); *(LAS u32x2*)(lds + SS_S + (16 * pt + fr) * SS_RSB + (16 * w + 4 * g4) * 2) = pk; }
            __syncthreads();
            { const float el = __expf(csl);
#pragma unroll
              for (int pt = 0; pt < 4; ++pt) accY[pt] *= el; }
#pragma unroll
            for (int ks = 0; ks < 4; ++ks) { const bf16x8 mf = *(const LAS bf16x8*)(lds + SS_C + l * SS_RSB + (4 * ks + g4) * 16);
#pragma unroll
                for (int pt = 0; pt < 4; ++pt) { const bf16x8 xf = tr_frag(lds, SS_X + (32 * ks + 8 * g4 + q) * SS_RSX + (16 * pt + 4 * pq) * 2, 4 * SS_RSX); accY[pt] = MFMA16(xf, mf, accY[pt]); } }
            { float sq = 0.f; const size_t tok = (size_t)(tok0 + l);
#pragma unroll
              for (int pt = 0; pt < 4; ++pt) { const u32x2 x2 = *(const LAS u32x2*)(lds + SS_X + l * SS_RSX + (16 * pt + 4 * g4) * 2); bf16_t* zp = ZS + tok * DI + h * 64 + 16 * pt + 4 * g4; const u32x2 z2 = *(const u32x2*)zp;
                  const float y0 = (accY[pt][0] + Dk * bflo(x2.x)) * bflo(z2.x), y1 = (accY[pt][1] + Dk * bfhi(x2.x)) * bfhi(z2.x), y2 = (accY[pt][2] + Dk * bflo(x2.y)) * bflo(z2.y), y3 = (accY[pt][3] + Dk * bfhi(x2.y)) * bfhi(z2.y);
                  sq += y0 * y0 + y1 * y1 + y2 * y2 + y3 * y3; u32x2 o; o.x = pk2(y0, y1); o.y = pk2(y2, y3); *(u32x2*)zp = o; }
              sq += __shfl_xor(sq, 16); sq += __shfl_xor(sq, 32);
              if (g4 == 0) SSQH[tok * NH + h] = sq; }
            __syncthreads();
        }
    }
}

__device__ __forceinline__ void phase_gnorm(const Params& p) {
    bf16_t* ZS = (bf16_t*)(p.ws + OFF_ZS); const float* SSQH = (const float*)(p.ws + OFF_SSQH);
    const size_t total = (size_t)NTOK * 512;
    for (size_t idx = (size_t)blockIdx.x * 512 + threadIdx.x; idx < total; idx += (size_t)gridDim.x * 512) {
        const int t = (int)(idx >> 9), cg8 = (int)(idx & 511), c = cg8 * 8, g = cg8 >> 6;
        const f32x4 s0 = *(const f32x4*)(SSQH + (size_t)t * NH + g * 8), s1 = *(const f32x4*)(SSQH + (size_t)t * NH + g * 8 + 4);
        const float ss = s0[0] + s0[1] + s0[2] + s0[3] + s1[0] + s1[1] + s1[2] + s1[3];
        const float r = rsqrtf(ss * (1.0f / 512.0f) + EPS);
        f32x4 v0, v1; unpack8(*(const u32x4*)(ZS + (size_t)t * DI + c), v0, v1);
        v0 = v0 * r * *(const f32x4*)(p.ssm_norm_g + c); v1 = v1 * r * *(const f32x4*)(p.ssm_norm_g + c + 4);
        *(u32x4*)(ZS + (size_t)t * DI + c) = pack8(v0, v1);
    }
}

__device__ __forceinline__ void phase_mixa(const Params& p) {
    const bf16_t* BB = (const bf16_t*)(p.ws + OFF_BB); const bf16_t* BC = (const bf16_t*)(p.ws + OFF_BC); const bf16_t* BH = (const bf16_t*)(p.ws + OFF_BH); bf16_t* YA = (bf16_t*)(p.ws + OFF_U);
    const size_t total = (size_t)NTOK * 256;
    for (size_t idx = (size_t)blockIdx.x * 512 + threadIdx.x; idx < total; idx += (size_t)gridDim.x * 512) {
        const int t = (int)(idx >> 8), c = (int)(idx & 255) * 8, tl = t & (SEQ - 1);
        f32x4 a0 = {0.f, 0.f, 0.f, 0.f}, a1 = {0.f, 0.f, 0.f, 0.f};
#pragma unroll
        for (int j = 0; j < 3; ++j) { if (tl - 2 + j >= 0) { const size_t o = (size_t)(t - 2 + j) * DM + c; f32x4 c0, c1, h0, h1; unpack8(*(const u32x4*)(BC + o), c0, c1); unpack8(*(const u32x4*)(BH + o), h0, h1);
                a0 += *(const f32x4*)(p.conv_a_w + j * DM + c) * (c0 * h0); a1 += *(const f32x4*)(p.conv_a_w + j * DM + c + 4) * (c1 * h1); } }
        f32x4 b0, b1; unpack8(*(const u32x4*)(BB + (size_t)t * DM + c), b0, b1);
        *(u32x4*)(YA + (size_t)t * DM + c) = pack8(a0 * b0, a1 * b1);
    }
}

__device__ __forceinline__ void phase_final(const Params& p) {
    const float* SSQ2 = (const float*)(p.ws + OFF_SSQ2);
    const size_t total = (size_t)NTOK * 512;
    for (size_t idx = (size_t)blockIdx.x * 512 + threadIdx.x; idx < total; idx += (size_t)gridDim.x * 512) {
        const int t = (int)(idx >> 9), c = (int)(idx & 511) * 4;
        const float r = rsqrtf(SSQ2[t] * (1.0f / DM) + EPS);
        f32x4 v = *(const f32x4*)(p.out + (size_t)t * DM + c);
        *(f32x4*)(p.out + (size_t)t * DM + c) = v * r * *(const f32x4*)(p.norm_final_g + c);
    }
}

constexpr int NPHASE = 11;
template <int PH> __device__ __forceinline__ void run_phase(const Params& p, LAS unsigned char* lds) {
    unsigned char* ws = p.ws;
    pg8::StaticOrder S; pg8::Gemm g;
    if constexpr (PH == 0) { phase_prep(p, lds); }
    else if constexpr (PH == 1) {
        g.A = (const bf16_t*)(ws + OFF_U); g.Bt = (const bf16_t*)(ws + OFF_WIN) + (size_t)40 * 256 * DM; g.M = NTOK; g.N = 41 * 256; g.K = DM; S.init(g.M, g.N, gridDim.x, blockIdx.x);
        EpiRoute E{(bf16_t*)p.out, (bf16_t*)p.out + (size_t)NTOK * DM, (bf16_t*)(ws + OFF_BB), (bf16_t*)(ws + OFF_BC), (bf16_t*)(ws + OFF_BH), (bf16_t*)(ws + OFF_ZS), (bf16_t*)(ws + OFF_XBC), (float*)(ws + OFF_DT), p.dt_bias, 40};
        pg8::gemm_phase(lds, g, S, E); }
    else if constexpr (PH == 2) { phase_ssmconv(p); }
    else if constexpr (PH == 3) { phase_ssd_chunk(p, lds); }
    else if constexpr (PH == 4) {
        g.A = (const bf16_t*)(ws + OFF_U); g.Bt = (const bf16_t*)(ws + OFF_WIN); g.M = NTOK; g.N = 40 * 256; g.K = DM; S.init(g.M, g.N, gridDim.x, blockIdx.x);
        EpiRoute E{(bf16_t*)p.out, (bf16_t*)p.out + (size_t)NTOK * DM, (bf16_t*)(ws + OFF_BB), (bf16_t*)(ws + OFF_BC), (bf16_t*)(ws + OFF_BH), (bf16_t*)(ws + OFF_ZS), (bf16_t*)(ws + OFF_XBC), (float*)(ws + OFF_DT), p.dt_bias, 0};
        pg8::gemm_phase(lds, g, S, E);
        phase_gnorm(p); }
    else if constexpr (PH == 5) { phase_mixa(p); }
    else if constexpr (PH == 6) {
        g.A = (const bf16_t*)(ws + OFF_U); g.Bt = (const bf16_t*)(ws + OFF_WOA); g.M = NTOK; g.N = DM; g.K = DM; S.init(g.M, g.N, gridDim.x, blockIdx.x);
        EpiGate<false> Ea{(const bf16_t*)p.out, nullptr, (bf16_t*)(ws + OFF_BB)};
        pg8::gemm_phase(lds, g, S, Ea);
        g.A = (const bf16_t*)(ws + OFF_ZS); g.Bt = (const bf16_t*)(ws + OFF_WOS); g.K = DI;
        EpiGate<true> Eb{(const bf16_t*)p.out + (size_t)NTOK * DM, (const bf16_t*)(ws + OFF_BB), (bf16_t*)(ws + OFF_BC)};
        pg8::gemm_phase(lds, g, S, Eb); }
    else if constexpr (PH == 7) {
        g.A = (const bf16_t*)(ws + OFF_BC); g.Bt = (const bf16_t*)(ws + OFF_WO); g.M = NTOK; g.N = DM; g.K = DM; S.init(g.M, g.N, gridDim.x, blockIdx.x);
        EpiRes<true> E{p.x, p.out, (bf16_t*)(ws + OFF_BH), (float*)(ws + OFF_SSQ1)};
        pg8::gemm_phase(lds, g, S, E); }
    else if constexpr (PH == 8) {
        g.A = (const bf16_t*)(ws + OFF_BH); g.Bt = (const bf16_t*)(ws + OFF_WGU); g.M = NTOK; g.N = 2 * DFF; g.K = DM; S.init(g.M, g.N, gridDim.x, blockIdx.x);
        EpiSwiglu E{(const float*)(ws + OFF_SSQ1), (bf16_t*)(ws + OFF_ZS)};
        pg8::gemm_phase(lds, g, S, E); }
    else if constexpr (PH == 9) {
        g.A = (const bf16_t*)(ws + OFF_ZS); g.Bt = (const bf16_t*)(ws + OFF_WDN); g.M = NTOK; g.N = DM; g.K = DFF; S.init(g.M, g.N, gridDim.x, blockIdx.x);
        EpiRes<false> E{p.out, p.out, nullptr, (float*)(ws + OFF_SSQ2)};
        pg8::gemm_phase(lds, g, S, E); }
    else if constexpr (PH == 10) { phase_final(p); }
}

template <int PH> __global__ void __launch_bounds__(512, 2) k_one(Params p) {
    extern __shared__ __attribute__((aligned(16))) unsigned char lds_raw[];
    run_phase<PH>(p, (LAS unsigned char*)lds_raw);
}

__global__ void __launch_bounds__(512, 2) k_mega(Params p) {
    extern __shared__ __attribute__((aligned(16))) unsigned char lds_raw[];
    LAS unsigned char* lds = (LAS unsigned char*)lds_raw;
    cg::grid_group grid = cg::this_grid();
    run_phase<0>(p, lds); grid.sync();
    run_phase<1>(p, lds); grid.sync();
    run_phase<2>(p, lds); grid.sync();
    run_phase<3>(p, lds); grid.sync();
    run_phase<4>(p, lds); grid.sync();
    run_phase<5>(p, lds); grid.sync();
    run_phase<6>(p, lds); grid.sync();
    run_phase<7>(p, lds); grid.sync();
    run_phase<8>(p, lds); grid.sync();
    run_phase<9>(p, lds); grid.sync();
    run_phase<10>(p, lds);
}

constexpr int LDS_BYTES = pg8::STAGE_BYTES;

template <int PH> static void launch_one(const Params& p, int grid, hipStream_t stream) {
    static bool attr = false;
    if (!attr) { (void)hipFuncSetAttribute((const void*)k_one<PH>, hipFuncAttributeMaxDynamicSharedMemorySize, LDS_BYTES); attr = true; }
    hipLaunchKernelGGL(k_one<PH>, dim3(grid), dim3(512), LDS_BYTES, stream, p);
}

extern "C" void kernel_launch(void* const* d_in, const int* in_sizes, int n_in, void* d_out, int out_size, void* d_ws, size_t ws_size, hipStream_t stream) {
    static int grid = 0;
    if (grid == 0) {
        if (n_in != 18 || out_size != NTOK * DM || ws_size < WS_END) { fprintf(stderr, "kernel_launch: unexpected shapes: n_in %d out %d ws %zu (need %zu)\n", n_in, out_size, ws_size, (size_t)WS_END); grid = -1; return; }
        int dev = 0, cus = 0, per_cu = 0;
        (void)hipGetDevice(&dev); (void)hipDeviceGetAttribute(&cus, hipDeviceAttributeMultiprocessorCount, dev);
        (void)hipFuncSetAttribute((const void*)k_mega, hipFuncAttributeMaxDynamicSharedMemorySize, LDS_BYTES);
        (void)hipOccupancyMaxActiveBlocksPerMultiprocessor(&per_cu, (const void*)k_mega, 512, LDS_BYTES);
        if (per_cu < 1) { fprintf(stderr, "kernel_launch: occupancy query says %d blocks per CU\n", per_cu); per_cu = 1; }
        (void)hipGetLastError();
        grid = cus * per_cu;
        fprintf(stderr, "kernel_launch: cus %d per_cu %d grid %d ws %zu\n", cus, per_cu, grid, ws_size);
    }
    if (grid < 0) return;
    Params p{};
    const float** pp = (const float**)&p;
    for (int i = 0; i < 18; ++i) pp[i] = (const float*)d_in[i];
    p.out = (float*)d_out; p.ws = (unsigned char*)d_ws;
#if MEGA
    void* args[] = {&p};
    hipError_t e = hipLaunchCooperativeKernel((const void*)k_mega, dim3(grid), dim3(512), args, LDS_BYTES, stream);
    if (e != hipSuccess) fprintf(stderr, "cooperative launch failed: %s (grid %d)\n", hipGetErrorString(e), grid);
#else
    launch_one<0>(p, grid, stream); launch_one<1>(p, grid, stream); launch_one<2>(p, grid, stream); launch_one<3>(p, grid, stream); launch_one<4>(p, grid, stream); launch_one<5>(p, grid, stream);
    launch_one<6>(p, grid, stream); launch_one<7>(p, grid, stream); launch_one<8>(p, grid, stream); launch_one<9>(p, grid, stream); launch_one<10>(p, grid, stream);
#endif
}
```

```cpp
#include <hip/hip_runtime.h>
#include <hip/hip_cooperative_groups.h>
#include <cstdio>
namespace cg = cooperative_groups;

#ifndef MEGA
#define MEGA 1
#endif

#define LAS __attribute__((address_space(3)))
typedef unsigned short bf16_t;
typedef short bf16x8 __attribute__((ext_vector_type(8)));
typedef float f32x4 __attribute__((ext_vector_type(4)));
typedef unsigned u32x4 __attribute__((ext_vector_type(4)));
typedef unsigned u32x2 __attribute__((ext_vector_type(2)));

constexpr int DM = 2048, NTOK = 16384, SEQ = 4096;
constexpr int IN_COLS = 20544, IN_TILES = 81;
constexpr int DI = 4096, NH = 64, HD = 64, NG = 8, NST = 128, CONVD = 6144;
constexpr int DFF = 5632;
constexpr float EPS = 1e-6f;

constexpr size_t MiB = 1024ull * 1024ull;
constexpr size_t OFF_WIN = 0;
constexpr size_t OFF_WOA = 81 * MiB;
constexpr size_t OFF_WOS = 89 * MiB;
constexpr size_t OFF_WO  = 105 * MiB;
constexpr size_t OFF_WGU = 113 * MiB;
constexpr size_t OFF_WDN = 157 * MiB;
constexpr size_t OFF_ZS  = 179 * MiB;
constexpr size_t OFF_U   = 307 * MiB;
constexpr size_t OFF_XBC = 371 * MiB;
constexpr size_t OFF_BB  = 371 * MiB, OFF_BC = 435 * MiB, OFF_BH = 499 * MiB;
constexpr size_t OFF_DT  = 563 * MiB;
constexpr size_t OFF_SSQH = 567 * MiB;
constexpr size_t OFF_SSQ1 = 571 * MiB;
constexpr size_t OFF_SSQ2 = 571 * MiB + 65536;
constexpr size_t OFF_BCS = 572 * MiB;
constexpr size_t WS_END = 636 * MiB;

struct Params {
    const float *x, *norm_mix_g, *w_in, *conv_a_w, *w_out_a, *ssm_conv_w, *ssm_conv_b, *dt_bias, *a_log, *d_skip, *ssm_norm_g, *w_out_ssm, *w_o, *norm_ffn_g, *w_ffn_gate, *w_ffn_up,
        *w_ffn_down, *norm_final_g;
    float* out; unsigned char* ws;
};

__device__ __forceinline__ unsigned f2bf(float f) { unsigned u = __builtin_bit_cast(unsigned, f); return (u + 0x7fffu + ((u >> 16) & 1u)) >> 16; }
__device__ __forceinline__ unsigned pk2(float lo, float hi) { return f2bf(lo) | (f2bf(hi) << 16); }
__device__ __forceinline__ float bflo(unsigned w) { return __builtin_bit_cast(float, w << 16); }
__device__ __forceinline__ float bfhi(unsigned w) { return __builtin_bit_cast(float, w & 0xffff0000u); }
__device__ __forceinline__ float bf2f(bf16_t v) { return __builtin_bit_cast(float, ((unsigned)v) << 16); }
__device__ __forceinline__ float sigmoidf_(float v) { return __builtin_amdgcn_rcpf(1.0f + __expf(-v)); }
__device__ __forceinline__ float siluf_(float v) { return v * sigmoidf_(v); }
__device__ __forceinline__ float softplusf_(float v) { return fmaxf(v, 0.f) + log1pf(__expf(-fabsf(v))); }
__device__ __forceinline__ u32x4 pack8(const f32x4& a, const f32x4& b) { u32x4 w; w.x = pk2(a[0], a[1]); w.y = pk2(a[2], a[3]); w.z = pk2(b[0], b[1]); w.w = pk2(b[2], b[3]); return w; }
__device__ __forceinline__ void unpack8(const u32x4& w, f32x4& a, f32x4& b) { a[0] = bflo(w.x); a[1] = bfhi(w.x); a[2] = bflo(w.y); a[3] = bfhi(w.y); b[0] = bflo(w.z); b[1] = bfhi(w.z); b[2] = bflo(w.w); b[3] = bfhi(w.w); }

namespace pg8 {
constexpr int BM = 256, BK = 64, HALF = 128, HTB = HALF * BK * 2, STAGE_BYTES = 8 * HTB, NXCD = 8, WGM = 8;
__host__ __device__ __forceinline__ int lds_byte(int r, int c) { const int st = (r >> 4) * 2 + (c >> 5), rr = r & 15, cc = c & 31, ob = rr * 64 + cc * 2; return st * 1024 + (ob ^ (((ob >> 9) & 1) << 5)); }
__host__ __device__ __forceinline__ void stage_rc(int b, int& R, int& C) { const int st = b / 1024, sb = b % 1024, swz = sb ^ (((sb >> 9) & 1) << 5); R = (st >> 1) * 16 + swz / 64; C = (st & 1) * 32 + (swz % 64) / 2; }
__host__ __device__ __forceinline__ int perm32(int rho) { const int n = rho >> 4, i = rho & 15; return 8 * (i >> 2) + 4 * n + (i & 3); }
struct Unit { int pm, pn; };
struct Gemm { const bf16_t* A; const bf16_t* Bt; int M, N, K; };
struct StaticOrder {
    int nM, nN, nwg, G, c;
    __host__ __device__ void init(int M, int N, int G_, int c_) { nM = M / BM; nN = N / BM; nwg = nM * nN; G = G_; c = c_; }
    __host__ __device__ bool next(int i, Unit& u) const {
        const long L = (long)i * G + c; if (L >= nwg) return false;
        int wgid = (int)L; { const int q = nwg / NXCD, r = nwg % NXCD, xcd = wgid % NXCD, off = wgid / NXCD; wgid = (xcd < r ? xcd * (q + 1) : r * (q + 1) + (xcd - r) * q) + off; }
        const int nig = WGM * nN, gid = wgid / nig, fm = gid * WGM, gsz = (nM - fm) < WGM ? (nM - fm) : WGM;
        u.pm = fm + ((wgid % nig) % gsz); u.pn = (wgid % nig) / gsz; return true;
    }
};

template <class Epi>
__device__ __forceinline__ void gemm_phase(LAS unsigned char* lds, const Gemm g, const StaticOrder& S, const Epi& E) {
    const int tid = threadIdx.x, wid = __builtin_amdgcn_readfirstlane(tid >> 6), lane = tid & 63, wr = wid >> 2, wc = wid & 3, fr = lane & 15, fq = lane >> 4;
    const int K = g.K, nt = K / BK;
    unsigned voffA[2];
#pragma unroll
    for (int i = 0; i < 2; ++i) { int R, C; stage_rc(tid * 16 + i * 8192, R, C); voffA[i] = (unsigned)(R * K + C) * 2u; }
    const size_t kstep = (size_t)(BK * 2);
    const size_t hstep = (size_t)HALF * K * 2;
    const size_t tstep = 2 * hstep;
    const unsigned ldsw = (unsigned)wid * 1024u;
    const int aoff = lds_byte(wr * 64 + fr, fq * 8), boff = lds_byte(wc * 32 + fr, fq * 8);
#define PG8_SA(b, h) (((b) * 2 + (h)) * HTB)
#define PG8_SB(b, h) ((4 + (b) * 2 + (h)) * HTB)
#define PG8_STAGE(bufoff, gbase, voff) do { _Pragma("unroll") for (int _i = 0; _i < 2; ++_i) \
        __builtin_amdgcn_global_load_lds((const unsigned*)((const char*)(gbase) + (voff)[_i]), (LAS unsigned*)(lds + (bufoff) + ldsw + _i * 8192), 16, 0, 0); } while (0)
#define PG8_LDA(dst, b, h) do { _Pragma("unroll") for (int m = 0; m < 4; ++m) _Pragma("unroll") for (int k = 0; k < 2; ++k) dst[m][k] = *(const LAS bf16x8*)(lds + PG8_SA(b, h) + aoff + m * 2048 + k * 1024); } while (0)
#define PG8_LDB(dst, b, h) do { _Pragma("unroll") for (int n = 0; n < 2; ++n) _Pragma("unroll") for (int k = 0; k < 2; ++k) dst[n][k] = *(const LAS bf16x8*)(lds + PG8_SB(b, h) + boff + n * 2048 + k * 1024); } while (0)
#define PG8_MMA(ai, bj, At, Bt) do { __builtin_amdgcn_s_setprio(1); _Pragma("unroll") for (int m = 0; m < 4; ++m) _Pragma("unroll") for (int n = 0; n < 2; ++n) _Pragma("unroll") for (int k = 0; k < 2; ++k) \
        acc[ai][bj][m][n] = __builtin_amdgcn_mfma_f32_16x16x32_bf16(Bt[n][k], At[m][k], acc[ai][bj][m][n], 0, 0, 0); __builtin_amdgcn_s_setprio(0); } while (0)
#define PG8_WAIT_V(n) asm volatile("s_waitcnt vmcnt(" #n ")" ::: "memory")
#define PG8_WAIT_L(n) asm volatile("s_waitcnt lgkmcnt(" #n ")" ::: "memory")
#define PG8_BAR __builtin_amdgcn_s_barrier()
#define PG8_SCHED __builtin_amdgcn_sched_barrier(0)
    Unit cur, nxt; int ui = 0;
    if (!S.next(0, cur)) return;
    f32x4 acc[2][2][4][2];
#pragma unroll
    for (int a = 0; a < 2; ++a)
#pragma unroll
        for (int b = 0; b < 2; ++b)
#pragma unroll
            for (int m = 0; m < 4; ++m)
#pragma unroll
                for (int n = 0; n < 2; ++n) acc[a][b][m][n] = (f32x4){0.f, 0.f, 0.f, 0.f};
    bf16x8 At[4][2], B0[2][2], B1[2][2];
    const char* cA = (const char*)g.A + (size_t)cur.pm * tstep; const char* cB = (const char*)g.Bt + (size_t)cur.pn * tstep;
    PG8_STAGE(PG8_SB(0, 0), cB, voffA); PG8_STAGE(PG8_SA(0, 0), cA, voffA); PG8_STAGE(PG8_SB(0, 1), cB + hstep, voffA); PG8_STAGE(PG8_SA(0, 1), cA + hstep, voffA);
    if (wr == 1) PG8_BAR;
    PG8_WAIT_V(4); PG8_BAR;
    PG8_STAGE(PG8_SB(1, 0), cB + kstep, voffA); PG8_STAGE(PG8_SA(1, 0), cA + kstep, voffA); PG8_STAGE(PG8_SB(1, 1), cB + hstep + kstep, voffA);
    PG8_WAIT_V(6); PG8_BAR;
    for (;;) {
        const bool has_next = S.next(ui + 1, nxt);
        const char* nA = has_next ? (const char*)g.A + (size_t)nxt.pm * tstep : cA; const char* nB = has_next ? (const char*)g.Bt + (size_t)nxt.pn * tstep : cB;
        for (int t = 0; t < nt; t += 2) {
            const bool last = (t == nt - 2);
            const char* a1 = cA + (size_t)(t + 1) * kstep;
            const char* a2 = last ? nA : cA + (size_t)(t + 2) * kstep; const char* b2 = last ? nB : cB + (size_t)(t + 2) * kstep;
            const char* a3 = a2 + kstep; const char* b3 = b2 + kstep;
            PG8_LDB(B0, 0, 0); PG8_SCHED; PG8_LDA(At, 0, 0); PG8_STAGE(PG8_SA(1, 1), a1 + hstep, voffA);
            PG8_WAIT_L(8); PG8_BAR; PG8_WAIT_L(0); PG8_MMA(0, 0, At, B0); PG8_BAR; PG8_SCHED;
            PG8_LDB(B1, 0, 1); PG8_STAGE(PG8_SB(0, 0), b2, voffA);
            PG8_BAR; PG8_WAIT_L(0); PG8_MMA(0, 1, At, B1); PG8_BAR;
            PG8_LDA(At, 0, 1); PG8_STAGE(PG8_SA(0, 0), a2, voffA);
            PG8_BAR; PG8_WAIT_L(0); PG8_MMA(1, 0, At, B0); PG8_BAR; PG8_SCHED;
            PG8_STAGE(PG8_SB(0, 1), b2 + hstep, voffA);
            PG8_WAIT_V(6); PG8_BAR; PG8_MMA(1, 1, At, B1); PG8_BAR;
            PG8_LDB(B0, 1, 0); PG8_SCHED; PG8_LDA(At, 1, 0); PG8_STAGE(PG8_SA(0, 1), a2 + hstep, voffA);
            PG8_WAIT_L(8); PG8_BAR; PG8_WAIT_L(0); PG8_MMA(0, 0, At, B0); PG8_BAR; PG8_SCHED;
            PG8_LDB(B1, 1, 1); PG8_STAGE(PG8_SB(1, 0), b3, voffA);
            PG8_BAR; PG8_WAIT_L(0); PG8_MMA(0, 1, At, B1); PG8_BAR;
            PG8_LDA(At, 1, 1); PG8_STAGE(PG8_SA(1, 0), a3, voffA);
            PG8_BAR; PG8_WAIT_L(0); PG8_MMA(1, 0, At, B0); PG8_BAR; PG8_SCHED;
            PG8_STAGE(PG8_SB(1, 1), b3 + hstep, voffA);
            PG8_WAIT_V(6); PG8_BAR; PG8_MMA(1, 1, At, B1); PG8_BAR;
        }
        E(acc, cur, wr, wc, fr, fq);
        if (!has_next) break;
#pragma unroll
        for (int a = 0; a < 2; ++a)
#pragma unroll
            for (int b = 0; b < 2; ++b)
#pragma unroll
                for (int m = 0; m < 4; ++m)
#pragma unroll
                    for (int n = 0; n < 2; ++n) acc[a][b][m][n] = (f32x4){0.f, 0.f, 0.f, 0.f};
        cur = nxt; cA = nA; cB = nB; ++ui;
    }
    PG8_WAIT_V(0);
    if (wr == 0) PG8_BAR;
    PG8_BAR;
#undef PG8_SA
#undef PG8_SB
#undef PG8_STAGE
#undef PG8_LDA
#undef PG8_LDB
#undef PG8_MMA
#undef PG8_WAIT_V
#undef PG8_WAIT_L
#undef PG8_BAR
#undef PG8_SCHED
}
}
using pg8::Unit;

struct EpiRoute {
    bf16_t *GA, *GB, *BB, *BC, *BH, *ZS, *XBC; float* DT; const float* dt_bias; int tile0;
    __device__ __forceinline__ void operator()(const f32x4 (&acc)[2][2][4][2], const Unit& u, int wr, int wc, int fr, int fq) const {
        const int gt = u.pn + tile0; const int row0 = u.pm * 256 + wr * 64 + fr;
        if (gt < 80) {
            bf16_t* base; int ldc, cb, act;
            if (gt < 40) { const int r = gt >> 3; base = (r == 0 ? GA : r == 1 ? GB : r == 2 ? BB : r == 3 ? BC : BH); ldc = DM; cb = (gt & 7) * 256; act = r < 2 ? 1 : 0; }
            else if (gt < 56) { base = ZS; ldc = DI; cb = (gt - 40) * 256; act = 2; }
            else { base = XBC; ldc = CONVD; cb = (gt - 56) * 256; act = 0; }
            const int col0 = cb + wc * 32 + 8 * fq;
#pragma unroll
            for (int ai = 0; ai < 2; ++ai)
#pragma unroll
                for (int m = 0; m < 4; ++m) { bf16_t* rowp = base + (size_t)(row0 + ai * 128 + m * 16) * ldc + col0;
#pragma unroll
                    for (int bj = 0; bj < 2; ++bj) { f32x4 v0 = acc[ai][bj][m][0], v1 = acc[ai][bj][m][1];
                        if (act == 1) {
#pragma unroll
                            for (int j = 0; j < 4; ++j) { v0[j] = sigmoidf_(v0[j]); v1[j] = sigmoidf_(v1[j]); } }
                        else if (act == 2) {
#pragma unroll
                            for (int j = 0; j < 4; ++j) { v0[j] = siluf_(v0[j]); v1[j] = siluf_(v1[j]); } }
                        *(u32x4*)(rowp + bj * 128) = pack8(v0, v1); } }
        } else if (wc < 2) {
            const int c0 = wc * 32 + 8 * fq;
            f32x4 b0 = *(const f32x4*)(dt_bias + c0), b1 = *(const f32x4*)(dt_bias + c0 + 4);
#pragma unroll
            for (int ai = 0; ai < 2; ++ai)
#pragma unroll
                for (int m = 0; m < 4; ++m) { float* rowp = DT + (size_t)(row0 + ai * 128 + m * 16) * NH + c0;
                    f32x4 v0 = acc[ai][0][m][0] + b0, v1 = acc[ai][0][m][1] + b1;
#pragma unroll
                    for (int j = 0; j < 4; ++j) { v0[j] = softplusf_(v0[j]); v1[j] = softplusf_(v1[j]); }
                    *(f32x4*)rowp = v0; *(f32x4*)(rowp + 4) = v1; }
        }
    }
};
template <bool ADD> struct EpiGate {
    const bf16_t* GATE; const bf16_t* PREV; bf16_t* O;
    __device__ __forceinline__ void operator()(const f32x4 (&acc)[2][2][4][2], const Unit& u, int wr, int wc, int fr, int fq) const {
        const int row0 = u.pm * 256 + wr * 64 + fr, col0 = u.pn * 256 + wc * 32 + 8 * fq;
#pragma unroll
        for (int ai = 0; ai < 2; ++ai)
#pragma unroll
            for (int m = 0; m < 4; ++m) { const size_t ro = (size_t)(row0 + ai * 128 + m * 16) * DM + col0;
#pragma unroll
                for (int bj = 0; bj < 2; ++bj) { const size_t idx = ro + bj * 128;
                    f32x4 g0, g1; unpack8(*(const u32x4*)(GATE + idx), g0, g1);
                    f32x4 v0 = g0 * acc[ai][bj][m][0], v1 = g1 * acc[ai][bj][m][1];
                    if (ADD) { f32x4 p0, p1; unpack8(*(const u32x4*)(PREV + idx), p0, p1); v0 += p0; v1 += p1; }
                    *(u32x4*)(O + idx) = pack8(v0, v1); } }
    }
};
template <bool WBF> struct EpiRes {
    const float* X; float* H; bf16_t* HBF; float* ssq;
    __device__ __forceinline__ void operator()(const f32x4 (&acc)[2][2][4][2], const Unit& u, int wr, int wc, int fr, int fq) const {
        const int row0 = u.pm * 256 + wr * 64 + fr, col0 = u.pn * 256 + wc * 32 + 8 * fq;
#pragma unroll
        for (int ai = 0; ai < 2; ++ai)
#pragma unroll
            for (int m = 0; m < 4; ++m) { const int row = row0 + ai * 128 + m * 16; const size_t ro = (size_t)row * DM + col0; float s = 0.f;
#pragma unroll
                for (int bj = 0; bj < 2; ++bj) { const size_t idx = ro + bj * 128;
                    f32x4 h0 = *(const f32x4*)(X + idx) + acc[ai][bj][m][0], h1 = *(const f32x4*)(X + idx + 4) + acc[ai][bj][m][1];
                    *(f32x4*)(H + idx) = h0; *(f32x4*)(H + idx + 4) = h1;
                    if (WBF) *(u32x4*)(HBF + idx) = pack8(h0, h1);
#pragma unroll
                    for (int j = 0; j < 4; ++j) s += h0[j] * h0[j] + h1[j] * h1[j]; }
                s += __shfl_xor(s, 16); s += __shfl_xor(s, 32);
                if (fq == 0) atomicAdd(ssq + row, s); }
    }
};
struct EpiSwiglu {
    const float* ssq; bf16_t* ACT;
    __device__ __forceinline__ void operator()(const f32x4 (&acc)[2][2][4][2], const Unit& u, int wr, int wc, int fr, int fq) const {
        const int row0 = u.pm * 256 + wr * 64 + fr, ch0 = u.pn * 128 + wc * 32 + 8 * fq;
#pragma unroll
        for (int ai = 0; ai < 2; ++ai)
#pragma unroll
            for (int m = 0; m < 4; ++m) { const int row = row0 + ai * 128 + m * 16; const float r = rsqrtf(ssq[row] * (1.0f / DM) + EPS);
                f32x4 v0, v1;
#pragma unroll
                for (int j = 0; j < 4; ++j) { v0[j] = siluf_(acc[ai][0][m][0][j] * r) * (acc[ai][1][m][0][j] * r); v1[j] = siluf_(acc[ai][0][m][1][j] * r) * (acc[ai][1][m][1][j] * r); }
                *(u32x4*)(ACT + (size_t)row * DFF + ch0) = pack8(v0, v1); }
    }
};

__device__ __forceinline__ int slot2lc(int slot) { return (slot & ~31) + pg8::perm32(slot & 31); }
__device__ __forceinline__ void conv_tile(LAS float* tile, const float* src0, const float* src1, int ldsrc, int nvalid, int K, bf16_t* dst, const float* kscale, int mode, int nt, int kt) {
    const int tid = threadIdx.x;
    { const int j = tid & 63, i0 = tid >> 6; const int nrow = nt * 64 + j, t256 = nrow >> 8, lc = slot2lc(nrow & 255);
      const float* s; int col; bool valid;
      if (mode == 0) { col = t256 * 256 + lc; s = src0; valid = col < nvalid; } else { col = t256 * 128 + (lc & 127); s = (lc >> 7) ? src1 : src0; valid = true; }
      if (!valid) col = 0;
      const float* sp = s + (size_t)(kt * 256 + i0) * ldsrc + col;
      float v[32];
#pragma unroll
      for (int ii = 0; ii < 32; ++ii) v[ii] = sp[(size_t)(8 * ii) * ldsrc];
#pragma unroll
      for (int ii = 0; ii < 32; ++ii) { const int kl = i0 + 8 * ii; float x = valid ? v[ii] : 0.f; if (kscale) x *= kscale[kt * 256 + kl]; tile[j * 257 + kl] = x; } }
    __syncthreads();
    { const int kk = (tid & 127) * 2, j0 = tid >> 7;
#pragma unroll
      for (int it = 0; it < 16; ++it) { const int j = j0 + 4 * it; *(unsigned*)(dst + (size_t)(nt * 64 + j) * K + kt * 256 + kk) = pk2(tile[j * 257 + kk], tile[j * 257 + kk + 1]); } }
    __syncthreads();
}

__device__ __forceinline__ void phase_prep(const Params& p, LAS unsigned char* lds) {
    LAS float* tile = (LAS float*)lds; unsigned char* ws = p.ws;
    constexpr int N0 = 324 * 8, N1 = N0 + 32 * 8, N2 = N1 + 32 * 16, N3 = N2 + 32 * 8, N4 = N3 + 176 * 8, N5 = N4 + 32 * 22;
    for (int it = blockIdx.x; it < N5; it += gridDim.x) {
        if (it < N0)      { const int i = it;      conv_tile(tile, p.w_in, nullptr, IN_COLS, IN_COLS, DM, (bf16_t*)(ws + OFF_WIN), nullptr, 0, i / 8, i % 8); }
        else if (it < N1) { const int i = it - N0; conv_tile(tile, p.w_out_a, nullptr, DM, DM, DM, (bf16_t*)(ws + OFF_WOA), nullptr, 0, i / 8, i % 8); }
        else if (it < N2) { const int i = it - N1; conv_tile(tile, p.w_out_ssm, nullptr, DM, DM, DI, (bf16_t*)(ws + OFF_WOS), nullptr, 0, i / 16, i % 16); }
        else if (it < N3) { const int i = it - N2; conv_tile(tile, p.w_o, nullptr, DM, DM, DM, (bf16_t*)(ws + OFF_WO), nullptr, 0, i / 8, i % 8); }
        else if (it < N4) { const int i = it - N3; conv_tile(tile, p.w_ffn_gate, p.w_ffn_up, DFF, DFF, DM, (bf16_t*)(ws + OFF_WGU), p.norm_ffn_g, 1, i / 8, i % 8); }
        else              { const int i = it - N4; conv_tile(tile, p.w_ffn_down, nullptr, DM, DM, DFF, (bf16_t*)(ws + OFF_WDN), nullptr, 0, i / 22, i % 22); }
    }
    { float* s1 = (float*)(ws + OFF_SSQ1); for (int i = blockIdx.x * 512 + threadIdx.x; i < 2 * NTOK; i += gridDim.x * 512) s1[i] = 0.f; }
    { const int wave = threadIdx.x >> 6, lane = threadIdx.x & 63; bf16_t* U = (bf16_t*)(ws + OFF_U);
      for (int row = (blockIdx.x * 8 + wave) * 2; row < NTOK; row += gridDim.x * 16) {
          const f32x4* xr = (const f32x4*)(p.x + (size_t)row * DM); f32x4 v[16]; float ss0 = 0.f, ss1 = 0.f;
#pragma unroll
          for (int i = 0; i < 16; ++i) v[i] = xr[lane + 64 * i];
#pragma unroll
          for (int i = 0; i < 8; ++i) { ss0 += v[i][0] * v[i][0] + v[i][1] * v[i][1] + v[i][2] * v[i][2] + v[i][3] * v[i][3]; ss1 += v[8 + i][0] * v[8 + i][0] + v[8 + i][1] * v[8 + i][1] + v[8 + i][2] * v[8 + i][2] + v[8 + i][3] * v[8 + i][3]; }
#pragma unroll
          for (int o = 32; o >= 1; o >>= 1) { ss0 += __shfl_xor(ss0, o); ss1 += __shfl_xor(ss1, o); }
          const float r0 = rsqrtf(ss0 * (1.0f / DM) + EPS), r1 = rsqrtf(ss1 * (1.0f / DM) + EPS);
#pragma unroll
          for (int i = 0; i < 16; ++i) { const float r = i < 8 ? r0 : r1; const f32x4 gg = ((const f32x4*)p.norm_mix_g)[lane + 64 * (i & 7)]; u32x2 w; w.x = pk2(v[i][0] * r * gg[0], v[i][1] * r * gg[1]); w.y = pk2(v[i][2] * r * gg[2], v[i][3] * r * gg[3]);
              *(u32x2*)(U + (size_t)row * DM + (lane + 64 * i) * 4) = w; } } }
}

__device__ __forceinline__ void phase_ssmconv(const Params& p) {
    const bf16_t* XBC = (const bf16_t*)(p.ws + OFF_XBC); bf16_t* XS = (bf16_t*)p.out; bf16_t* BCS = (bf16_t*)(p.ws + OFF_BCS);
    constexpr int TS = 16; const int total = (NTOK / TS) * 768;
    for (int idx = blockIdx.x * 512 + threadIdx.x; idx < total; idx += gridDim.x * 512) {
        const int t0 = (idx / 768) * TS, c = (idx % 768) * 8; const bool first = (t0 & (SEQ - 1)) == 0;
        u32x4 raw[TS + 3];
#pragma unroll
        for (int r = 0; r < TS + 3; ++r) raw[r] = (r < 3 && first) ? (u32x4){0u, 0u, 0u, 0u} : *(const u32x4*)(XBC + (size_t)(t0 - 3 + r) * CONVD + c);
        f32x4 w0[4], w1[4];
#pragma unroll
        for (int j = 0; j < 4; ++j) { w0[j] = *(const f32x4*)(p.ssm_conv_w + j * CONVD + c); w1[j] = *(const f32x4*)(p.ssm_conv_w + j * CONVD + c + 4); }
        const f32x4 b0 = *(const f32x4*)(p.ssm_conv_b + c), b1 = *(const f32x4*)(p.ssm_conv_b + c + 4);
        bf16_t* dst = (c < DI) ? XS + (size_t)t0 * DI + c : BCS + (size_t)t0 * 2048 + (c - DI); const int ldd = (c < DI) ? DI : 2048;
#pragma unroll
        for (int i = 0; i < TS; ++i) { f32x4 a0 = b0, a1 = b1;
#pragma unroll
            for (int j = 0; j < 4; ++j) { f32x4 r0, r1; unpack8(raw[i + j], r0, r1); a0 += w0[j] * r0; a1 += w1[j] * r1; }
#pragma unroll
            for (int j = 0; j < 4; ++j) { a0[j] = siluf_(a0[j]); a1[j] = siluf_(a1[j]); }
            *(u32x4*)(dst + (size_t)i * ldd) = pack8(a0, a1); }
    }
}

__device__ __forceinline__ void phase_ssd_seq(const Params& p, LAS unsigned char* lds) {
    LAS float* part = (LAS float*)lds;
    const int tid = threadIdx.x, pp = tid >> 3, ng = tid & 7, wave = tid >> 6, lane = tid & 63;
    const bf16_t* XS = (const bf16_t*)p.out; const bf16_t* BCS = (const bf16_t*)(p.ws + OFF_BCS); bf16_t* ZS = (bf16_t*)(p.ws + OFF_ZS);
    const float* DT = (const float*)(p.ws + OFF_DT); float* SSQH = (float*)(p.ws + OFF_SSQH);
    for (int item = blockIdx.x; item < 256; item += gridDim.x) {
        const int b = item >> 6, h = item & 63, g = h >> 3;
        const float a = -__expf(p.a_log[h]), Dk = p.d_skip[h];
        const bf16_t* xs = XS + (size_t)b * SEQ * DI + h * 64 + pp;
        const bf16_t* Bs = BCS + (size_t)b * SEQ * 2048 + g * 128 + ng * 16;
        const bf16_t* Cs = Bs + 1024;
        bf16_t* zs = ZS + (size_t)b * SEQ * DI + h * 64 + pp;
        const float* dt = DT + (size_t)b * SEQ * NH + h;
        float st[16];
#pragma unroll
        for (int i = 0; i < 16; ++i) st[i] = 0.f;
        for (int t0 = 0; t0 < SEQ; t0 += 64) {
#pragma unroll 4
            for (int tt = 0; tt < 64; ++tt) {
                const int t = t0 + tt;
                const float dtv = dt[(size_t)t * NH], xv = bf2f(xs[(size_t)t * DI]), zv = bf2f(zs[(size_t)t * DI]);
                f32x4 B0, B1, B2, B3, C0, C1, C2, C3;
                unpack8(*(const u32x4*)(Bs + (size_t)t * 2048), B0, B1); unpack8(*(const u32x4*)(Bs + (size_t)t * 2048 + 8), B2, B3);
                unpack8(*(const u32x4*)(Cs + (size_t)t * 2048), C0, C1); unpack8(*(const u32x4*)(Cs + (size_t)t * 2048 + 8), C2, C3);
                const float dA = __expf(dtv * a), xdt = xv * dtv; float y = 0.f;
#pragma unroll
                for (int i = 0; i < 4; ++i) {
                    st[i] = dA * st[i] + xdt * B0[i]; y += C0[i] * st[i];
                    st[4 + i] = dA * st[4 + i] + xdt * B1[i]; y += C1[i] * st[4 + i];
                    st[8 + i] = dA * st[8 + i] + xdt * B2[i]; y += C2[i] * st[8 + i];
                    st[12 + i] = dA * st[12 + i] + xdt * B3[i]; y += C3[i] * st[12 + i]; }
                y += __shfl_xor(y, 1); y += __shfl_xor(y, 2); y += __shfl_xor(y, 4);
                y += Dk * xv;
                const float yz = y * zv;
                if (ng == 0) zs[(size_t)t * DI] = (bf16_t)f2bf(yz);
                float sq = (ng == 0) ? yz * yz : 0.f;
                sq += __shfl_xor(sq, 8); sq += __shfl_xor(sq, 16); sq += __shfl_xor(sq, 32);
                if (lane == 0) part[tt * 8 + wave] = sq;
            }
            __syncthreads();
            if (tid < 64) { float s = 0.f;
#pragma unroll
                for (int w = 0; w < 8; ++w) s += part[tid * 8 + w];
                SSQH[(size_t)(b * SEQ + t0 + tid) * NH + h] = s; }
            __syncthreads();
        }
    }
}

typedef short s16x4 __attribute__((ext_vector_type(4)));
constexpr int SS_RSB = 272, SS_RSX = 144;
constexpr int SS_C = 0, SS_B = 34816, SS_X = 69632, SS_XW = 88064, SS_S = 106496, SS_SC = 123904;
__device__ __forceinline__ bf16x8 tr_frag(LAS unsigned char* lds, int addr, int step) {
    const s16x4 lo = __builtin_amdgcn_ds_read_tr16_b64_v4i16((LAS s16x4*)(lds + addr));
    const s16x4 hi = __builtin_amdgcn_ds_read_tr16_b64_v4i16((LAS s16x4*)(lds + addr + step));
    return __builtin_shufflevector(lo, hi, 0, 1, 2, 3, 4, 5, 6, 7);
}
#define MFMA16(a, b, c) __builtin_amdgcn_mfma_f32_16x16x32_bf16(a, b, c, 0, 0, 0)
__device__ __forceinline__ void phase_ssd_chunk(const Params& p, LAS unsigned char* lds) {
    const int tid = threadIdx.x, w = __builtin_amdgcn_readfirstlane(tid >> 6), lane = tid & 63, fr = lane & 15, g4 = lane >> 4, q = fr >> 2, pq = fr & 3;
    const bf16_t* XS = (const bf16_t*)p.out; const bf16_t* BCS = (const bf16_t*)(p.ws + OFF_BCS); bf16_t* ZS = (bf16_t*)(p.ws + OFF_ZS);
    const float* DT = (const float*)(p.ws + OFF_DT); float* SSQH = (float*)(p.ws + OFF_SSQH);
    LAS float* csA = (LAS float*)(lds + SS_SC); LAS float* dtA = csA + 128;
    for (int item = blockIdx.x; item < 256; item += gridDim.x) {
        const int b = item >> 6, h = item & 63, grp = h >> 3;
        const float a = -__expf(p.a_log[h]), Dk = p.d_skip[h];
        f32x4 accS[4];
#pragma unroll
        for (int i = 0; i < 4; ++i) accS[i] = (f32x4){0.f, 0.f, 0.f, 0.f};
        for (int i = tid; i < 64 * SS_RSB / 16; i += 512) *(LAS u32x4*)(lds + SS_S + i * 16) = (u32x4){0u, 0u, 0u, 0u};
        for (int c = 0; c < 32; ++c) {
            const int tok0 = b * SEQ + c * 128;
            if (w == 0) {
                const float d0 = DT[(size_t)(tok0 + lane) * NH + h], d1 = DT[(size_t)(tok0 + 64 + lane) * NH + h];
                float s0 = d0 * a, s1 = d1 * a;
#pragma unroll
                for (int o = 1; o < 64; o <<= 1) { const float t0 = __shfl_up(s0, o), t1 = __shfl_up(s1, o); if (lane >= o) { s0 += t0; s1 += t1; } }
                s1 += __shfl(s0, 63);
                csA[lane] = s0; csA[64 + lane] = s1; dtA[lane] = d0; dtA[64 + lane] = d1;
            }
            u32x4 xr[2];
#pragma unroll
            for (int i = 0; i < 4; ++i) { const int idx = tid + 512 * i, row = idx >> 4, ch = idx & 15; const bf16_t* src = BCS + (size_t)(tok0 + row) * 2048 + grp * 128 + ch * 8;
                const u32x4 vb = *(const u32x4*)src, vc = *(const u32x4*)(src + 1024);
                *(LAS u32x4*)(lds + SS_B + row * SS_RSB + ch * 16) = vb; *(LAS u32x4*)(lds + SS_C + row * SS_RSB + ch * 16) = vc; }
#pragma unroll
            for (int i = 0; i < 2; ++i) { const int idx = tid + 512 * i, row = idx >> 3, ch = idx & 7; xr[i] = *(const u32x4*)(XS + (size_t)(tok0 + row) * DI + h * 64 + ch * 8);
                *(LAS u32x4*)(lds + SS_X + row * SS_RSX + ch * 16) = xr[i]; }
            __syncthreads();
            const float csend = csA[127];
#pragma unroll
            for (int i = 0; i < 2; ++i) { const int idx = tid + 512 * i, row = idx >> 3, ch = idx & 7; const float wl = __expf(csend - csA[row]) * dtA[row];
                f32x4 v0, v1; unpack8(xr[i], v0, v1); v0 *= wl; v1 *= wl; *(LAS u32x4*)(lds + SS_XW + row * SS_RSX + ch * 16) = pack8(v0, v1); }
            __syncthreads();
            const int l = 16 * w + fr;
            bf16x8 cf[4];
#pragma unroll
            for (int ks = 0; ks < 4; ++ks) cf[ks] = *(const LAS bf16x8*)(lds + SS_C + l * SS_RSB + (4 * ks + g4) * 16);
            f32x4 acc1[8], accY[4];
#pragma unroll
            for (int st = 0; st < 8; ++st) { acc1[st] = (f32x4){0.f, 0.f, 0.f, 0.f};
#pragma unroll
                for (int ks = 0; ks < 4; ++ks) { const bf16x8 bf = *(const LAS bf16x8*)(lds + SS_B + (16 * st + fr) * SS_RSB + (4 * ks + g4) * 16); acc1[st] = MFMA16(bf, cf[ks], acc1[st]); } }
#pragma unroll
            for (int pt = 0; pt < 4; ++pt) { accY[pt] = (f32x4){0.f, 0.f, 0.f, 0.f};
#pragma unroll
                for (int ks = 0; ks < 4; ++ks) { const bf16x8 sf = *(const LAS bf16x8*)(lds + SS_S + (16 * pt + fr) * SS_RSB + (4 * ks + g4) * 16); accY[pt] = MFMA16(sf, cf[ks], accY[pt]); } }
            { const float dec = __expf(csend);
#pragma unroll
              for (int pt = 0; pt < 4; ++pt) accS[pt] *= dec;
#pragma unroll
              for (int ks = 0; ks < 4; ++ks) { const bf16x8 btf = tr_frag(lds, SS_B + (32 * ks + 8 * g4 + q) * SS_RSB + (16 * w + 4 * pq) * 2, 4 * SS_RSB);
#pragma unroll
                  for (int pt = 0; pt < 4; ++pt) { const bf16x8 xwf = tr_frag(lds, SS_XW + (32 * ks + 8 * g4 + q) * SS_RSX + (16 * pt + 4 * pq) * 2, 4 * SS_RSX); accS[pt] = MFMA16(btf, xwf, accS[pt]); } } }
            __syncthreads();
            const float csl = csA[l];
#pragma unroll
            for (int st = 0; st < 8; ++st) { const f32x4 cs4 = *(const LAS f32x4*)(csA + 16 * st + 4 * g4), dt4 = *(const LAS f32x4*)(dtA + 16 * st + 4 * g4); float v[4];
#pragma unroll
                for (int r = 0; r < 4; ++r) { const int s = 16 * st + 4 * g4 + r; v[r] = (s <= l) ? acc1[st][r] * __expf(fminf(csl - cs4[r], 0.f)) * dt4[r] : 0.f; }
                u32x2 pk; pk.x = pk2(v[0], v[1]); pk.y = pk2(v[2], v[3]); *(LAS u32x2*)(lds + SS_C + l * SS_RSB + (16 * st + 4 * g4) * 2) = pk; }
#pragma unroll
            for (int pt = 0; pt < 4; ++pt) { u32x2 pk; pk.x = pk2(accS[pt][0], accS[pt][1]); pk.y = pk2(accS[pt][2], accS[pt][3]); *(LAS u32x2*)(lds + SS_S + (16 * pt + fr) * SS_RSB + (16 * w + 4 * g4) * 2) = pk; }
            __syncthreads();
            { const float el = __expf(csl);
#pragma unroll
              for (int pt = 0; pt < 4; ++pt) accY[pt] *= el; }
#pragma unroll
            for (int ks = 0; ks < 4; ++ks) { const bf16x8 mf = *(const LAS bf16x8*)(lds + SS_C + l * SS_RSB + (4 * ks + g4) * 16);
#pragma unroll
                for (int pt = 0; pt < 4; ++pt) { const bf16x8 xf = tr_frag(lds, SS_X + (32 * ks + 8 * g4 + q) * SS_RSX + (16 * pt + 4 * pq) * 2, 4 * SS_RSX); accY[pt] = MFMA16(xf, mf, accY[pt]); } }
            { float sq = 0.f; const size_t tok = (size_t)(tok0 + l);
#pragma unroll
              for (int pt = 0; pt < 4; ++pt) { const u32x2 x2 = *(const LAS u32x2*)(lds + SS_X + l * SS_RSX + (16 * pt + 4 * g4) * 2); bf16_t* zp = ZS + tok * DI + h * 64 + 16 * pt + 4 * g4; const u32x2 z2 = *(const u32x2*)zp;
                  const float y0 = (accY[pt][0] + Dk * bflo(x2.x)) * bflo(z2.x), y1 = (accY[pt][1] + Dk * bfhi(x2.x)) * bfhi(z2.x), y2 = (accY[pt][2] + Dk * bflo(x2.y)) * bflo(z2.y), y3 = (accY[pt][3] + Dk * bfhi(x2.y)) * bfhi(z2.y);
                  sq += y0 * y0 + y1 * y1 + y2 * y2 + y3 * y3; u32x2 o; o.x = pk2(y0, y1); o.y = pk2(y2, y3); *(u32x2*)zp = o; }
              sq += __shfl_xor(sq, 16); sq += __shfl_xor(sq, 32);
              if (g4 == 0) SSQH[tok * NH + h] = sq; }
            __syncthreads();
        }
    }
}

__device__ __forceinline__ void phase_gnorm(const Params& p) {
    bf16_t* ZS = (bf16_t*)(p.ws + OFF_ZS); const float* SSQH = (const float*)(p.ws + OFF_SSQH);
    const int total = NTOK * 512 / 4;
    for (int idx = blockIdx.x * 512 + threadIdx.x; idx < total; idx += gridDim.x * 512) {
        const int t0 = (idx >> 9) * 4, cg8 = idx & 511, c = cg8 * 8, g = cg8 >> 6;
        u32x4 raw[4]; f32x4 s0[4], s1[4];
#pragma unroll
        for (int i = 0; i < 4; ++i) { raw[i] = *(const u32x4*)(ZS + (size_t)(t0 + i) * DI + c); s0[i] = *(const f32x4*)(SSQH + (size_t)(t0 + i) * NH + g * 8); s1[i] = *(const f32x4*)(SSQH + (size_t)(t0 + i) * NH + g * 8 + 4); }
        const f32x4 g0 = *(const f32x4*)(p.ssm_norm_g + c), g1 = *(const f32x4*)(p.ssm_norm_g + c + 4);
#pragma unroll
        for (int i = 0; i < 4; ++i) { const float ss = s0[i][0] + s0[i][1] + s0[i][2] + s0[i][3] + s1[i][0] + s1[i][1] + s1[i][2] + s1[i][3]; const float r = rsqrtf(ss * (1.0f / 512.0f) + EPS);
            f32x4 v0, v1; unpack8(raw[i], v0, v1); v0 = v0 * r * g0; v1 = v1 * r * g1; *(u32x4*)(ZS + (size_t)(t0 + i) * DI + c) = pack8(v0, v1); }
    }
}

__device__ __forceinline__ void phase_mixa(const Params& p) {
    const bf16_t* BB = (const bf16_t*)(p.ws + OFF_BB); const bf16_t* BC = (const bf16_t*)(p.ws + OFF_BC); const bf16_t* BH = (const bf16_t*)(p.ws + OFF_BH); bf16_t* YA = (bf16_t*)(p.ws + OFF_U);
    constexpr int TS = 8; const int total = (NTOK / TS) * 256;
    for (int idx = blockIdx.x * 512 + threadIdx.x; idx < total; idx += gridDim.x * 512) {
        const int t0 = (idx >> 8) * TS, c = (idx & 255) * 8; const bool first = (t0 & (SEQ - 1)) == 0;
        u32x4 rc[TS + 2], rh[TS + 2], rb[TS];
#pragma unroll
        for (int r = 0; r < TS + 2; ++r) { const size_t o = (size_t)(t0 - 2 + r) * DM + c; const bool z = (r < 2 && first); rc[r] = z ? (u32x4){0u, 0u, 0u, 0u} : *(const u32x4*)(BC + o); rh[r] = z ? (u32x4){0u, 0u, 0u, 0u} : *(const u32x4*)(BH + o); }
#pragma unroll
        for (int i = 0; i < TS; ++i) rb[i] = *(const u32x4*)(BB + (size_t)(t0 + i) * DM + c);
        f32x4 w0[3], w1[3];
#pragma unroll
        for (int j = 0; j < 3; ++j) { w0[j] = *(const f32x4*)(p.conv_a_w + j * DM + c); w1[j] = *(const f32x4*)(p.conv_a_w + j * DM + c + 4); }
        f32x4 q0[3], q1[3];
#pragma unroll
        for (int r = 0; r < 2; ++r) { f32x4 c0, c1, h0, h1; unpack8(rc[r], c0, c1); unpack8(rh[r], h0, h1); q0[r] = c0 * h0; q1[r] = c1 * h1; }
#pragma unroll
        for (int i = 0; i < TS; ++i) { { f32x4 c0, c1, h0, h1; unpack8(rc[i + 2], c0, c1); unpack8(rh[i + 2], h0, h1); q0[2] = c0 * h0; q1[2] = c1 * h1; }
            f32x4 a0 = w0[0] * q0[0] + w0[1] * q0[1] + w0[2] * q0[2], a1 = w1[0] * q1[0] + w1[1] * q1[1] + w1[2] * q1[2];
            f32x4 b0, b1; unpack8(rb[i], b0, b1);
            *(u32x4*)(YA + (size_t)(t0 + i) * DM + c) = pack8(a0 * b0, a1 * b1);
            q0[0] = q0[1]; q0[1] = q0[2]; q1[0] = q1[1]; q1[1] = q1[2]; }
    }
}

__device__ __forceinline__ void phase_final(const Params& p) {
    const float* SSQ2 = (const float*)(p.ws + OFF_SSQ2);
    const int total = NTOK * 512 / 4;
    for (int idx = blockIdx.x * 512 + threadIdx.x; idx < total; idx += gridDim.x * 512) {
        const int t0 = (idx >> 9) * 4, c = (idx & 511) * 4;
        f32x4 v[4]; float r[4];
#pragma unroll
        for (int i = 0; i < 4; ++i) { v[i] = *(const f32x4*)(p.out + (size_t)(t0 + i) * DM + c); r[i] = SSQ2[t0 + i]; }
        const f32x4 g = *(const f32x4*)(p.norm_final_g + c);
#pragma unroll
        for (int i = 0; i < 4; ++i) *(f32x4*)(p.out + (size_t)(t0 + i) * DM + c) = v[i] * rsqrtf(r[i] * (1.0f / DM) + EPS) * g;
    }
}

constexpr int NPHASE = 11;
template <int PH> __device__ __forceinline__ void run_phase(const Params& p, LAS unsigned char* lds) {
    unsigned char* ws = p.ws;
    pg8::StaticOrder S; pg8::Gemm g;
    if constexpr (PH == 0) { phase_prep(p, lds); }
    else if constexpr (PH == 1) {
        g.A = (const bf16_t*)(ws + OFF_U); g.Bt = (const bf16_t*)(ws + OFF_WIN) + (size_t)40 * 256 * DM; g.M = NTOK; g.N = 41 * 256; g.K = DM; S.init(g.M, g.N, gridDim.x, blockIdx.x);
        EpiRoute E{(bf16_t*)p.out, (bf16_t*)p.out + (size_t)NTOK * DM, (bf16_t*)(ws + OFF_BB), (bf16_t*)(ws + OFF_BC), (bf16_t*)(ws + OFF_BH), (bf16_t*)(ws + OFF_ZS), (bf16_t*)(ws + OFF_XBC), (float*)(ws + OFF_DT), p.dt_bias, 40};
        pg8::gemm_phase(lds, g, S, E); }
    else if constexpr (PH == 2) { phase_ssmconv(p); }
    else if constexpr (PH == 3) { phase_ssd_chunk(p, lds); }
    else if constexpr (PH == 4) {
        g.A = (const bf16_t*)(ws + OFF_U); g.Bt = (const bf16_t*)(ws + OFF_WIN); g.M = NTOK; g.N = 40 * 256; g.K = DM; S.init(g.M, g.N, gridDim.x, blockIdx.x);
        EpiRoute E{(bf16_t*)p.out, (bf16_t*)p.out + (size_t)NTOK * DM, (bf16_t*)(ws + OFF_BB), (bf16_t*)(ws + OFF_BC), (bf16_t*)(ws + OFF_BH), (bf16_t*)(ws + OFF_ZS), (bf16_t*)(ws + OFF_XBC), (float*)(ws + OFF_DT), p.dt_bias, 0};
        pg8::gemm_phase(lds, g, S, E);
        phase_gnorm(p); }
    else if constexpr (PH == 5) { phase_mixa(p); }
    else if constexpr (PH == 6) {
        g.A = (const bf16_t*)(ws + OFF_U); g.Bt = (const bf16_t*)(ws + OFF_WOA); g.M = NTOK; g.N = DM; g.K = DM; S.init(g.M, g.N, gridDim.x, blockIdx.x);
        EpiGate<false> Ea{(const bf16_t*)p.out, nullptr, (bf16_t*)(ws + OFF_BB)};
        pg8::gemm_phase(lds, g, S, Ea);
        g.A = (const bf16_t*)(ws + OFF_ZS); g.Bt = (const bf16_t*)(ws + OFF_WOS); g.K = DI;
        EpiGate<true> Eb{(const bf16_t*)p.out + (size_t)NTOK * DM, (const bf16_t*)(ws + OFF_BB), (bf16_t*)(ws + OFF_BC)};
        pg8::gemm_phase(lds, g, S, Eb); }
    else if constexpr (PH == 7) {
        g.A = (const bf16_t*)(ws + OFF_BC); g.Bt = (const bf16_t*)(ws + OFF_WO); g.M = NTOK; g.N = DM; g.K = DM; S.init(g.M, g.N, gridDim.x, blockIdx.x);
        EpiRes<true> E{p.x, p.out, (bf16_t*)(ws + OFF_BH), (float*)(ws + OFF_SSQ1)};
        pg8::gemm_phase(lds, g, S, E); }
    else if constexpr (PH == 8) {
        g.A = (const bf16_t*)(ws + OFF_BH); g.Bt = (const bf16_t*)(ws + OFF_WGU); g.M = NTOK; g.N = 2 * DFF; g.K = DM; S.init(g.M, g.N, gridDim.x, blockIdx.x);
        EpiSwiglu E{(const float*)(ws + OFF_SSQ1), (bf16_t*)(ws + OFF_ZS)};
        pg8::gemm_phase(lds, g, S, E); }
    else if constexpr (PH == 9) {
        g.A = (const bf16_t*)(ws + OFF_ZS); g.Bt = (const bf16_t*)(ws + OFF_WDN); g.M = NTOK; g.N = DM; g.K = DFF; S.init(g.M, g.N, gridDim.x, blockIdx.x);
        EpiRes<false> E{p.out, p.out, nullptr, (float*)(ws + OFF_SSQ2)};
        pg8::gemm_phase(lds, g, S, E); }
    else if constexpr (PH == 10) { phase_final(p); }
}

template <int PH> __global__ void __launch_bounds__(512, 2) k_one(Params p) {
    extern __shared__ __attribute__((aligned(16))) unsigned char lds_raw[];
    run_phase<PH>(p, (LAS unsigned char*)lds_raw);
}

#ifndef PROBE_MASK
#define PROBE_MASK 0
#endif
__global__ void __launch_bounds__(512, 2) k_mega(Params p) {
    extern __shared__ __attribute__((aligned(16))) unsigned char lds_raw[];
    LAS unsigned char* lds = (LAS unsigned char*)lds_raw;
    cg::grid_group grid = cg::this_grid();
    unsigned long long spin = 0, t0 = 0;
#define PH_RUN(i, SYNC) do { if (PROBE_MASK) t0 = __builtin_amdgcn_s_memrealtime(); run_phase<i>(p, lds); if (SYNC) grid.sync(); \
        if (PROBE_MASK & (1 << i)) spin += __builtin_amdgcn_s_memrealtime() - t0; } while (0)
    PH_RUN(0, 1); PH_RUN(1, 1); PH_RUN(2, 1); PH_RUN(3, 1); PH_RUN(4, 1); PH_RUN(5, 1); PH_RUN(6, 1); PH_RUN(7, 1); PH_RUN(8, 1); PH_RUN(9, 1); PH_RUN(10, 0);
    if (PROBE_MASK && blockIdx.x == 0) { t0 = __builtin_amdgcn_s_memrealtime(); while (__builtin_amdgcn_s_memrealtime() - t0 < spin) __builtin_amdgcn_s_sleep(8); }
}

constexpr int LDS_BYTES = pg8::STAGE_BYTES;

template <int PH> static void launch_one(const Params& p, int grid, hipStream_t stream) {
    static bool attr = false;
    if (!attr) { (void)hipFuncSetAttribute((const void*)k_one<PH>, hipFuncAttributeMaxDynamicSharedMemorySize, LDS_BYTES); attr = true; }
    hipLaunchKernelGGL(k_one<PH>, dim3(grid), dim3(512), LDS_BYTES, stream, p);
}

extern "C" void kernel_launch(void* const* d_in, const int* in_sizes, int n_in, void* d_out, int out_size, void* d_ws, size_t ws_size, hipStream_t stream) {
    static int grid = 0;
    if (grid == 0) {
        if (n_in != 18 || out_size != NTOK * DM || ws_size < WS_END) { fprintf(stderr, "kernel_launch: unexpected shapes: n_in %d out %d ws %zu (need %zu)\n", n_in, out_size, ws_size, (size_t)WS_END); grid = -1; return; }
        int dev = 0, cus = 0, per_cu = 0;
        (void)hipGetDevice(&dev); (void)hipDeviceGetAttribute(&cus, hipDeviceAttributeMultiprocessorCount, dev);
        (void)hipFuncSetAttribute((const void*)k_mega, hipFuncAttributeMaxDynamicSharedMemorySize, LDS_BYTES);
        (void)hipOccupancyMaxActiveBlocksPerMultiprocessor(&per_cu, (const void*)k_mega, 512, LDS_BYTES);
        if (per_cu < 1) { fprintf(stderr, "kernel_launch: occupancy query says %d blocks per CU\n", per_cu); per_cu = 1; }
        (void)hipGetLastError();
        grid = cus * per_cu;
        fprintf(stderr, "kernel_launch: cus %d per_cu %d grid %d ws %zu\n", cus, per_cu, grid, ws_size);
    }
    if (grid < 0) return;
    Params p{};
    const float** pp = (const float**)&p;
    for (int i = 0; i < 18; ++i) pp[i] = (const float*)d_in[i];
    p.out = (float*)d_out; p.ws = (unsigned char*)d_ws;
#if MEGA
    void* args[] = {&p};
    hipError_t e = hipLaunchCooperativeKernel((const void*)k_mega, dim3(grid), dim3(512), args, LDS_BYTES, stream);
    if (e != hipSuccess) fprintf(stderr, "cooperative launch failed: %s (grid %d)\n", hipGetErrorString(e), grid);
#else
    launch_one<0>(p, grid, stream); launch_one<1>(p, grid, stream); launch_one<2>(p, grid, stream); launch_one<3>(p, grid, stream); launch_one<4>(p, grid, stream); launch_one<5>(p, grid, stream);
    launch_one<6>(p, grid, stream); launch_one<7>(p, grid, stream); launch_one<8>(p, grid, stream); launch_one<9>(p, grid, stream); launch_one<10>(p, grid, stream);
#endif
}
```

```cpp
#include <hip/hip_runtime.h>
#include <hip/hip_cooperative_groups.h>
#include <cstdio>
namespace cg = cooperative_groups;

#ifndef MEGA
#define MEGA 1
#endif

#define LAS __attribute__((address_space(3)))
typedef unsigned short bf16_t;
typedef short bf16x8 __attribute__((ext_vector_type(8)));
typedef float f32x4 __attribute__((ext_vector_type(4)));
typedef unsigned u32x4 __attribute__((ext_vector_type(4)));
typedef unsigned u32x2 __attribute__((ext_vector_type(2)));

constexpr int DM = 2048, NTOK = 16384, SEQ = 4096;
constexpr int IN_COLS = 20544, IN_TILES = 81;
constexpr int DI = 4096, NH = 64, HD = 64, NG = 8, NST = 128, CONVD = 6144;
constexpr int DFF = 5632;
constexpr float EPS = 1e-6f;

constexpr size_t MiB = 1024ull * 1024ull;
constexpr size_t OFF_WIN = 0;
constexpr size_t OFF_WOA = 81 * MiB;
constexpr size_t OFF_WOS = 89 * MiB;
constexpr size_t OFF_WO  = 105 * MiB;
constexpr size_t OFF_WGU = 113 * MiB;
constexpr size_t OFF_WDN = 157 * MiB;
constexpr size_t OFF_ZS  = 179 * MiB;
constexpr size_t OFF_U   = 307 * MiB;
constexpr size_t OFF_XBC = 371 * MiB;
constexpr size_t OFF_BB  = 371 * MiB, OFF_BC = 435 * MiB, OFF_BH = 499 * MiB;
constexpr size_t OFF_DT  = 563 * MiB;
constexpr size_t OFF_SSQH = 567 * MiB;
constexpr size_t OFF_SSQ1 = 571 * MiB;
constexpr size_t OFF_SSQ2 = 571 * MiB + 65536;
constexpr size_t OFF_BCS = 572 * MiB;
constexpr size_t WS_END = 636 * MiB;

struct Params {
    const float *x, *norm_mix_g, *w_in, *conv_a_w, *w_out_a, *ssm_conv_w, *ssm_conv_b, *dt_bias, *a_log, *d_skip, *ssm_norm_g, *w_out_ssm, *w_o, *norm_ffn_g, *w_ffn_gate, *w_ffn_up,
        *w_ffn_down, *norm_final_g;
    float* out; unsigned char* ws;
};

__device__ __forceinline__ unsigned f2bf(float f) { unsigned u = __builtin_bit_cast(unsigned, f); return (u + 0x7fffu + ((u >> 16) & 1u)) >> 16; }
__device__ __forceinline__ unsigned pk2(float lo, float hi) { return f2bf(lo) | (f2bf(hi) << 16); }
__device__ __forceinline__ float bflo(unsigned w) { return __builtin_bit_cast(float, w << 16); }
__device__ __forceinline__ float bfhi(unsigned w) { return __builtin_bit_cast(float, w & 0xffff0000u); }
__device__ __forceinline__ float bf2f(bf16_t v) { return __builtin_bit_cast(float, ((unsigned)v) << 16); }
__device__ __forceinline__ float sigmoidf_(float v) { return __builtin_amdgcn_rcpf(1.0f + __expf(-v)); }
__device__ __forceinline__ float siluf_(float v) { return v * sigmoidf_(v); }
__device__ __forceinline__ float softplusf_(float v) { return fmaxf(v, 0.f) + log1pf(__expf(-fabsf(v))); }
__device__ __forceinline__ u32x4 pack8(const f32x4& a, const f32x4& b) { u32x4 w; w.x = pk2(a[0], a[1]); w.y = pk2(a[2], a[3]); w.z = pk2(b[0], b[1]); w.w = pk2(b[2], b[3]); return w; }
__device__ __forceinline__ void unpack8(const u32x4& w, f32x4& a, f32x4& b) { a[0] = bflo(w.x); a[1] = bfhi(w.x); a[2] = bflo(w.y); a[3] = bfhi(w.y); b[0] = bflo(w.z); b[1] = bfhi(w.z); b[2] = bflo(w.w); b[3] = bfhi(w.w); }

namespace pg8 {
constexpr int BM = 256, BK = 64, HALF = 128, HTB = HALF * BK * 2, STAGE_BYTES = 8 * HTB, NXCD = 8, WGM = 8;
__host__ __device__ __forceinline__ int lds_byte(int r, int c) { const int st = (r >> 4) * 2 + (c >> 5), rr = r & 15, cc = c & 31, ob = rr * 64 + cc * 2; return st * 1024 + (ob ^ (((ob >> 9) & 1) << 5)); }
__host__ __device__ __forceinline__ void stage_rc(int b, int& R, int& C) { const int st = b / 1024, sb = b % 1024, swz = sb ^ (((sb >> 9) & 1) << 5); R = (st >> 1) * 16 + swz / 64; C = (st & 1) * 32 + (swz % 64) / 2; }
__host__ __device__ __forceinline__ int perm32(int rho) { const int n = rho >> 4, i = rho & 15; return 8 * (i >> 2) + 4 * n + (i & 3); }
struct Unit { int pm, pn; };
struct Gemm { const bf16_t* A; const bf16_t* Bt; int M, N, K; };
struct StaticOrder {
    int nM, nN, nwg, G, c;
    __host__ __device__ void init(int M, int N, int G_, int c_) { nM = M / BM; nN = N / BM; nwg = nM * nN; G = G_; c = c_; }
    __host__ __device__ bool next(int i, Unit& u) const {
        const long L = (long)i * G + c; if (L >= nwg) return false;
        int wgid = (int)L; { const int q = nwg / NXCD, r = nwg % NXCD, xcd = wgid % NXCD, off = wgid / NXCD; wgid = (xcd < r ? xcd * (q + 1) : r * (q + 1) + (xcd - r) * q) + off; }
        const int nig = WGM * nN, gid = wgid / nig, fm = gid * WGM, gsz = (nM - fm) < WGM ? (nM - fm) : WGM;
        u.pm = fm + ((wgid % nig) % gsz); u.pn = (wgid % nig) / gsz; return true;
    }
};

template <class Epi>
__device__ __forceinline__ void gemm_phase(LAS unsigned char* lds, const Gemm g, const StaticOrder& S, const Epi& E) {
    const int tid = threadIdx.x, wid = __builtin_amdgcn_readfirstlane(tid >> 6), lane = tid & 63, wr = wid >> 2, wc = wid & 3, fr = lane & 15, fq = lane >> 4;
    const int K = g.K, nt = K / BK;
    unsigned voffA[2];
#pragma unroll
    for (int i = 0; i < 2; ++i) { int R, C; stage_rc(tid * 16 + i * 8192, R, C); voffA[i] = (unsigned)(R * K + C) * 2u; }
    const size_t kstep = (size_t)(BK * 2);
    const size_t hstep = (size_t)HALF * K * 2;
    const size_t tstep = 2 * hstep;
    const unsigned ldsw = (unsigned)wid * 1024u;
    const int aoff = lds_byte(wr * 64 + fr, fq * 8), boff = lds_byte(wc * 32 + fr, fq * 8);
#define PG8_SA(b, h) (((b) * 2 + (h)) * HTB)
#define PG8_SB(b, h) ((4 + (b) * 2 + (h)) * HTB)
#define PG8_STAGE(bufoff, gbase, voff) do { _Pragma("unroll") for (int _i = 0; _i < 2; ++_i) \
        __builtin_amdgcn_global_load_lds((const unsigned*)((const char*)(gbase) + (voff)[_i]), (LAS unsigned*)(lds + (bufoff) + ldsw + _i * 8192), 16, 0, 0); } while (0)
#define PG8_LDA(dst, b, h) do { _Pragma("unroll") for (int m = 0; m < 4; ++m) _Pragma("unroll") for (int k = 0; k < 2; ++k) dst[m][k] = *(const LAS bf16x8*)(lds + PG8_SA(b, h) + aoff + m * 2048 + k * 1024); } while (0)
#define PG8_LDB(dst, b, h) do { _Pragma("unroll") for (int n = 0; n < 2; ++n) _Pragma("unroll") for (int k = 0; k < 2; ++k) dst[n][k] = *(const LAS bf16x8*)(lds + PG8_SB(b, h) + boff + n * 2048 + k * 1024); } while (0)
#define PG8_MMA(ai, bj, At, Bt) do { __builtin_amdgcn_s_setprio(1); _Pragma("unroll") for (int m = 0; m < 4; ++m) _Pragma("unroll") for (int n = 0; n < 2; ++n) _Pragma("unroll") for (int k = 0; k < 2; ++k) \
        acc[ai][bj][m][n] = __builtin_amdgcn_mfma_f32_16x16x32_bf16(Bt[n][k], At[m][k], acc[ai][bj][m][n], 0, 0, 0); __builtin_amdgcn_s_setprio(0); } while (0)
#define PG8_WAIT_V(n) asm volatile("s_waitcnt vmcnt(" #n ")" ::: "memory")
#define PG8_WAIT_L(n) asm volatile("s_waitcnt lgkmcnt(" #n ")" ::: "memory")
#define PG8_BAR __builtin_amdgcn_s_barrier()
#define PG8_SCHED __builtin_amdgcn_sched_barrier(0)
    Unit cur, nxt; int ui = 0;
    if (!S.next(0, cur)) return;
    f32x4 acc[2][2][4][2];
#pragma unroll
    for (int a = 0; a < 2; ++a)
#pragma unroll
        for (int b = 0; b < 2; ++b)
#pragma unroll
            for (int m = 0; m < 4; ++m)
#pragma unroll
                for (int n = 0; n < 2; ++n) acc[a][b][m][n] = (f32x4){0.f, 0.f, 0.f, 0.f};
    bf16x8 At[4][2], B0[2][2], B1[2][2];
    const char* cA = (const char*)g.A + (size_t)cur.pm * tstep; const char* cB = (const char*)g.Bt + (size_t)cur.pn * tstep;
    PG8_STAGE(PG8_SB(0, 0), cB, voffA); PG8_STAGE(PG8_SA(0, 0), cA, voffA); PG8_STAGE(PG8_SB(0, 1), cB + hstep, voffA); PG8_STAGE(PG8_SA(0, 1), cA + hstep, voffA);
    if (wr == 1) PG8_BAR;
    PG8_WAIT_V(4); PG8_BAR;
    PG8_STAGE(PG8_SB(1, 0), cB + kstep, voffA); PG8_STAGE(PG8_SA(1, 0), cA + kstep, voffA); PG8_STAGE(PG8_SB(1, 1), cB + hstep + kstep, voffA);
    PG8_WAIT_V(6); PG8_BAR;
    for (;;) {
        const bool has_next = S.next(ui + 1, nxt);
        const char* nA = has_next ? (const char*)g.A + (size_t)nxt.pm * tstep : cA; const char* nB = has_next ? (const char*)g.Bt + (size_t)nxt.pn * tstep : cB;
        for (int t = 0; t < nt; t += 2) {
            const bool last = (t == nt - 2);
            const char* a1 = cA + (size_t)(t + 1) * kstep;
            const char* a2 = last ? nA : cA + (size_t)(t + 2) * kstep; const char* b2 = last ? nB : cB + (size_t)(t + 2) * kstep;
            const char* a3 = a2 + kstep; const char* b3 = b2 + kstep;
            PG8_LDB(B0, 0, 0); PG8_SCHED; PG8_LDA(At, 0, 0); PG8_STAGE(PG8_SA(1, 1), a1 + hstep, voffA);
            PG8_WAIT_L(8); PG8_BAR; PG8_WAIT_L(0); PG8_MMA(0, 0, At, B0); PG8_BAR; PG8_SCHED;
            PG8_LDB(B1, 0, 1); PG8_STAGE(PG8_SB(0, 0), b2, voffA);
            PG8_BAR; PG8_WAIT_L(0); PG8_MMA(0, 1, At, B1); PG8_BAR;
            PG8_LDA(At, 0, 1); PG8_STAGE(PG8_SA(0, 0), a2, voffA);
            PG8_BAR; PG8_WAIT_L(0); PG8_MMA(1, 0, At, B0); PG8_BAR; PG8_SCHED;
            PG8_STAGE(PG8_SB(0, 1), b2 + hstep, voffA);
            PG8_WAIT_V(6); PG8_BAR; PG8_MMA(1, 1, At, B1); PG8_BAR;
            PG8_LDB(B0, 1, 0); PG8_SCHED; PG8_LDA(At, 1, 0); PG8_STAGE(PG8_SA(0, 1), a2 + hstep, voffA);
            PG8_WAIT_L(8); PG8_BAR; PG8_WAIT_L(0); PG8_MMA(0, 0, At, B0); PG8_BAR; PG8_SCHED;
            PG8_LDB(B1, 1, 1); PG8_STAGE(PG8_SB(1, 0), b3, voffA);
            PG8_BAR; PG8_WAIT_L(0); PG8_MMA(0, 1, At, B1); PG8_BAR;
            PG8_LDA(At, 1, 1); PG8_STAGE(PG8_SA(1, 0), a3, voffA);
            PG8_BAR; PG8_WAIT_L(0); PG8_MMA(1, 0, At, B0); PG8_BAR; PG8_SCHED;
            PG8_STAGE(PG8_SB(1, 1), b3 + hstep, voffA);
            PG8_WAIT_V(6); PG8_BAR; PG8_MMA(1, 1, At, B1); PG8_BAR;
        }
        E(acc, cur, wr, wc, fr, fq);
        if (!has_next) break;
#pragma unroll
        for (int a = 0; a < 2; ++a)
#pragma unroll
            for (int b = 0; b < 2; ++b)
#pragma unroll
                for (int m = 0; m < 4; ++m)
#pragma unroll
                    for (int n = 0; n < 2; ++n) acc[a][b][m][n] = (f32x4){0.f, 0.f, 0.f, 0.f};
        cur = nxt; cA = nA; cB = nB; ++ui;
    }
    PG8_WAIT_V(0);
    if (wr == 0) PG8_BAR;
    PG8_BAR;
#undef PG8_SA
#undef PG8_SB
#undef PG8_STAGE
#undef PG8_LDA
#undef PG8_LDB
#undef PG8_MMA
#undef PG8_WAIT_V
#undef PG8_WAIT_L
#undef PG8_BAR
#undef PG8_SCHED
}
}
using pg8::Unit;

struct EpiRoute {
    bf16_t *GA, *GB, *BB, *BC, *BH, *ZS, *XBC; float* DT; const float* dt_bias; int tile0;
    __device__ __forceinline__ void operator()(const f32x4 (&acc)[2][2][4][2], const Unit& u, int wr, int wc, int fr, int fq) const {
        const int gt = u.pn + tile0; const int row0 = u.pm * 256 + wr * 64 + fr;
        if (gt < 80) {
            bf16_t* base; int ldc, cb, act;
            if (gt < 40) { const int r = gt >> 3; base = (r == 0 ? GA : r == 1 ? GB : r == 2 ? BB : r == 3 ? BC : BH); ldc = DM; cb = (gt & 7) * 256; act = r < 2 ? 1 : 0; }
            else if (gt < 56) { base = ZS; ldc = DI; cb = (gt - 40) * 256; act = 2; }
            else { base = XBC; ldc = CONVD; cb = (gt - 56) * 256; act = 0; }
            const int col0 = cb + wc * 32 + 8 * fq;
#pragma unroll
            for (int ai = 0; ai < 2; ++ai)
#pragma unroll
                for (int m = 0; m < 4; ++m) { bf16_t* rowp = base + (size_t)(row0 + ai * 128 + m * 16) * ldc + col0;
#pragma unroll
                    for (int bj = 0; bj < 2; ++bj) { f32x4 v0 = acc[ai][bj][m][0], v1 = acc[ai][bj][m][1];
                        if (act == 1) {
#pragma unroll
                            for (int j = 0; j < 4; ++j) { v0[j] = sigmoidf_(v0[j]); v1[j] = sigmoidf_(v1[j]); } }
                        else if (act == 2) {
#pragma unroll
                            for (int j = 0; j < 4; ++j) { v0[j] = siluf_(v0[j]); v1[j] = siluf_(v1[j]); } }
                        *(u32x4*)(rowp + bj * 128) = pack8(v0, v1); } }
        } else if (wc < 2) {
            const int c0 = wc * 32 + 8 * fq;
            f32x4 b0 = *(const f32x4*)(dt_bias + c0), b1 = *(const f32x4*)(dt_bias + c0 + 4);
#pragma unroll
            for (int ai = 0; ai < 2; ++ai)
#pragma unroll
                for (int m = 0; m < 4; ++m) { float* rowp = DT + (size_t)(row0 + ai * 128 + m * 16) * NH + c0;
                    f32x4 v0 = acc[ai][0][m][0] + b0, v1 = acc[ai][0][m][1] + b1;
#pragma unroll
                    for (int j = 0; j < 4; ++j) { v0[j] = softplusf_(v0[j]); v1[j] = softplusf_(v1[j]); }
                    *(f32x4*)rowp = v0; *(f32x4*)(rowp + 4) = v1; }
        }
    }
};
template <bool ADD> struct EpiGate {
    const bf16_t* GATE; const bf16_t* PREV; bf16_t* O;
    __device__ __forceinline__ void operator()(const f32x4 (&acc)[2][2][4][2], const Unit& u, int wr, int wc, int fr, int fq) const {
        const int row0 = u.pm * 256 + wr * 64 + fr, col0 = u.pn * 256 + wc * 32 + 8 * fq;
#pragma unroll
        for (int ai = 0; ai < 2; ++ai)
#pragma unroll
            for (int m = 0; m < 4; ++m) { const size_t ro = (size_t)(row0 + ai * 128 + m * 16) * DM + col0;
#pragma unroll
                for (int bj = 0; bj < 2; ++bj) { const size_t idx = ro + bj * 128;
                    f32x4 g0, g1; unpack8(*(const u32x4*)(GATE + idx), g0, g1);
                    f32x4 v0 = g0 * acc[ai][bj][m][0], v1 = g1 * acc[ai][bj][m][1];
                    if (ADD) { f32x4 p0, p1; unpack8(*(const u32x4*)(PREV + idx), p0, p1); v0 += p0; v1 += p1; }
                    *(u32x4*)(O + idx) = pack8(v0, v1); } }
    }
};
template <bool WBF> struct EpiRes {
    const float* X; float* H; bf16_t* HBF; float* ssq;
    __device__ __forceinline__ void operator()(const f32x4 (&acc)[2][2][4][2], const Unit& u, int wr, int wc, int fr, int fq) const {
        const int row0 = u.pm * 256 + wr * 64 + fr, col0 = u.pn * 256 + wc * 32 + 8 * fq;
#pragma unroll
        for (int ai = 0; ai < 2; ++ai)
#pragma unroll
            for (int m = 0; m < 4; ++m) { const int row = row0 + ai * 128 + m * 16; const size_t ro = (size_t)row * DM + col0; float s = 0.f;
#pragma unroll
                for (int bj = 0; bj < 2; ++bj) { const size_t idx = ro + bj * 128;
                    f32x4 h0 = *(const f32x4*)(X + idx) + acc[ai][bj][m][0], h1 = *(const f32x4*)(X + idx + 4) + acc[ai][bj][m][1];
                    *(f32x4*)(H + idx) = h0; *(f32x4*)(H + idx + 4) = h1;
                    if (WBF) *(u32x4*)(HBF + idx) = pack8(h0, h1);
#pragma unroll
                    for (int j = 0; j < 4; ++j) s += h0[j] * h0[j] + h1[j] * h1[j]; }
                s += __shfl_xor(s, 16); s += __shfl_xor(s, 32);
                if (fq == 0) atomicAdd(ssq + row, s); }
    }
};
struct EpiSwiglu {
    const float* ssq; bf16_t* ACT;
    __device__ __forceinline__ void operator()(const f32x4 (&acc)[2][2][4][2], const Unit& u, int wr, int wc, int fr, int fq) const {
        const int row0 = u.pm * 256 + wr * 64 + fr, ch0 = u.pn * 128 + wc * 32 + 8 * fq;
#pragma unroll
        for (int ai = 0; ai < 2; ++ai)
#pragma unroll
            for (int m = 0; m < 4; ++m) { const int row = row0 + ai * 128 + m * 16; const float r = rsqrtf(ssq[row] * (1.0f / DM) + EPS);
                f32x4 v0, v1;
#pragma unroll
                for (int j = 0; j < 4; ++j) { v0[j] = siluf_(acc[ai][0][m][0][j] * r) * (acc[ai][1][m][0][j] * r); v1[j] = siluf_(acc[ai][0][m][1][j] * r) * (acc[ai][1][m][1][j] * r); }
                *(u32x4*)(ACT + (size_t)row * DFF + ch0) = pack8(v0, v1); }
    }
};

__device__ __forceinline__ int slot2lc(int slot) { return (slot & ~31) + pg8::perm32(slot & 31); }
__device__ __forceinline__ void conv_tile(LAS float* tile, const float* src0, const float* src1, int ldsrc, int nvalid, int K, bf16_t* dst, const float* kscale, int mode, int nt, int kt) {
    const int tid = threadIdx.x;
    { const int j = tid & 63, i0 = tid >> 6; const int nrow = nt * 64 + j, t256 = nrow >> 8, lc = slot2lc(nrow & 255);
      const float* s; int col; bool valid;
      if (mode == 0) { col = t256 * 256 + lc; s = src0; valid = col < nvalid; } else { col = t256 * 128 + (lc & 127); s = (lc >> 7) ? src1 : src0; valid = true; }
      if (!valid) col = 0;
      const float* sp = s + (size_t)(kt * 256 + i0) * ldsrc + col;
      float v[32];
#pragma unroll
      for (int ii = 0; ii < 32; ++ii) v[ii] = sp[(size_t)(8 * ii) * ldsrc];
#pragma unroll
      for (int ii = 0; ii < 32; ++ii) { const int kl = i0 + 8 * ii; float x = valid ? v[ii] : 0.f; if (kscale) x *= kscale[kt * 256 + kl]; tile[j * 257 + kl] = x; } }
    __syncthreads();
    { const int kk = (tid & 127) * 2, j0 = tid >> 7;
#pragma unroll
      for (int it = 0; it < 16; ++it) { const int j = j0 + 4 * it; *(unsigned*)(dst + (size_t)(nt * 64 + j) * K + kt * 256 + kk) = pk2(tile[j * 257 + kk], tile[j * 257 + kk + 1]); } }
    __syncthreads();
}

__device__ __forceinline__ void phase_prep(const Params& p, LAS unsigned char* lds) {
    LAS float* tile = (LAS float*)lds; unsigned char* ws = p.ws;
    constexpr int N0 = 324 * 8, N1 = N0 + 32 * 8, N2 = N1 + 32 * 16, N3 = N2 + 32 * 8, N4 = N3 + 176 * 8, N5 = N4 + 32 * 22;
    for (int it = blockIdx.x; it < N5; it += gridDim.x) {
        if (it < N0)      { const int i = it;      conv_tile(tile, p.w_in, nullptr, IN_COLS, IN_COLS, DM, (bf16_t*)(ws + OFF_WIN), nullptr, 0, i / 8, i % 8); }
        else if (it < N1) { const int i = it - N0; conv_tile(tile, p.w_out_a, nullptr, DM, DM, DM, (bf16_t*)(ws + OFF_WOA), nullptr, 0, i / 8, i % 8); }
        else if (it < N2) { const int i = it - N1; conv_tile(tile, p.w_out_ssm, nullptr, DM, DM, DI, (bf16_t*)(ws + OFF_WOS), nullptr, 0, i / 16, i % 16); }
        else if (it < N3) { const int i = it - N2; conv_tile(tile, p.w_o, nullptr, DM, DM, DM, (bf16_t*)(ws + OFF_WO), nullptr, 0, i / 8, i % 8); }
        else if (it < N4) { const int i = it - N3; conv_tile(tile, p.w_ffn_gate, p.w_ffn_up, DFF, DFF, DM, (bf16_t*)(ws + OFF_WGU), p.norm_ffn_g, 1, i / 8, i % 8); }
        else              { const int i = it - N4; conv_tile(tile, p.w_ffn_down, nullptr, DM, DM, DFF, (bf16_t*)(ws + OFF_WDN), nullptr, 0, i / 22, i % 22); }
    }
    { float* s1 = (float*)(ws + OFF_SSQ1); for (int i = blockIdx.x * 512 + threadIdx.x; i < 2 * NTOK; i += gridDim.x * 512) s1[i] = 0.f; }
    { const int wave = threadIdx.x >> 6, lane = threadIdx.x & 63; bf16_t* U = (bf16_t*)(ws + OFF_U);
      for (int row = (blockIdx.x * 8 + wave) * 2; row < NTOK; row += gridDim.x * 16) {
          const f32x4* xr = (const f32x4*)(p.x + (size_t)row * DM); f32x4 v[16]; float ss0 = 0.f, ss1 = 0.f;
#pragma unroll
          for (int i = 0; i < 16; ++i) v[i] = xr[lane + 64 * i];
#pragma unroll
          for (int i = 0; i < 8; ++i) { ss0 += v[i][0] * v[i][0] + v[i][1] * v[i][1] + v[i][2] * v[i][2] + v[i][3] * v[i][3]; ss1 += v[8 + i][0] * v[8 + i][0] + v[8 + i][1] * v[8 + i][1] + v[8 + i][2] * v[8 + i][2] + v[8 + i][3] * v[8 + i][3]; }
#pragma unroll
          for (int o = 32; o >= 1; o >>= 1) { ss0 += __shfl_xor(ss0, o); ss1 += __shfl_xor(ss1, o); }
          const float r0 = rsqrtf(ss0 * (1.0f / DM) + EPS), r1 = rsqrtf(ss1 * (1.0f / DM) + EPS);
#pragma unroll
          for (int i = 0; i < 16; ++i) { const float r = i < 8 ? r0 : r1; const f32x4 gg = ((const f32x4*)p.norm_mix_g)[lane + 64 * (i & 7)]; u32x2 w; w.x = pk2(v[i][0] * r * gg[0], v[i][1] * r * gg[1]); w.y = pk2(v[i][2] * r * gg[2], v[i][3] * r * gg[3]);
              *(u32x2*)(U + (size_t)row * DM + (lane + 64 * i) * 4) = w; } } }
}

__device__ __forceinline__ void phase_ssmconv(const Params& p) {
    const bf16_t* XBC = (const bf16_t*)(p.ws + OFF_XBC); bf16_t* XS = (bf16_t*)p.out; bf16_t* BCS = (bf16_t*)(p.ws + OFF_BCS);
    constexpr int TS = 16; const int total = (NTOK / TS) * 768;
    for (int idx = blockIdx.x * 512 + threadIdx.x; idx < total; idx += gridDim.x * 512) {
        const int t0 = (idx / 768) * TS, c = (idx % 768) * 8; const bool first = (t0 & (SEQ - 1)) == 0;
        u32x4 raw[TS + 3];
#pragma unroll
        for (int r = 0; r < TS + 3; ++r) raw[r] = (r < 3 && first) ? (u32x4){0u, 0u, 0u, 0u} : *(const u32x4*)(XBC + (size_t)(t0 - 3 + r) * CONVD + c);
        f32x4 w0[4], w1[4];
#pragma unroll
        for (int j = 0; j < 4; ++j) { w0[j] = *(const f32x4*)(p.ssm_conv_w + j * CONVD + c); w1[j] = *(const f32x4*)(p.ssm_conv_w + j * CONVD + c + 4); }
        const f32x4 b0 = *(const f32x4*)(p.ssm_conv_b + c), b1 = *(const f32x4*)(p.ssm_conv_b + c + 4);
        bf16_t* dst = (c < DI) ? XS + (size_t)t0 * DI + c : BCS + (size_t)t0 * 2048 + (c - DI); const int ldd = (c < DI) ? DI : 2048;
#pragma unroll
        for (int i = 0; i < TS; ++i) { f32x4 a0 = b0, a1 = b1;
#pragma unroll
            for (int j = 0; j < 4; ++j) { f32x4 r0, r1; unpack8(raw[i + j], r0, r1); a0 += w0[j] * r0; a1 += w1[j] * r1; }
#pragma unroll
            for (int j = 0; j < 4; ++j) { a0[j] = siluf_(a0[j]); a1[j] = siluf_(a1[j]); }
            *(u32x4*)(dst + (size_t)i * ldd) = pack8(a0, a1); }
    }
}

__device__ __forceinline__ void phase_ssd_seq(const Params& p, LAS unsigned char* lds) {
    LAS float* part = (LAS float*)lds;
    const int tid = threadIdx.x, pp = tid >> 3, ng = tid & 7, wave = tid >> 6, lane = tid & 63;
    const bf16_t* XS = (const bf16_t*)p.out; const bf16_t* BCS = (const bf16_t*)(p.ws + OFF_BCS); bf16_t* ZS = (bf16_t*)(p.ws + OFF_ZS);
    const float* DT = (const float*)(p.ws + OFF_DT); float* SSQH = (float*)(p.ws + OFF_SSQH);
    for (int item = blockIdx.x; item < 256; item += gridDim.x) {
        const int b = item >> 6, h = item & 63, g = h >> 3;
        const float a = -__expf(p.a_log[h]), Dk = p.d_skip[h];
        const bf16_t* xs = XS + (size_t)b * SEQ * DI + h * 64 + pp;
        const bf16_t* Bs = BCS + (size_t)b * SEQ * 2048 + g * 128 + ng * 16;
        const bf16_t* Cs = Bs + 1024;
        bf16_t* zs = ZS + (size_t)b * SEQ * DI + h * 64 + pp;
        const float* dt = DT + (size_t)b * SEQ * NH + h;
        float st[16];
#pragma unroll
        for (int i = 0; i < 16; ++i) st[i] = 0.f;
        for (int t0 = 0; t0 < SEQ; t0 += 64) {
#pragma unroll 4
            for (int tt = 0; tt < 64; ++tt) {
                const int t = t0 + tt;
                const float dtv = dt[(size_t)t * NH], xv = bf2f(xs[(size_t)t * DI]), zv = bf2f(zs[(size_t)t * DI]);
                f32x4 B0, B1, B2, B3, C0, C1, C2, C3;
                unpack8(*(const u32x4*)(Bs + (size_t)t * 2048), B0, B1); unpack8(*(const u32x4*)(Bs + (size_t)t * 2048 + 8), B2, B3);
                unpack8(*(const u32x4*)(Cs + (size_t)t * 2048), C0, C1); unpack8(*(const u32x4*)(Cs + (size_t)t * 2048 + 8), C2, C3);
                const float dA = __expf(dtv * a), xdt = xv * dtv; float y = 0.f;
#pragma unroll
                for (int i = 0; i < 4; ++i) {
                    st[i] = dA * st[i] + xdt * B0[i]; y += C0[i] * st[i];
                    st[4 + i] = dA * st[4 + i] + xdt * B1[i]; y += C1[i] * st[4 + i];
                    st[8 + i] = dA * st[8 + i] + xdt * B2[i]; y += C2[i] * st[8 + i];
                    st[12 + i] = dA * st[12 + i] + xdt * B3[i]; y += C3[i] * st[12 + i]; }
                y += __shfl_xor(y, 1); y += __shfl_xor(y, 2); y += __shfl_xor(y, 4);
                y += Dk * xv;
                const float yz = y * zv;
                if (ng == 0) zs[(size_t)t * DI] = (bf16_t)f2bf(yz);
                float sq = (ng == 0) ? yz * yz : 0.f;
                sq += __shfl_xor(sq, 8); sq += __shfl_xor(sq, 16); sq += __shfl_xor(sq, 32);
                if (lane == 0) part[tt * 8 + wave] = sq;
            }
            __syncthreads();
            if (tid < 64) { float s = 0.f;
#pragma unroll
                for (int w = 0; w < 8; ++w) s += part[tid * 8 + w];
                SSQH[(size_t)(b * SEQ + t0 + tid) * NH + h] = s; }
            __syncthreads();
        }
    }
}

typedef short s16x4 __attribute__((ext_vector_type(4)));
constexpr int SS_RSB = 272, SS_RSX = 144;
constexpr int SS_C = 0, SS_B = 34816, SS_X = 69632, SS_XW = 88064, SS_S = 106496, SS_SC = 123904, SS_M = 125952, SS_END = 160768;
__device__ __forceinline__ bf16x8 tr_frag(LAS unsigned char* lds, int addr, int step) {
    const s16x4 lo = __builtin_amdgcn_ds_read_tr16_b64_v4i16((LAS s16x4*)(lds + addr));
    const s16x4 hi = __builtin_amdgcn_ds_read_tr16_b64_v4i16((LAS s16x4*)(lds + addr + step));
    return __builtin_shufflevector(lo, hi, 0, 1, 2, 3, 4, 5, 6, 7);
}
#define MFMA16(a, b, c) __builtin_amdgcn_mfma_f32_16x16x32_bf16(a, b, c, 0, 0, 0)
#define WG_BAR() do { asm volatile("s_waitcnt lgkmcnt(0)" ::: "memory"); __builtin_amdgcn_s_barrier(); asm volatile("" ::: "memory"); } while (0)
__device__ __forceinline__ void phase_ssd_chunk(const Params& p, LAS unsigned char* lds) {
    const int tid = threadIdx.x, w = __builtin_amdgcn_readfirstlane(tid >> 6), lane = tid & 63, fr = lane & 15, g4 = lane >> 4, q = fr >> 2, pq = fr & 3;
    const bf16_t* XS = (const bf16_t*)p.out; const bf16_t* BCS = (const bf16_t*)(p.ws + OFF_BCS); bf16_t* ZS = (bf16_t*)(p.ws + OFF_ZS);
    const float* DT = (const float*)(p.ws + OFF_DT); float* SSQH = (float*)(p.ws + OFF_SSQH);
    LAS float* scal = (LAS float*)(lds + SS_SC);
    const int l = 16 * w + fr;
    for (int item = blockIdx.x; item < 256; item += gridDim.x) {
        const int b = item >> 6, h = item & 63, grp = h >> 3;
        const float a = -__expf(p.a_log[h]), Dk = p.d_skip[h];
        f32x4 accS[4];
#pragma unroll
        for (int i = 0; i < 4; ++i) accS[i] = (f32x4){0.f, 0.f, 0.f, 0.f};
        u32x4 pb[4], pc[4], px[2]; float d0 = 0.f, d1 = 0.f;
        const bf16_t* bsrc = BCS + (size_t)(b * SEQ + (tid >> 4)) * 2048 + grp * 128 + (tid & 15) * 8;
        const bf16_t* xsrc = XS + (size_t)(b * SEQ + (tid >> 3)) * DI + h * 64 + (tid & 7) * 8;
        const float* dsrc = DT + (size_t)(b * SEQ + lane) * NH + h;
#define SSD_PREFETCH(c_) do { const size_t ro_ = (size_t)(c_) * 128; \
            _Pragma("unroll") for (int i = 0; i < 4; ++i) { pb[i] = *(const u32x4*)(bsrc + (ro_ + 32 * i) * 2048); pc[i] = *(const u32x4*)(bsrc + (ro_ + 32 * i) * 2048 + 1024); } \
            _Pragma("unroll") for (int i = 0; i < 2; ++i) px[i] = *(const u32x4*)(xsrc + (ro_ + 64 * i) * DI); \
            if (w == 0) { d0 = dsrc[ro_ * NH]; d1 = dsrc[(ro_ + 64) * NH]; } } while (0)
#define SSD_SCAN(buf_) do { if (w == 0) { float s0 = d0 * a, s1 = d1 * a; \
            _Pragma("unroll") for (int o = 1; o < 64; o <<= 1) { const float t0 = __shfl_up(s0, o), t1 = __shfl_up(s1, o); if (lane >= o) { s0 += t0; s1 += t1; } } \
            s1 += __shfl(s0, 63); LAS float* cs_ = scal + (buf_) * 256; cs_[lane] = s0; cs_[64 + lane] = s1; cs_[128 + lane] = d0; cs_[192 + lane] = d1; } } while (0)
        SSD_PREFETCH(0);
        for (int i = tid; i < 64 * SS_RSB / 16; i += 512) *(LAS u32x4*)(lds + SS_S + i * 16) = (u32x4){0u, 0u, 0u, 0u};
        SSD_SCAN(0);
        WG_BAR();
        for (int c = 0; c < 32; ++c) {
            const int tok0 = b * SEQ + c * 128;
            LAS float* csA = scal + (c & 1) * 256; LAS float* dtA = csA + 128;
            const float csend = csA[127];
#pragma unroll
            for (int i = 0; i < 4; ++i) { const int row = (tid >> 4) + 32 * i, ch = tid & 15; *(LAS u32x4*)(lds + SS_B + row * SS_RSB + ch * 16) = pb[i]; *(LAS u32x4*)(lds + SS_C + row * SS_RSB + ch * 16) = pc[i]; }
#pragma unroll
            for (int i = 0; i < 2; ++i) { const int row = (tid >> 3) + 64 * i, ch = tid & 7; *(LAS u32x4*)(lds + SS_X + row * SS_RSX + ch * 16) = px[i];
                const float wl = __expf(csend - csA[row]) * dtA[row]; f32x4 v0, v1; unpack8(px[i], v0, v1); v0 *= wl; v1 *= wl; *(LAS u32x4*)(lds + SS_XW + row * SS_RSX + ch * 16) = pack8(v0, v1); }
            WG_BAR();
            if (c + 1 < 32) SSD_PREFETCH(c + 1);
            const size_t tok = (size_t)(tok0 + l);
            bf16_t* zp = ZS + tok * DI + h * 64 + 4 * g4;
            u32x2 z2[4];
#pragma unroll
            for (int pt = 0; pt < 4; ++pt) z2[pt] = *(const u32x2*)(zp + 16 * pt);
            const float csl = csA[l];
            bf16x8 cf[4];
#pragma unroll
            for (int ks = 0; ks < 4; ++ks) cf[ks] = *(const LAS bf16x8*)(lds + SS_C + l * SS_RSB + (4 * ks + g4) * 16);
            f32x4 accY[4];
#pragma unroll
            for (int pt = 0; pt < 4; ++pt) { accY[pt] = (f32x4){0.f, 0.f, 0.f, 0.f};
#pragma unroll
                for (int ks = 0; ks < 4; ++ks) { const bf16x8 sf = *(const LAS bf16x8*)(lds + SS_S + (16 * pt + fr) * SS_RSB + (4 * ks + g4) * 16); accY[pt] = MFMA16(sf, cf[ks], accY[pt]); } }
            { const float el = __expf(csl);
#pragma unroll
              for (int pt = 0; pt < 4; ++pt) accY[pt] *= el; }
#pragma unroll
            for (int st = 0; st < 8; ++st) {
                if (st <= w) { f32x4 a1 = (f32x4){0.f, 0.f, 0.f, 0.f};
#pragma unroll
                    for (int ks = 0; ks < 4; ++ks) { const bf16x8 bf = *(const LAS bf16x8*)(lds + SS_B + (16 * st + fr) * SS_RSB + (4 * ks + g4) * 16); a1 = MFMA16(bf, cf[ks], a1); }
                    const f32x4 cs4 = *(const LAS f32x4*)(csA + 16 * st + 4 * g4), dt4 = *(const LAS f32x4*)(dtA + 16 * st + 4 * g4); float v[4];
#pragma unroll
                    for (int r = 0; r < 4; ++r) { const int s = 16 * st + 4 * g4 + r; v[r] = (s <= l) ? a1[r] * __expf(fminf(csl - cs4[r], 0.f)) * dt4[r] : 0.f; }
                    u32x2 pk; pk.x = pk2(v[0], v[1]); pk.y = pk2(v[2], v[3]); *(LAS u32x2*)(lds + SS_M + l * SS_RSB + (16 * st + 4 * g4) * 2) = pk; }
                else if (st == w + 1 && (w & 1) == 0) { *(LAS u32x2*)(lds + SS_M + l * SS_RSB + (16 * st + 4 * g4) * 2) = (u32x2){0u, 0u}; } }
            { const float dec = __expf(csend);
#pragma unroll
              for (int pt = 0; pt < 4; ++pt) accS[pt] *= dec;
#pragma unroll
              for (int ks = 0; ks < 4; ++ks) { const bf16x8 btf = tr_frag(lds, SS_B + (32 * ks + 8 * g4 + q) * SS_RSB + (16 * w + 4 * pq) * 2, 4 * SS_RSB);
#pragma unroll
                  for (int pt = 0; pt < 4; ++pt) { const bf16x8 xwf = tr_frag(lds, SS_XW + (32 * ks + 8 * g4 + q) * SS_RSX + (16 * pt + 4 * pq) * 2, 4 * SS_RSX); accS[pt] = MFMA16(btf, xwf, accS[pt]); } } }
            if (c + 1 < 32) SSD_SCAN((c + 1) & 1);
#pragma unroll
            for (int ks = 0; ks < 4; ++ks) { if (2 * ks <= w) { const bf16x8 mf = *(const LAS bf16x8*)(lds + SS_M + l * SS_RSB + (4 * ks + g4) * 16);
#pragma unroll
                for (int pt = 0; pt < 4; ++pt) { const bf16x8 xf = tr_frag(lds, SS_X + (32 * ks + 8 * g4 + q) * SS_RSX + (16 * pt + 4 * pq) * 2, 4 * SS_RSX); accY[pt] = MFMA16(xf, mf, accY[pt]); } } }
            { float sq = 0.f;
#pragma unroll
              for (int pt = 0; pt < 4; ++pt) { const u32x2 x2 = *(const LAS u32x2*)(lds + SS_X + l * SS_RSX + (16 * pt + 4 * g4) * 2);
                  const float y0 = (accY[pt][0] + Dk * bflo(x2.x)) * bflo(z2[pt].x), y1 = (accY[pt][1] + Dk * bfhi(x2.x)) * bfhi(z2[pt].x), y2 = (accY[pt][2] + Dk * bflo(x2.y)) * bflo(z2[pt].y), y3 = (accY[pt][3] + Dk * bfhi(x2.y)) * bfhi(z2[pt].y);
                  sq += y0 * y0 + y1 * y1 + y2 * y2 + y3 * y3; u32x2 o; o.x = pk2(y0, y1); o.y = pk2(y2, y3); *(u32x2*)(zp + 16 * pt) = o; }
              sq += __shfl_xor(sq, 16); sq += __shfl_xor(sq, 32);
              if (g4 == 0) SSQH[tok * NH + h] = sq; }
            WG_BAR();
#pragma unroll
            for (int pt = 0; pt < 4; ++pt) { u32x2 pk; pk.x = pk2(accS[pt][0], accS[pt][1]); pk.y = pk2(accS[pt][2], accS[pt][3]); *(LAS u32x2*)(lds + SS_S + (16 * pt + fr) * SS_RSB + (16 * w + 4 * g4) * 2) = pk; }
        }
        WG_BAR();
#undef SSD_PREFETCH
#undef SSD_SCAN
    }
}

__device__ __forceinline__ void phase_gnorm(const Params& p) {
    bf16_t* ZS = (bf16_t*)(p.ws + OFF_ZS); const float* SSQH = (const float*)(p.ws + OFF_SSQH);
    const int total = NTOK * 512 / 4;
    for (int idx = blockIdx.x * 512 + threadIdx.x; idx < total; idx += gridDim.x * 512) {
        const int t0 = (idx >> 9) * 4, cg8 = idx & 511, c = cg8 * 8, g = cg8 >> 6;
        u32x4 raw[4]; f32x4 s0[4], s1[4];
#pragma unroll
        for (int i = 0; i < 4; ++i) { raw[i] = *(const u32x4*)(ZS + (size_t)(t0 + i) * DI + c); s0[i] = *(const f32x4*)(SSQH + (size_t)(t0 + i) * NH + g * 8); s1[i] = *(const f32x4*)(SSQH + (size_t)(t0 + i) * NH + g * 8 + 4); }
        const f32x4 g0 = *(const f32x4*)(p.ssm_norm_g + c), g1 = *(const f32x4*)(p.ssm_norm_g + c + 4);
#pragma unroll
        for (int i = 0; i < 4; ++i) { const float ss = s0[i][0] + s0[i][1] + s0[i][2] + s0[i][3] + s1[i][0] + s1[i][1] + s1[i][2] + s1[i][3]; const float r = rsqrtf(ss * (1.0f / 512.0f) + EPS);
            f32x4 v0, v1; unpack8(raw[i], v0, v1); v0 = v0 * r * g0; v1 = v1 * r * g1; *(u32x4*)(ZS + (size_t)(t0 + i) * DI + c) = pack8(v0, v1); }
    }
}

__device__ __forceinline__ void phase_mixa(const Params& p) {
    const bf16_t* BB = (const bf16_t*)(p.ws + OFF_BB); const bf16_t* BC = (const bf16_t*)(p.ws + OFF_BC); const bf16_t* BH = (const bf16_t*)(p.ws + OFF_BH); bf16_t* YA = (bf16_t*)(p.ws + OFF_U);
    constexpr int TS = 8; const int total = (NTOK / TS) * 256;
    for (int idx = blockIdx.x * 512 + threadIdx.x; idx < total; idx += gridDim.x * 512) {
        const int t0 = (idx >> 8) * TS, c = (idx & 255) * 8; const bool first = (t0 & (SEQ - 1)) == 0;
        u32x4 rc[TS + 2], rh[TS + 2], rb[TS];
#pragma unroll
        for (int r = 0; r < TS + 2; ++r) { const size_t o = (size_t)(t0 - 2 + r) * DM + c; const bool z = (r < 2 && first); rc[r] = z ? (u32x4){0u, 0u, 0u, 0u} : *(const u32x4*)(BC + o); rh[r] = z ? (u32x4){0u, 0u, 0u, 0u} : *(const u32x4*)(BH + o); }
#pragma unroll
        for (int i = 0; i < TS; ++i) rb[i] = *(const u32x4*)(BB + (size_t)(t0 + i) * DM + c);
        f32x4 w0[3], w1[3];
#pragma unroll
        for (int j = 0; j < 3; ++j) { w0[j] = *(const f32x4*)(p.conv_a_w + j * DM + c); w1[j] = *(const f32x4*)(p.conv_a_w + j * DM + c + 4); }
        f32x4 q0[3], q1[3];
#pragma unroll
        for (int r = 0; r < 2; ++r) { f32x4 c0, c1, h0, h1; unpack8(rc[r], c0, c1); unpack8(rh[r], h0, h1); q0[r] = c0 * h0; q1[r] = c1 * h1; }
#pragma unroll
        for (int i = 0; i < TS; ++i) { { f32x4 c0, c1, h0, h1; unpack8(rc[i + 2], c0, c1); unpack8(rh[i + 2], h0, h1); q0[2] = c0 * h0; q1[2] = c1 * h1; }
            f32x4 a0 = w0[0] * q0[0] + w0[1] * q0[1] + w0[2] * q0[2], a1 = w1[0] * q1[0] + w1[1] * q1[1] + w1[2] * q1[2];
            f32x4 b0, b1; unpack8(rb[i], b0, b1);
            *(u32x4*)(YA + (size_t)(t0 + i) * DM + c) = pack8(a0 * b0, a1 * b1);
            q0[0] = q0[1]; q0[1] = q0[2]; q1[0] = q1[1]; q1[1] = q1[2]; }
    }
}

__device__ __forceinline__ void phase_final(const Params& p) {
    const float* SSQ2 = (const float*)(p.ws + OFF_SSQ2);
    const int total = NTOK * 512 / 4;
    for (int idx = blockIdx.x * 512 + threadIdx.x; idx < total; idx += gridDim.x * 512) {
        const int t0 = (idx >> 9) * 4, c = (idx & 511) * 4;
        f32x4 v[4]; float r[4];
#pragma unroll
        for (int i = 0; i < 4; ++i) { v[i] = *(const f32x4*)(p.out + (size_t)(t0 + i) * DM + c); r[i] = SSQ2[t0 + i]; }
        const f32x4 g = *(const f32x4*)(p.norm_final_g + c);
#pragma unroll
        for (int i = 0; i < 4; ++i) *(f32x4*)(p.out + (size_t)(t0 + i) * DM + c) = v[i] * rsqrtf(r[i] * (1.0f / DM) + EPS) * g;
    }
}

constexpr int NPHASE = 11;
template <int PH> __device__ __forceinline__ void run_phase(const Params& p, LAS unsigned char* lds) {
    unsigned char* ws = p.ws;
    pg8::StaticOrder S; pg8::Gemm g;
    if constexpr (PH == 0) { phase_prep(p, lds); }
    else if constexpr (PH == 1) {
        g.A = (const bf16_t*)(ws + OFF_U); g.Bt = (const bf16_t*)(ws + OFF_WIN) + (size_t)40 * 256 * DM; g.M = NTOK; g.N = 41 * 256; g.K = DM; S.init(g.M, g.N, gridDim.x, blockIdx.x);
        EpiRoute E{(bf16_t*)p.out, (bf16_t*)p.out + (size_t)NTOK * DM, (bf16_t*)(ws + OFF_BB), (bf16_t*)(ws + OFF_BC), (bf16_t*)(ws + OFF_BH), (bf16_t*)(ws + OFF_ZS), (bf16_t*)(ws + OFF_XBC), (float*)(ws + OFF_DT), p.dt_bias, 40};
        pg8::gemm_phase(lds, g, S, E); }
    else if constexpr (PH == 2) { phase_ssmconv(p); }
    else if constexpr (PH == 3) { phase_ssd_chunk(p, lds); }
    else if constexpr (PH == 4) {
        g.A = (const bf16_t*)(ws + OFF_U); g.Bt = (const bf16_t*)(ws + OFF_WIN); g.M = NTOK; g.N = 40 * 256; g.K = DM; S.init(g.M, g.N, gridDim.x, blockIdx.x);
        EpiRoute E{(bf16_t*)p.out, (bf16_t*)p.out + (size_t)NTOK * DM, (bf16_t*)(ws + OFF_BB), (bf16_t*)(ws + OFF_BC), (bf16_t*)(ws + OFF_BH), (bf16_t*)(ws + OFF_ZS), (bf16_t*)(ws + OFF_XBC), (float*)(ws + OFF_DT), p.dt_bias, 0};
        pg8::gemm_phase(lds, g, S, E);
        phase_gnorm(p); }
    else if constexpr (PH == 5) { phase_mixa(p); }
    else if constexpr (PH == 6) {
        g.A = (const bf16_t*)(ws + OFF_U); g.Bt = (const bf16_t*)(ws + OFF_WOA); g.M = NTOK; g.N = DM; g.K = DM; S.init(g.M, g.N, gridDim.x, blockIdx.x);
        EpiGate<false> Ea{(const bf16_t*)p.out, nullptr, (bf16_t*)(ws + OFF_BB)};
        pg8::gemm_phase(lds, g, S, Ea);
        g.A = (const bf16_t*)(ws + OFF_ZS); g.Bt = (const bf16_t*)(ws + OFF_WOS); g.K = DI;
        EpiGate<true> Eb{(const bf16_t*)p.out + (size_t)NTOK * DM, (const bf16_t*)(ws + OFF_BB), (bf16_t*)(ws + OFF_BC)};
        pg8::gemm_phase(lds, g, S, Eb); }
    else if constexpr (PH == 7) {
        g.A = (const bf16_t*)(ws + OFF_BC); g.Bt = (const bf16_t*)(ws + OFF_WO); g.M = NTOK; g.N = DM; g.K = DM; S.init(g.M, g.N, gridDim.x, blockIdx.x);
        EpiRes<true> E{p.x, p.out, (bf16_t*)(ws + OFF_BH), (float*)(ws + OFF_SSQ1)};
        pg8::gemm_phase(lds, g, S, E); }
    else if constexpr (PH == 8) {
        g.A = (const bf16_t*)(ws + OFF_BH); g.Bt = (const bf16_t*)(ws + OFF_WGU); g.M = NTOK; g.N = 2 * DFF; g.K = DM; S.init(g.M, g.N, gridDim.x, blockIdx.x);
        EpiSwiglu E{(const float*)(ws + OFF_SSQ1), (bf16_t*)(ws + OFF_ZS)};
        pg8::gemm_phase(lds, g, S, E); }
    else if constexpr (PH == 9) {
        g.A = (const bf16_t*)(ws + OFF_ZS); g.Bt = (const bf16_t*)(ws + OFF_WDN); g.M = NTOK; g.N = DM; g.K = DFF; S.init(g.M, g.N, gridDim.x, blockIdx.x);
        EpiRes<false> E{p.out, p.out, nullptr, (float*)(ws + OFF_SSQ2)};
        pg8::gemm_phase(lds, g, S, E); }
    else if constexpr (PH == 10) { phase_final(p); }
}

template <int PH> __global__ void __launch_bounds__(512, 2) k_one(Params p) {
    extern __shared__ __attribute__((aligned(16))) unsigned char lds_raw[];
    run_phase<PH>(p, (LAS unsigned char*)lds_raw);
}

#ifndef PROBE_MASK
#define PROBE_MASK 0
#endif
__global__ void __launch_bounds__(512, 2) k_mega(Params p) {
    extern __shared__ __attribute__((aligned(16))) unsigned char lds_raw[];
    LAS unsigned char* lds = (LAS unsigned char*)lds_raw;
    cg::grid_group grid = cg::this_grid();
    unsigned long long spin = 0, t0 = 0;
#define PH_RUN(i, SYNC) do { if (PROBE_MASK) t0 = __builtin_amdgcn_s_memrealtime(); run_phase<i>(p, lds); if (SYNC) grid.sync(); \
        if (PROBE_MASK & (1 << i)) spin += __builtin_amdgcn_s_memrealtime() - t0; } while (0)
    PH_RUN(0, 1); PH_RUN(1, 1); PH_RUN(2, 1); PH_RUN(3, 1); PH_RUN(4, 1); PH_RUN(5, 1); PH_RUN(6, 1); PH_RUN(7, 1); PH_RUN(8, 1); PH_RUN(9, 1); PH_RUN(10, 0);
    if (PROBE_MASK && blockIdx.x == 0) { t0 = __builtin_amdgcn_s_memrealtime(); while (__builtin_amdgcn_s_memrealtime() - t0 < spin) __builtin_amdgcn_s_sleep(8); }
}

constexpr int LDS_BYTES = SS_END;

template <int PH> static void launch_one(const Params& p, int grid, hipStream_t stream) {
    static bool attr = false;
    if (!attr) { (void)hipFuncSetAttribute((const void*)k_one<PH>, hipFuncAttributeMaxDynamicSharedMemorySize, LDS_BYTES); attr = true; }
    hipLaunchKernelGGL(k_one<PH>, dim3(grid), dim3(512), LDS_BYTES, stream, p);
}

extern "C" void kernel_launch(void* const* d_in, const int* in_sizes, int n_in, void* d_out, int out_size, void* d_ws, size_t ws_size, hipStream_t stream) {
    static int grid = 0;
    if (grid == 0) {
        if (n_in != 18 || out_size != NTOK * DM || ws_size < WS_END) { fprintf(stderr, "kernel_launch: unexpected shapes: n_in %d out %d ws %zu (need %zu)\n", n_in, out_size, ws_size, (size_t)WS_END); grid = -1; return; }
        int dev = 0, cus = 0, per_cu = 0;
        (void)hipGetDevice(&dev); (void)hipDeviceGetAttribute(&cus, hipDeviceAttributeMultiprocessorCount, dev);
        (void)hipFuncSetAttribute((const void*)k_mega, hipFuncAttributeMaxDynamicSharedMemorySize, LDS_BYTES);
        (void)hipOccupancyMaxActiveBlocksPerMultiprocessor(&per_cu, (const void*)k_mega, 512, LDS_BYTES);
        if (per_cu < 1) { fprintf(stderr, "kernel_launch: occupancy query says %d blocks per CU\n", per_cu); per_cu = 1; }
        (void)hipGetLastError();
        grid = cus * per_cu;
        fprintf(stderr, "kernel_launch: cus %d per_cu %d grid %d ws %zu\n", cus, per_cu, grid, ws_size);
    }
    if (grid < 0) return;
    Params p{};
    const float** pp = (const float**)&p;
    for (int i = 0; i < 18; ++i) pp[i] = (const float*)d_in[i];
    p.out = (float*)d_out; p.ws = (unsigned char*)d_ws;
#if MEGA
    void* args[] = {&p};
    hipError_t e = hipLaunchCooperativeKernel((const void*)k_mega, dim3(grid), dim3(512), args, LDS_BYTES, stream);
    if (e != hipSuccess) fprintf(stderr, "cooperative launch failed: %s (grid %d)\n", hipGetErrorString(e), grid);
#else
    launch_one<0>(p, grid, stream); launch_one<1>(p, grid, stream); launch_one<2>(p, grid, stream); launch_one<3>(p, grid, stream); launch_one<4>(p, grid, stream); launch_one<5>(p, grid, stream);
    launch_one<6>(p, grid, stream); launch_one<7>(p, grid, stream); launch_one<8>(p, grid, stream); launch_one<9>(p, grid, stream); launch_one<10>(p, grid, stream);
#endif
}
```

```cpp
#include <hip/hip_runtime.h>
#include <hip/hip_cooperative_groups.h>
#include <cstdio>
namespace cg = cooperative_groups;

#ifndef MEGA
#define MEGA 1
#endif

#define LAS __attribute__((address_space(3)))
typedef unsigned short bf16_t;
typedef short bf16x8 __attribute__((ext_vector_type(8)));
typedef float f32x4 __attribute__((ext_vector_type(4)));
typedef unsigned u32x4 __attribute__((ext_vector_type(4)));
typedef unsigned u32x2 __attribute__((ext_vector_type(2)));

constexpr int DM = 2048, NTOK = 16384, SEQ = 4096;
constexpr int IN_COLS = 20544, IN_TILES = 81;
constexpr int DI = 4096, NH = 64, HD = 64, NG = 8, NST = 128, CONVD = 6144;
constexpr int DFF = 5632;
constexpr float EPS = 1e-6f;

constexpr size_t MiB = 1024ull * 1024ull;
constexpr size_t OFF_WIN = 0;
constexpr size_t OFF_WOA = 81 * MiB;
constexpr size_t OFF_WOS = 89 * MiB;
constexpr size_t OFF_WO  = 105 * MiB;
constexpr size_t OFF_WGU = 113 * MiB;
constexpr size_t OFF_WDN = 157 * MiB;
constexpr size_t OFF_ZS  = 179 * MiB;
constexpr size_t OFF_U   = 307 * MiB;
constexpr size_t OFF_XBC = 371 * MiB;
constexpr size_t OFF_BB  = 371 * MiB, OFF_BC = 435 * MiB, OFF_BH = 499 * MiB;
constexpr size_t OFF_DT  = 563 * MiB;
constexpr size_t OFF_SSQH = 567 * MiB;
constexpr size_t OFF_SSQ1 = 571 * MiB;
constexpr size_t OFF_SSQ2 = 571 * MiB + 65536;
constexpr size_t OFF_BCS = 572 * MiB;
constexpr size_t OFF_BAR = 636 * MiB;
constexpr size_t WS_END = 637 * MiB;

struct Params {
    const float *x, *norm_mix_g, *w_in, *conv_a_w, *w_out_a, *ssm_conv_w, *ssm_conv_b, *dt_bias, *a_log, *d_skip, *ssm_norm_g, *w_out_ssm, *w_o, *norm_ffn_g, *w_ffn_gate, *w_ffn_up,
        *w_ffn_down, *norm_final_g;
    float* out; unsigned char* ws;
};

__device__ __forceinline__ unsigned f2bf(float f) { unsigned u = __builtin_bit_cast(unsigned, f); return (u + 0x7fffu + ((u >> 16) & 1u)) >> 16; }
__device__ __forceinline__ unsigned pk2(float lo, float hi) { return f2bf(lo) | (f2bf(hi) << 16); }
__device__ __forceinline__ float bflo(unsigned w) { return __builtin_bit_cast(float, w << 16); }
__device__ __forceinline__ float bfhi(unsigned w) { return __builtin_bit_cast(float, w & 0xffff0000u); }
__device__ __forceinline__ float bf2f(bf16_t v) { return __builtin_bit_cast(float, ((unsigned)v) << 16); }
__device__ __forceinline__ float sigmoidf_(float v) { return __builtin_amdgcn_rcpf(1.0f + __expf(-v)); }
__device__ __forceinline__ float siluf_(float v) { return v * sigmoidf_(v); }
__device__ __forceinline__ float softplusf_(float v) { return fmaxf(v, 0.f) + log1pf(__expf(-fabsf(v))); }
__device__ __forceinline__ u32x4 pack8(const f32x4& a, const f32x4& b) { u32x4 w; w.x = pk2(a[0], a[1]); w.y = pk2(a[2], a[3]); w.z = pk2(b[0], b[1]); w.w = pk2(b[2], b[3]); return w; }
__device__ __forceinline__ void unpack8(const u32x4& w, f32x4& a, f32x4& b) { a[0] = bflo(w.x); a[1] = bfhi(w.x); a[2] = bflo(w.y); a[3] = bfhi(w.y); b[0] = bflo(w.z); b[1] = bfhi(w.z); b[2] = bflo(w.w); b[3] = bfhi(w.w); }

namespace pg8 {
constexpr int BM = 256, BK = 64, HALF = 128, HTB = HALF * BK * 2, STAGE_BYTES = 8 * HTB, NXCD = 8, WGM = 8;
__host__ __device__ __forceinline__ int lds_byte(int r, int c) { const int st = (r >> 4) * 2 + (c >> 5), rr = r & 15, cc = c & 31, ob = rr * 64 + cc * 2; return st * 1024 + (ob ^ (((ob >> 9) & 1) << 5)); }
__host__ __device__ __forceinline__ void stage_rc(int b, int& R, int& C) { const int st = b / 1024, sb = b % 1024, swz = sb ^ (((sb >> 9) & 1) << 5); R = (st >> 1) * 16 + swz / 64; C = (st & 1) * 32 + (swz % 64) / 2; }
__host__ __device__ __forceinline__ int perm32(int rho) { const int n = rho >> 4, i = rho & 15; return 8 * (i >> 2) + 4 * n + (i & 3); }
struct Unit { int pm, pn; };
struct Gemm { const bf16_t* A; const bf16_t* Bt; int M, N, K; };
struct StaticOrder {
    int nM, nN, nwg, G, c;
    __host__ __device__ void init(int M, int N, int G_, int c_) { nM = M / BM; nN = N / BM; nwg = nM * nN; G = G_; c = c_; }
    __host__ __device__ bool next(int i, Unit& u) const {
        const long L = (long)i * G + c; if (L >= nwg) return false;
        int wgid = (int)L; { const int q = nwg / NXCD, r = nwg % NXCD, xcd = wgid % NXCD, off = wgid / NXCD; wgid = (xcd < r ? xcd * (q + 1) : r * (q + 1) + (xcd - r) * q) + off; }
        const int nig = WGM * nN, gid = wgid / nig, fm = gid * WGM, gsz = (nM - fm) < WGM ? (nM - fm) : WGM;
        u.pm = fm + ((wgid % nig) % gsz); u.pn = (wgid % nig) / gsz; return true;
    }
};

template <class Epi>
__device__ __forceinline__ void gemm_phase(LAS unsigned char* lds, const Gemm g, const StaticOrder& S, const Epi& E) {
    const int tid = threadIdx.x, wid = __builtin_amdgcn_readfirstlane(tid >> 6), lane = tid & 63, wr = wid >> 2, wc = wid & 3, fr = lane & 15, fq = lane >> 4;
    const int K = g.K, nt = K / BK;
    unsigned voffA[2];
#pragma unroll
    for (int i = 0; i < 2; ++i) { int R, C; stage_rc(tid * 16 + i * 8192, R, C); voffA[i] = (unsigned)(R * K + C) * 2u; }
    const size_t kstep = (size_t)(BK * 2);
    const size_t hstep = (size_t)HALF * K * 2;
    const size_t tstep = 2 * hstep;
    const unsigned ldsw = (unsigned)wid * 1024u;
    const int aoff = lds_byte(wr * 64 + fr, fq * 8), boff = lds_byte(wc * 32 + fr, fq * 8);
#define PG8_SA(b, h) (((b) * 2 + (h)) * HTB)
#define PG8_SB(b, h) ((4 + (b) * 2 + (h)) * HTB)
#define PG8_STAGE(bufoff, gbase, voff) do { _Pragma("unroll") for (int _i = 0; _i < 2; ++_i) \
        __builtin_amdgcn_global_load_lds((const unsigned*)((const char*)(gbase) + (voff)[_i]), (LAS unsigned*)(lds + (bufoff) + ldsw + _i * 8192), 16, 0, 0); } while (0)
#define PG8_LDA(dst, b, h) do { _Pragma("unroll") for (int m = 0; m < 4; ++m) _Pragma("unroll") for (int k = 0; k < 2; ++k) dst[m][k] = *(const LAS bf16x8*)(lds + PG8_SA(b, h) + aoff + m * 2048 + k * 1024); } while (0)
#define PG8_LDB(dst, b, h) do { _Pragma("unroll") for (int n = 0; n < 2; ++n) _Pragma("unroll") for (int k = 0; k < 2; ++k) dst[n][k] = *(const LAS bf16x8*)(lds + PG8_SB(b, h) + boff + n * 2048 + k * 1024); } while (0)
#define PG8_MMA(ai, bj, At, Bt) do { __builtin_amdgcn_s_setprio(1); _Pragma("unroll") for (int m = 0; m < 4; ++m) _Pragma("unroll") for (int n = 0; n < 2; ++n) _Pragma("unroll") for (int k = 0; k < 2; ++k) \
        acc[ai][bj][m][n] = __builtin_amdgcn_mfma_f32_16x16x32_bf16(Bt[n][k], At[m][k], acc[ai][bj][m][n], 0, 0, 0); __builtin_amdgcn_s_setprio(0); } while (0)
#define PG8_WAIT_V(n) asm volatile("s_waitcnt vmcnt(" #n ")" ::: "memory")
#define PG8_WAIT_L(n) asm volatile("s_waitcnt lgkmcnt(" #n ")" ::: "memory")
#define PG8_BAR __builtin_amdgcn_s_barrier()
#define PG8_SCHED __builtin_amdgcn_sched_barrier(0)
    Unit cur, nxt; int ui = 0;
    if (!S.next(0, cur)) return;
    f32x4 acc[2][2][4][2];
#pragma unroll
    for (int a = 0; a < 2; ++a)
#pragma unroll
        for (int b = 0; b < 2; ++b)
#pragma unroll
            for (int m = 0; m < 4; ++m)
#pragma unroll
                for (int n = 0; n < 2; ++n) acc[a][b][m][n] = (f32x4){0.f, 0.f, 0.f, 0.f};
    bf16x8 At[4][2], B0[2][2], B1[2][2];
    const char* cA = (const char*)g.A + (size_t)cur.pm * tstep; const char* cB = (const char*)g.Bt + (size_t)cur.pn * tstep;
    PG8_STAGE(PG8_SB(0, 0), cB, voffA); PG8_STAGE(PG8_SA(0, 0), cA, voffA); PG8_STAGE(PG8_SB(0, 1), cB + hstep, voffA); PG8_STAGE(PG8_SA(0, 1), cA + hstep, voffA);
    if (wr == 1) PG8_BAR;
    PG8_WAIT_V(4); PG8_BAR;
    PG8_STAGE(PG8_SB(1, 0), cB + kstep, voffA); PG8_STAGE(PG8_SA(1, 0), cA + kstep, voffA); PG8_STAGE(PG8_SB(1, 1), cB + hstep + kstep, voffA);
    PG8_WAIT_V(6); PG8_BAR;
    for (;;) {
        const bool has_next = S.next(ui + 1, nxt);
        const char* nA = has_next ? (const char*)g.A + (size_t)nxt.pm * tstep : cA; const char* nB = has_next ? (const char*)g.Bt + (size_t)nxt.pn * tstep : cB;
        for (int t = 0; t < nt; t += 2) {
            const bool last = (t == nt - 2);
            const char* a1 = cA + (size_t)(t + 1) * kstep;
            const char* a2 = last ? nA : cA + (size_t)(t + 2) * kstep; const char* b2 = last ? nB : cB + (size_t)(t + 2) * kstep;
            const char* a3 = a2 + kstep; const char* b3 = b2 + kstep;
            PG8_LDB(B0, 0, 0); PG8_SCHED; PG8_LDA(At, 0, 0); PG8_STAGE(PG8_SA(1, 1), a1 + hstep, voffA);
            PG8_WAIT_L(8); PG8_BAR; PG8_WAIT_L(0); PG8_MMA(0, 0, At, B0); PG8_BAR; PG8_SCHED;
            PG8_LDB(B1, 0, 1); PG8_STAGE(PG8_SB(0, 0), b2, voffA);
            PG8_BAR; PG8_WAIT_L(0); PG8_MMA(0, 1, At, B1); PG8_BAR;
            PG8_LDA(At, 0, 1); PG8_STAGE(PG8_SA(0, 0), a2, voffA);
            PG8_BAR; PG8_WAIT_L(0); PG8_MMA(1, 0, At, B0); PG8_BAR; PG8_SCHED;
            PG8_STAGE(PG8_SB(0, 1), b2 + hstep, voffA);
            PG8_WAIT_V(6); PG8_BAR; PG8_MMA(1, 1, At, B1); PG8_BAR;
            PG8_LDB(B0, 1, 0); PG8_SCHED; PG8_LDA(At, 1, 0); PG8_STAGE(PG8_SA(0, 1), a2 + hstep, voffA);
            PG8_WAIT_L(8); PG8_BAR; PG8_WAIT_L(0); PG8_MMA(0, 0, At, B0); PG8_BAR; PG8_SCHED;
            PG8_LDB(B1, 1, 1); PG8_STAGE(PG8_SB(1, 0), b3, voffA);
            PG8_BAR; PG8_WAIT_L(0); PG8_MMA(0, 1, At, B1); PG8_BAR;
            PG8_LDA(At, 1, 1); PG8_STAGE(PG8_SA(1, 0), a3, voffA);
            PG8_BAR; PG8_WAIT_L(0); PG8_MMA(1, 0, At, B0); PG8_BAR; PG8_SCHED;
            PG8_STAGE(PG8_SB(1, 1), b3 + hstep, voffA);
            PG8_WAIT_V(6); PG8_BAR; PG8_MMA(1, 1, At, B1); PG8_BAR;
        }
        E(acc, cur, wr, wc, fr, fq);
        if (!has_next) break;
#pragma unroll
        for (int a = 0; a < 2; ++a)
#pragma unroll
            for (int b = 0; b < 2; ++b)
#pragma unroll
                for (int m = 0; m < 4; ++m)
#pragma unroll
                    for (int n = 0; n < 2; ++n) acc[a][b][m][n] = (f32x4){0.f, 0.f, 0.f, 0.f};
        cur = nxt; cA = nA; cB = nB; ++ui;
    }
    PG8_WAIT_V(0);
    if (wr == 0) PG8_BAR;
    PG8_BAR;
#undef PG8_SA
#undef PG8_SB
#undef PG8_STAGE
#undef PG8_LDA
#undef PG8_LDB
#undef PG8_MMA
#undef PG8_WAIT_V
#undef PG8_WAIT_L
#undef PG8_BAR
#undef PG8_SCHED
}
}
using pg8::Unit;

struct EpiRoute {
    bf16_t *GA, *GB, *BB, *BC, *BH, *ZS, *XBC; float* DT; const float* dt_bias; int tile0;
    __device__ __forceinline__ void operator()(const f32x4 (&acc)[2][2][4][2], const Unit& u, int wr, int wc, int fr, int fq) const {
        const int gt = u.pn + tile0; const int row0 = u.pm * 256 + wr * 64 + fr;
        if (gt < 80) {
            bf16_t* base; int ldc, cb, act;
            if (gt < 40) { const int r = gt >> 3; base = (r == 0 ? GA : r == 1 ? GB : r == 2 ? BB : r == 3 ? BC : BH); ldc = DM; cb = (gt & 7) * 256; act = r < 2 ? 1 : 0; }
            else if (gt < 56) { base = ZS; ldc = DI; cb = (gt - 40) * 256; act = 2; }
            else { base = XBC; ldc = CONVD; cb = (gt - 56) * 256; act = 0; }
            const int col0 = cb + wc * 32 + 8 * fq;
#pragma unroll
            for (int ai = 0; ai < 2; ++ai)
#pragma unroll
                for (int m = 0; m < 4; ++m) { bf16_t* rowp = base + (size_t)(row0 + ai * 128 + m * 16) * ldc + col0;
#pragma unroll
                    for (int bj = 0; bj < 2; ++bj) { f32x4 v0 = acc[ai][bj][m][0], v1 = acc[ai][bj][m][1];
                        if (act == 1) {
#pragma unroll
                            for (int j = 0; j < 4; ++j) { v0[j] = sigmoidf_(v0[j]); v1[j] = sigmoidf_(v1[j]); } }
                        else if (act == 2) {
#pragma unroll
                            for (int j = 0; j < 4; ++j) { v0[j] = siluf_(v0[j]); v1[j] = siluf_(v1[j]); } }
                        *(u32x4*)(rowp + bj * 128) = pack8(v0, v1); } }
        } else if (wc < 2) {
            const int c0 = wc * 32 + 8 * fq;
            f32x4 b0 = *(const f32x4*)(dt_bias + c0), b1 = *(const f32x4*)(dt_bias + c0 + 4);
#pragma unroll
            for (int ai = 0; ai < 2; ++ai)
#pragma unroll
                for (int m = 0; m < 4; ++m) { float* rowp = DT + (size_t)(row0 + ai * 128 + m * 16) * NH + c0;
                    f32x4 v0 = acc[ai][0][m][0] + b0, v1 = acc[ai][0][m][1] + b1;
#pragma unroll
                    for (int j = 0; j < 4; ++j) { v0[j] = softplusf_(v0[j]); v1[j] = softplusf_(v1[j]); }
                    *(f32x4*)rowp = v0; *(f32x4*)(rowp + 4) = v1; }
        }
    }
};
template <bool ADD> struct EpiGate {
    const bf16_t* GATE; const bf16_t* PREV; bf16_t* O;
    __device__ __forceinline__ void operator()(const f32x4 (&acc)[2][2][4][2], const Unit& u, int wr, int wc, int fr, int fq) const {
        const int row0 = u.pm * 256 + wr * 64 + fr, col0 = u.pn * 256 + wc * 32 + 8 * fq;
#pragma unroll
        for (int ai = 0; ai < 2; ++ai)
#pragma unroll
            for (int m = 0; m < 4; ++m) { const size_t ro = (size_t)(row0 + ai * 128 + m * 16) * DM + col0;
#pragma unroll
                for (int bj = 0; bj < 2; ++bj) { const size_t idx = ro + bj * 128;
                    f32x4 g0, g1; unpack8(*(const u32x4*)(GATE + idx), g0, g1);
                    f32x4 v0 = g0 * acc[ai][bj][m][0], v1 = g1 * acc[ai][bj][m][1];
                    if (ADD) { f32x4 p0, p1; unpack8(*(const u32x4*)(PREV + idx), p0, p1); v0 += p0; v1 += p1; }
                    *(u32x4*)(O + idx) = pack8(v0, v1); } }
    }
};
template <bool WBF> struct EpiRes {
    const float* X; float* H; bf16_t* HBF; float* ssq;
    __device__ __forceinline__ void operator()(const f32x4 (&acc)[2][2][4][2], const Unit& u, int wr, int wc, int fr, int fq) const {
        const int row0 = u.pm * 256 + wr * 64 + fr, col0 = u.pn * 256 + wc * 32 + 8 * fq;
#pragma unroll
        for (int ai = 0; ai < 2; ++ai)
#pragma unroll
            for (int m = 0; m < 4; ++m) { const int row = row0 + ai * 128 + m * 16; const size_t ro = (size_t)row * DM + col0; float s = 0.f;
#pragma unroll
                for (int bj = 0; bj < 2; ++bj) { const size_t idx = ro + bj * 128;
                    f32x4 h0 = *(const f32x4*)(X + idx) + acc[ai][bj][m][0], h1 = *(const f32x4*)(X + idx + 4) + acc[ai][bj][m][1];
                    *(f32x4*)(H + idx) = h0; *(f32x4*)(H + idx + 4) = h1;
                    if (WBF) *(u32x4*)(HBF + idx) = pack8(h0, h1);
#pragma unroll
                    for (int j = 0; j < 4; ++j) s += h0[j] * h0[j] + h1[j] * h1[j]; }
                s += __shfl_xor(s, 16); s += __shfl_xor(s, 32);
                if (fq == 0) atomicAdd(ssq + row, s); }
    }
};
struct EpiSwiglu {
    const float* ssq; bf16_t* ACT;
    __device__ __forceinline__ void operator()(const f32x4 (&acc)[2][2][4][2], const Unit& u, int wr, int wc, int fr, int fq) const {
        const int row0 = u.pm * 256 + wr * 64 + fr, ch0 = u.pn * 128 + wc * 32 + 8 * fq;
#pragma unroll
        for (int ai = 0; ai < 2; ++ai)
#pragma unroll
            for (int m = 0; m < 4; ++m) { const int row = row0 + ai * 128 + m * 16; const float r = rsqrtf(ssq[row] * (1.0f / DM) + EPS);
                f32x4 v0, v1;
#pragma unroll
                for (int j = 0; j < 4; ++j) { v0[j] = siluf_(acc[ai][0][m][0][j] * r) * (acc[ai][1][m][0][j] * r); v1[j] = siluf_(acc[ai][0][m][1][j] * r) * (acc[ai][1][m][1][j] * r); }
                *(u32x4*)(ACT + (size_t)row * DFF + ch0) = pack8(v0, v1); }
    }
};

__device__ __forceinline__ int slot2lc(int slot) { return (slot & ~31) + pg8::perm32(slot & 31); }
__device__ __forceinline__ void conv_tile(LAS float* tile, const float* src0, const float* src1, int ldsrc, int nvalid, int K, bf16_t* dst, const float* kscale, int mode, int nt, int kt) {
    const int tid = threadIdx.x;
    { const int j = tid & 63, i0 = tid >> 6; const int nrow = nt * 64 + j, t256 = nrow >> 8, lc = slot2lc(nrow & 255);
      const float* s; int col; bool valid;
      if (mode == 0) { col = t256 * 256 + lc; s = src0; valid = col < nvalid; } else { col = t256 * 128 + (lc & 127); s = (lc >> 7) ? src1 : src0; valid = true; }
      if (!valid) col = 0;
      const float* sp = s + (size_t)(kt * 256 + i0) * ldsrc + col;
      float v[32];
#pragma unroll
      for (int ii = 0; ii < 32; ++ii) v[ii] = sp[(size_t)(8 * ii) * ldsrc];
#pragma unroll
      for (int ii = 0; ii < 32; ++ii) { const int kl = i0 + 8 * ii; float x = valid ? v[ii] : 0.f; if (kscale) x *= kscale[kt * 256 + kl]; tile[j * 257 + kl] = x; } }
    __syncthreads();
    { const int kk = (tid & 127) * 2, j0 = tid >> 7;
#pragma unroll
      for (int it = 0; it < 16; ++it) { const int j = j0 + 4 * it; *(unsigned*)(dst + (size_t)(nt * 64 + j) * K + kt * 256 + kk) = pk2(tile[j * 257 + kk], tile[j * 257 + kk + 1]); } }
    __syncthreads();
}

__device__ __forceinline__ void phase_prep(const Params& p, LAS unsigned char* lds) {
    LAS float* tile = (LAS float*)lds; unsigned char* ws = p.ws;
    constexpr int N0 = 324 * 8, N1 = N0 + 32 * 8, N2 = N1 + 32 * 16, N3 = N2 + 32 * 8, N4 = N3 + 176 * 8, N5 = N4 + 32 * 22;
    for (int it = blockIdx.x; it < N5; it += gridDim.x) {
        if (it < N0)      { const int i = it;      conv_tile(tile, p.w_in, nullptr, IN_COLS, IN_COLS, DM, (bf16_t*)(ws + OFF_WIN), nullptr, 0, i / 8, i % 8); }
        else if (it < N1) { const int i = it - N0; conv_tile(tile, p.w_out_a, nullptr, DM, DM, DM, (bf16_t*)(ws + OFF_WOA), nullptr, 0, i / 8, i % 8); }
        else if (it < N2) { const int i = it - N1; conv_tile(tile, p.w_out_ssm, nullptr, DM, DM, DI, (bf16_t*)(ws + OFF_WOS), nullptr, 0, i / 16, i % 16); }
        else if (it < N3) { const int i = it - N2; conv_tile(tile, p.w_o, nullptr, DM, DM, DM, (bf16_t*)(ws + OFF_WO), nullptr, 0, i / 8, i % 8); }
        else if (it < N4) { const int i = it - N3; conv_tile(tile, p.w_ffn_gate, p.w_ffn_up, DFF, DFF, DM, (bf16_t*)(ws + OFF_WGU), p.norm_ffn_g, 1, i / 8, i % 8); }
        else              { const int i = it - N4; conv_tile(tile, p.w_ffn_down, nullptr, DM, DM, DFF, (bf16_t*)(ws + OFF_WDN), nullptr, 0, i / 22, i % 22); }
    }
    { float* s1 = (float*)(ws + OFF_SSQ1); for (int i = blockIdx.x * 512 + threadIdx.x; i < 2 * NTOK; i += gridDim.x * 512) s1[i] = 0.f; }
    { const int wave = threadIdx.x >> 6, lane = threadIdx.x & 63; bf16_t* U = (bf16_t*)(ws + OFF_U);
      for (int row = (blockIdx.x * 8 + wave) * 2; row < NTOK; row += gridDim.x * 16) {
          const f32x4* xr = (const f32x4*)(p.x + (size_t)row * DM); f32x4 v[16]; float ss0 = 0.f, ss1 = 0.f;
#pragma unroll
          for (int i = 0; i < 16; ++i) v[i] = xr[lane + 64 * i];
#pragma unroll
          for (int i = 0; i < 8; ++i) { ss0 += v[i][0] * v[i][0] + v[i][1] * v[i][1] + v[i][2] * v[i][2] + v[i][3] * v[i][3]; ss1 += v[8 + i][0] * v[8 + i][0] + v[8 + i][1] * v[8 + i][1] + v[8 + i][2] * v[8 + i][2] + v[8 + i][3] * v[8 + i][3]; }
#pragma unroll
          for (int o = 32; o >= 1; o >>= 1) { ss0 += __shfl_xor(ss0, o); ss1 += __shfl_xor(ss1, o); }
          const float r0 = rsqrtf(ss0 * (1.0f / DM) + EPS), r1 = rsqrtf(ss1 * (1.0f / DM) + EPS);
#pragma unroll
          for (int i = 0; i < 16; ++i) { const float r = i < 8 ? r0 : r1; const f32x4 gg = ((const f32x4*)p.norm_mix_g)[lane + 64 * (i & 7)]; u32x2 w; w.x = pk2(v[i][0] * r * gg[0], v[i][1] * r * gg[1]); w.y = pk2(v[i][2] * r * gg[2], v[i][3] * r * gg[3]);
              *(u32x2*)(U + (size_t)row * DM + (lane + 64 * i) * 4) = w; } } }
}

__device__ __forceinline__ void phase_ssmconv(const Params& p) {
    const bf16_t* XBC = (const bf16_t*)(p.ws + OFF_XBC); bf16_t* XS = (bf16_t*)p.out; bf16_t* BCS = (bf16_t*)(p.ws + OFF_BCS);
    constexpr int TS = 16; const int total = (NTOK / TS) * 768;
    for (int idx = blockIdx.x * 512 + threadIdx.x; idx < total; idx += gridDim.x * 512) {
        const int t0 = (idx / 768) * TS, c = (idx % 768) * 8; const bool first = (t0 & (SEQ - 1)) == 0;
        u32x4 raw[TS + 3];
#pragma unroll
        for (int r = 0; r < TS + 3; ++r) raw[r] = (r < 3 && first) ? (u32x4){0u, 0u, 0u, 0u} : *(const u32x4*)(XBC + (size_t)(t0 - 3 + r) * CONVD + c);
        f32x4 w0[4], w1[4];
#pragma unroll
        for (int j = 0; j < 4; ++j) { w0[j] = *(const f32x4*)(p.ssm_conv_w + j * CONVD + c); w1[j] = *(const f32x4*)(p.ssm_conv_w + j * CONVD + c + 4); }
        const f32x4 b0 = *(const f32x4*)(p.ssm_conv_b + c), b1 = *(const f32x4*)(p.ssm_conv_b + c + 4);
        bf16_t* dst = (c < DI) ? XS + (size_t)t0 * DI + c : BCS + (size_t)t0 * 2048 + (c - DI); const int ldd = (c < DI) ? DI : 2048;
#pragma unroll
        for (int i = 0; i < TS; ++i) { f32x4 a0 = b0, a1 = b1;
#pragma unroll
            for (int j = 0; j < 4; ++j) { f32x4 r0, r1; unpack8(raw[i + j], r0, r1); a0 += w0[j] * r0; a1 += w1[j] * r1; }
#pragma unroll
            for (int j = 0; j < 4; ++j) { a0[j] = siluf_(a0[j]); a1[j] = siluf_(a1[j]); }
            *(u32x4*)(dst + (size_t)i * ldd) = pack8(a0, a1); }
    }
}

__device__ __forceinline__ void phase_ssd_seq(const Params& p, LAS unsigned char* lds) {
    LAS float* part = (LAS float*)lds;
    const int tid = threadIdx.x, pp = tid >> 3, ng = tid & 7, wave = tid >> 6, lane = tid & 63;
    const bf16_t* XS = (const bf16_t*)p.out; const bf16_t* BCS = (const bf16_t*)(p.ws + OFF_BCS); bf16_t* ZS = (bf16_t*)(p.ws + OFF_ZS);
    const float* DT = (const float*)(p.ws + OFF_DT); float* SSQH = (float*)(p.ws + OFF_SSQH);
    for (int item = blockIdx.x; item < 256; item += gridDim.x) {
        const int b = item >> 6, h = item & 63, g = h >> 3;
        const float a = -__expf(p.a_log[h]), Dk = p.d_skip[h];
        const bf16_t* xs = XS + (size_t)b * SEQ * DI + h * 64 + pp;
        const bf16_t* Bs = BCS + (size_t)b * SEQ * 2048 + g * 128 + ng * 16;
        const bf16_t* Cs = Bs + 1024;
        bf16_t* zs = ZS + (size_t)b * SEQ * DI + h * 64 + pp;
        const float* dt = DT + (size_t)b * SEQ * NH + h;
        float st[16];
#pragma unroll
        for (int i = 0; i < 16; ++i) st[i] = 0.f;
        for (int t0 = 0; t0 < SEQ; t0 += 64) {
#pragma unroll 4
            for (int tt = 0; tt < 64; ++tt) {
                const int t = t0 + tt;
                const float dtv = dt[(size_t)t * NH], xv = bf2f(xs[(size_t)t * DI]), zv = bf2f(zs[(size_t)t * DI]);
                f32x4 B0, B1, B2, B3, C0, C1, C2, C3;
                unpack8(*(const u32x4*)(Bs + (size_t)t * 2048), B0, B1); unpack8(*(const u32x4*)(Bs + (size_t)t * 2048 + 8), B2, B3);
                unpack8(*(const u32x4*)(Cs + (size_t)t * 2048), C0, C1); unpack8(*(const u32x4*)(Cs + (size_t)t * 2048 + 8), C2, C3);
                const float dA = __expf(dtv * a), xdt = xv * dtv; float y = 0.f;
#pragma unroll
                for (int i = 0; i < 4; ++i) {
                    st[i] = dA * st[i] + xdt * B0[i]; y += C0[i] * st[i];
                    st[4 + i] = dA * st[4 + i] + xdt * B1[i]; y += C1[i] * st[4 + i];
                    st[8 + i] = dA * st[8 + i] + xdt * B2[i]; y += C2[i] * st[8 + i];
                    st[12 + i] = dA * st[12 + i] + xdt * B3[i]; y += C3[i] * st[12 + i]; }
                y += __shfl_xor(y, 1); y += __shfl_xor(y, 2); y += __shfl_xor(y, 4);
                y += Dk * xv;
                const float yz = y * zv;
                if (ng == 0) zs[(size_t)t * DI] = (bf16_t)f2bf(yz);
                float sq = (ng == 0) ? yz * yz : 0.f;
                sq += __shfl_xor(sq, 8); sq += __shfl_xor(sq, 16); sq += __shfl_xor(sq, 32);
                if (lane == 0) part[tt * 8 + wave] = sq;
            }
            __syncthreads();
            if (tid < 64) { float s = 0.f;
#pragma unroll
                for (int w = 0; w < 8; ++w) s += part[tid * 8 + w];
                SSQH[(size_t)(b * SEQ + t0 + tid) * NH + h] = s; }
            __syncthreads();
        }
    }
}

typedef short s16x4 __attribute__((ext_vector_type(4)));
constexpr int SS_RSB = 272, SS_RSX = 144;
constexpr int SS_C = 0, SS_B = 34816, SS_X = 69632, SS_XW = 88064, SS_S = 106496, SS_SC = 123904, SS_M = 125952, SS_END = 160768;
__device__ __forceinline__ bf16x8 tr_frag(LAS unsigned char* lds, int addr, int step) {
    const s16x4 lo = __builtin_amdgcn_ds_read_tr16_b64_v4i16((LAS s16x4*)(lds + addr));
    const s16x4 hi = __builtin_amdgcn_ds_read_tr16_b64_v4i16((LAS s16x4*)(lds + addr + step));
    return __builtin_shufflevector(lo, hi, 0, 1, 2, 3, 4, 5, 6, 7);
}
#define MFMA16(a, b, c) __builtin_amdgcn_mfma_f32_16x16x32_bf16(a, b, c, 0, 0, 0)
#define WG_BAR() do { asm volatile("s_waitcnt lgkmcnt(0)" ::: "memory"); __builtin_amdgcn_s_barrier(); asm volatile("" ::: "memory"); } while (0)
__device__ __forceinline__ void phase_ssd_chunk(const Params& p, LAS unsigned char* lds) {
    const int tid = threadIdx.x, w = __builtin_amdgcn_readfirstlane(tid >> 6), lane = tid & 63, fr = lane & 15, g4 = lane >> 4, q = fr >> 2, pq = fr & 3;
    const bf16_t* XS = (const bf16_t*)p.out; const bf16_t* BCS = (const bf16_t*)(p.ws + OFF_BCS); bf16_t* ZS = (bf16_t*)(p.ws + OFF_ZS);
    const float* DT = (const float*)(p.ws + OFF_DT); float* SSQH = (float*)(p.ws + OFF_SSQH);
    LAS float* scal = (LAS float*)(lds + SS_SC);
    const int l = 16 * w + fr;
    for (int item = blockIdx.x; item < 256; item += gridDim.x) {
        const int b = item >> 6, h = item & 63, grp = h >> 3;
        const float a = -__expf(p.a_log[h]), Dk = p.d_skip[h];
        f32x4 accS[4];
#pragma unroll
        for (int i = 0; i < 4; ++i) accS[i] = (f32x4){0.f, 0.f, 0.f, 0.f};
        u32x4 pb[4], pc[4], px[2]; float d0 = 0.f, d1 = 0.f;
        const bf16_t* bsrc = BCS + (size_t)(b * SEQ + (tid >> 4)) * 2048 + grp * 128 + (tid & 15) * 8;
        const bf16_t* xsrc = XS + (size_t)(b * SEQ + (tid >> 3)) * DI + h * 64 + (tid & 7) * 8;
        const float* dsrc = DT + (size_t)(b * SEQ + lane) * NH + h;
#define SSD_PREFETCH(c_) do { const size_t ro_ = (size_t)(c_) * 128; \
            _Pragma("unroll") for (int i = 0; i < 4; ++i) { pb[i] = *(const u32x4*)(bsrc + (ro_ + 32 * i) * 2048); pc[i] = *(const u32x4*)(bsrc + (ro_ + 32 * i) * 2048 + 1024); } \
            _Pragma("unroll") for (int i = 0; i < 2; ++i) px[i] = *(const u32x4*)(xsrc + (ro_ + 64 * i) * DI); \
            if (w == 0) { d0 = dsrc[ro_ * NH]; d1 = dsrc[(ro_ + 64) * NH]; } } while (0)
#define SSD_SCAN(buf_) do { if (w == 0) { float s0 = d0 * a, s1 = d1 * a; \
            _Pragma("unroll") for (int o = 1; o < 64; o <<= 1) { const float t0 = __shfl_up(s0, o), t1 = __shfl_up(s1, o); if (lane >= o) { s0 += t0; s1 += t1; } } \
            s1 += __shfl(s0, 63); LAS float* cs_ = scal + (buf_) * 256; cs_[lane] = s0; cs_[64 + lane] = s1; cs_[128 + lane] = d0; cs_[192 + lane] = d1; } } while (0)
        SSD_PREFETCH(0);
        for (int i = tid; i < 64 * SS_RSB / 16; i += 512) *(LAS u32x4*)(lds + SS_S + i * 16) = (u32x4){0u, 0u, 0u, 0u};
        SSD_SCAN(0);
        WG_BAR();
        for (int c = 0; c < 32; ++c) {
            const int tok0 = b * SEQ + c * 128;
            LAS float* csA = scal + (c & 1) * 256; LAS float* dtA = csA + 128;
            const float csend = csA[127];
#pragma unroll
            for (int i = 0; i < 4; ++i) { const int row = (tid >> 4) + 32 * i, ch = tid & 15; *(LAS u32x4*)(lds + SS_B + row * SS_RSB + ch * 16) = pb[i]; *(LAS u32x4*)(lds + SS_C + row * SS_RSB + ch * 16) = pc[i]; }
#pragma unroll
            for (int i = 0; i < 2; ++i) { const int row = (tid >> 3) + 64 * i, ch = tid & 7; *(LAS u32x4*)(lds + SS_X + row * SS_RSX + ch * 16) = px[i];
                const float wl = __expf(csend - csA[row]) * dtA[row]; f32x4 v0, v1; unpack8(px[i], v0, v1); v0 *= wl; v1 *= wl; *(LAS u32x4*)(lds + SS_XW + row * SS_RSX + ch * 16) = pack8(v0, v1); }
            WG_BAR();
            if (c + 1 < 32) SSD_PREFETCH(c + 1);
            const size_t tok = (size_t)(tok0 + l);
            bf16_t* zp = ZS + tok * DI + h * 64 + 4 * g4;
            u32x2 z2[4];
#pragma unroll
            for (int pt = 0; pt < 4; ++pt) z2[pt] = *(const u32x2*)(zp + 16 * pt);
            const float csl = csA[l];
            bf16x8 cf[4];
#pragma unroll
            for (int ks = 0; ks < 4; ++ks) cf[ks] = *(const LAS bf16x8*)(lds + SS_C + l * SS_RSB + (4 * ks + g4) * 16);
            f32x4 accY[4];
#pragma unroll
            for (int pt = 0; pt < 4; ++pt) { accY[pt] = (f32x4){0.f, 0.f, 0.f, 0.f};
#pragma unroll
                for (int ks = 0; ks < 4; ++ks) { const bf16x8 sf = *(const LAS bf16x8*)(lds + SS_S + (16 * pt + fr) * SS_RSB + (4 * ks + g4) * 16); accY[pt] = MFMA16(sf, cf[ks], accY[pt]); } }
            { const float el = __expf(csl);
#pragma unroll
              for (int pt = 0; pt < 4; ++pt) accY[pt] *= el; }
#pragma unroll
            for (int st = 0; st < 8; ++st) {
                if (st <= w) { f32x4 a1 = (f32x4){0.f, 0.f, 0.f, 0.f};
#pragma unroll
                    for (int ks = 0; ks < 4; ++ks) { const bf16x8 bf = *(const LAS bf16x8*)(lds + SS_B + (16 * st + fr) * SS_RSB + (4 * ks + g4) * 16); a1 = MFMA16(bf, cf[ks], a1); }
                    const f32x4 cs4 = *(const LAS f32x4*)(csA + 16 * st + 4 * g4), dt4 = *(const LAS f32x4*)(dtA + 16 * st + 4 * g4); float v[4];
#pragma unroll
                    for (int r = 0; r < 4; ++r) { const int s = 16 * st + 4 * g4 + r; v[r] = (s <= l) ? a1[r] * __expf(fminf(csl - cs4[r], 0.f)) * dt4[r] : 0.f; }
                    u32x2 pk; pk.x = pk2(v[0], v[1]); pk.y = pk2(v[2], v[3]); *(LAS u32x2*)(lds + SS_M + l * SS_RSB + (16 * st + 4 * g4) * 2) = pk; }
                else if (st == w + 1 && (w & 1) == 0) { *(LAS u32x2*)(lds + SS_M + l * SS_RSB + (16 * st + 4 * g4) * 2) = (u32x2){0u, 0u}; } }
            { const float dec = __expf(csend);
#pragma unroll
              for (int pt = 0; pt < 4; ++pt) accS[pt] *= dec;
#pragma unroll
              for (int ks = 0; ks < 4; ++ks) { const bf16x8 btf = tr_frag(lds, SS_B + (32 * ks + 8 * g4 + q) * SS_RSB + (16 * w + 4 * pq) * 2, 4 * SS_RSB);
#pragma unroll
                  for (int pt = 0; pt < 4; ++pt) { const bf16x8 xwf = tr_frag(lds, SS_XW + (32 * ks + 8 * g4 + q) * SS_RSX + (16 * pt + 4 * pq) * 2, 4 * SS_RSX); accS[pt] = MFMA16(btf, xwf, accS[pt]); } } }
            if (c + 1 < 32) SSD_SCAN((c + 1) & 1);
#pragma unroll
            for (int ks = 0; ks < 4; ++ks) { if (2 * ks <= w) { const bf16x8 mf = *(const LAS bf16x8*)(lds + SS_M + l * SS_RSB + (4 * ks + g4) * 16);
#pragma unroll
                for (int pt = 0; pt < 4; ++pt) { const bf16x8 xf = tr_frag(lds, SS_X + (32 * ks + 8 * g4 + q) * SS_RSX + (16 * pt + 4 * pq) * 2, 4 * SS_RSX); accY[pt] = MFMA16(xf, mf, accY[pt]); } } }
            { float sq = 0.f;
#pragma unroll
              for (int pt = 0; pt < 4; ++pt) { const u32x2 x2 = *(const LAS u32x2*)(lds + SS_X + l * SS_RSX + (16 * pt + 4 * g4) * 2);
                  const float y0 = (accY[pt][0] + Dk * bflo(x2.x)) * bflo(z2[pt].x), y1 = (accY[pt][1] + Dk * bfhi(x2.x)) * bfhi(z2[pt].x), y2 = (accY[pt][2] + Dk * bflo(x2.y)) * bflo(z2[pt].y), y3 = (accY[pt][3] + Dk * bfhi(x2.y)) * bfhi(z2[pt].y);
                  sq += y0 * y0 + y1 * y1 + y2 * y2 + y3 * y3; u32x2 o; o.x = pk2(y0, y1); o.y = pk2(y2, y3); *(u32x2*)(zp + 16 * pt) = o; }
              sq += __shfl_xor(sq, 16); sq += __shfl_xor(sq, 32);
              if (g4 == 0) SSQH[tok * NH + h] = sq; }
            WG_BAR();
#pragma unroll
            for (int pt = 0; pt < 4; ++pt) { u32x2 pk; pk.x = pk2(accS[pt][0], accS[pt][1]); pk.y = pk2(accS[pt][2], accS[pt][3]); *(LAS u32x2*)(lds + SS_S + (16 * pt + fr) * SS_RSB + (16 * w + 4 * g4) * 2) = pk; }
        }
        WG_BAR();
#undef SSD_PREFETCH
#undef SSD_SCAN
    }
}

__device__ __forceinline__ void phase_gnorm(const Params& p) {
    bf16_t* ZS = (bf16_t*)(p.ws + OFF_ZS); const float* SSQH = (const float*)(p.ws + OFF_SSQH);
    const int total = NTOK * 512 / 4;
    for (int idx = blockIdx.x * 512 + threadIdx.x; idx < total; idx += gridDim.x * 512) {
        const int t0 = (idx >> 9) * 4, cg8 = idx & 511, c = cg8 * 8, g = cg8 >> 6;
        u32x4 raw[4]; f32x4 s0[4], s1[4];
#pragma unroll
        for (int i = 0; i < 4; ++i) { raw[i] = *(const u32x4*)(ZS + (size_t)(t0 + i) * DI + c); s0[i] = *(const f32x4*)(SSQH + (size_t)(t0 + i) * NH + g * 8); s1[i] = *(const f32x4*)(SSQH + (size_t)(t0 + i) * NH + g * 8 + 4); }
        const f32x4 g0 = *(const f32x4*)(p.ssm_norm_g + c), g1 = *(const f32x4*)(p.ssm_norm_g + c + 4);
#pragma unroll
        for (int i = 0; i < 4; ++i) { const float ss = s0[i][0] + s0[i][1] + s0[i][2] + s0[i][3] + s1[i][0] + s1[i][1] + s1[i][2] + s1[i][3]; const float r = rsqrtf(ss * (1.0f / 512.0f) + EPS);
            f32x4 v0, v1; unpack8(raw[i], v0, v1); v0 = v0 * r * g0; v1 = v1 * r * g1; *(u32x4*)(ZS + (size_t)(t0 + i) * DI + c) = pack8(v0, v1); }
    }
}

__device__ __forceinline__ void phase_mixa(const Params& p) {
    const bf16_t* BB = (const bf16_t*)(p.ws + OFF_BB); const bf16_t* BC = (const bf16_t*)(p.ws + OFF_BC); const bf16_t* BH = (const bf16_t*)(p.ws + OFF_BH); bf16_t* YA = (bf16_t*)(p.ws + OFF_U);
    constexpr int TS = 8; const int total = (NTOK / TS) * 256;
    for (int idx = blockIdx.x * 512 + threadIdx.x; idx < total; idx += gridDim.x * 512) {
        const int t0 = (idx >> 8) * TS, c = (idx & 255) * 8; const bool first = (t0 & (SEQ - 1)) == 0;
        u32x4 rc[TS + 2], rh[TS + 2], rb[TS];
#pragma unroll
        for (int r = 0; r < TS + 2; ++r) { const size_t o = (size_t)(t0 - 2 + r) * DM + c; const bool z = (r < 2 && first); rc[r] = z ? (u32x4){0u, 0u, 0u, 0u} : *(const u32x4*)(BC + o); rh[r] = z ? (u32x4){0u, 0u, 0u, 0u} : *(const u32x4*)(BH + o); }
#pragma unroll
        for (int i = 0; i < TS; ++i) rb[i] = *(const u32x4*)(BB + (size_t)(t0 + i) * DM + c);
        f32x4 w0[3], w1[3];
#pragma unroll
        for (int j = 0; j < 3; ++j) { w0[j] = *(const f32x4*)(p.conv_a_w + j * DM + c); w1[j] = *(const f32x4*)(p.conv_a_w + j * DM + c + 4); }
        f32x4 q0[3], q1[3];
#pragma unroll
        for (int r = 0; r < 2; ++r) { f32x4 c0, c1, h0, h1; unpack8(rc[r], c0, c1); unpack8(rh[r], h0, h1); q0[r] = c0 * h0; q1[r] = c1 * h1; }
#pragma unroll
        for (int i = 0; i < TS; ++i) { { f32x4 c0, c1, h0, h1; unpack8(rc[i + 2], c0, c1); unpack8(rh[i + 2], h0, h1); q0[2] = c0 * h0; q1[2] = c1 * h1; }
            f32x4 a0 = w0[0] * q0[0] + w0[1] * q0[1] + w0[2] * q0[2], a1 = w1[0] * q1[0] + w1[1] * q1[1] + w1[2] * q1[2];
            f32x4 b0, b1; unpack8(rb[i], b0, b1);
            *(u32x4*)(YA + (size_t)(t0 + i) * DM + c) = pack8(a0 * b0, a1 * b1);
            q0[0] = q0[1]; q0[1] = q0[2]; q1[0] = q1[1]; q1[1] = q1[2]; }
    }
}

__device__ __forceinline__ void phase_final(const Params& p) {
    const float* SSQ2 = (const float*)(p.ws + OFF_SSQ2);
    const int total = NTOK * 512 / 4;
    for (int idx = blockIdx.x * 512 + threadIdx.x; idx < total; idx += gridDim.x * 512) {
        const int t0 = (idx >> 9) * 4, c = (idx & 511) * 4;
        f32x4 v[4]; float r[4];
#pragma unroll
        for (int i = 0; i < 4; ++i) { v[i] = *(const f32x4*)(p.out + (size_t)(t0 + i) * DM + c); r[i] = SSQ2[t0 + i]; }
        const f32x4 g = *(const f32x4*)(p.norm_final_g + c);
#pragma unroll
        for (int i = 0; i < 4; ++i) *(f32x4*)(p.out + (size_t)(t0 + i) * DM + c) = v[i] * rsqrtf(r[i] * (1.0f / DM) + EPS) * g;
    }
}

#define XB_TMO      128
#define XB_XCNT(j)  (256  + 64 * (j))
#define XB_XSUB(j)  (1280 + 64 * (j))
#define XB_XGEN(j)  (2304 + 64 * (j))
#define XB_TOP      3328
#define XB_TOPGEN   3392
#define XCD_BAR_WORDS 3456
#define XB_SPIN_CAP (1u << 18)

__device__ __forceinline__ unsigned xb_ld(unsigned* p)              { return __hip_atomic_load(p, __ATOMIC_RELAXED, __HIP_MEMORY_SCOPE_AGENT); }
__device__ __forceinline__ unsigned xb_add(unsigned* p, unsigned v) { return __hip_atomic_fetch_add(p, v, __ATOMIC_RELAXED, __HIP_MEMORY_SCOPE_AGENT); }
__device__ __forceinline__ unsigned xb_xcc_id() { return (unsigned)__builtin_amdgcn_s_getreg((3 << 11) | 20) & 0xFu; }
#define XB_SPIN(cond, bar) do { unsigned _sp = 0; while (cond) { __builtin_amdgcn_s_sleep(1); \
    if ((++_sp & 255u) == 0u) { if (xb_ld(&(bar)[XB_TMO])) break; if (_sp > XB_SPIN_CAP) { atomicAdd(&(bar)[XB_TMO], 1u); break; } } } } while (0)

struct XcdBarrier {
    unsigned* bar; unsigned x;
    volatile LAS unsigned* st;
};

__device__ __forceinline__ XcdBarrier xcd_barrier_post(unsigned* bar, volatile LAS unsigned* st) {
    XcdBarrier b; b.bar = bar; b.x = xb_xcc_id(); b.st = st;
    if (threadIdx.x == 0) (void)xb_add(&bar[XB_XCNT(b.x)], 1u);
    return b;
}
__device__ __forceinline__ void xcd_barrier_complete(unsigned* bar, unsigned x, unsigned& nloc, unsigned& nx) {
    const unsigned G = gridDim.x * gridDim.y * gridDim.z;
    unsigned sum, cnt, mine, sp = 0u;
    for (;;) {
        sum = 0u; cnt = 0u; mine = 0u;
#pragma unroll
        for (unsigned j = 0; j < 16; ++j) { const unsigned c = xb_ld(&bar[XB_XCNT(j)]); sum += c; cnt += (c > 0u) ? 1u : 0u; mine = (j == x) ? c : mine; }
        if (sum == G) break;
        __builtin_amdgcn_s_sleep(1);
        if ((++sp & 255u) == 0u) { if (xb_ld(&bar[XB_TMO])) break; if (sp > XB_SPIN_CAP) { atomicAdd(&bar[XB_TMO], 1u); break; } }
    }
    nloc = mine > 0u ? mine : 1u; nx = cnt > 0u ? cnt : 1u;
}

__device__ __forceinline__ void xcd_barrier(const XcdBarrier& b) {
    asm volatile("s_waitcnt vmcnt(0)" ::: "memory");
    __syncthreads();
    if (threadIdx.x == 0) {
        unsigned* bar = b.bar;
        __builtin_amdgcn_s_waitcnt(0);
        unsigned nloc = b.st[0], nx = b.st[1];
        if (nloc == 0u) { xcd_barrier_complete(bar, b.x, nloc, nx); b.st[0] = nloc; b.st[1] = nx; }
        const unsigned old = xb_add(&bar[XB_XSUB(b.x)], 1u);
        const unsigned gen = old / nloc;
        if (old + 1u == (gen + 1u) * nloc) {
            __builtin_amdgcn_fence(__ATOMIC_RELEASE, "agent");
            asm volatile("s_waitcnt vmcnt(0)" ::: "memory");
            const unsigned og = xb_add(&bar[XB_TOP], 1u);
            const unsigned tg = og / nx;
            if (og + 1u == (tg + 1u) * nx) xb_add(&bar[XB_TOPGEN], 1u);
            else XB_SPIN(xb_ld(&bar[XB_TOPGEN]) == tg, bar);
            __builtin_amdgcn_fence(__ATOMIC_ACQUIRE, "agent");
            xb_add(&bar[XB_XGEN(b.x)], 1u);
            asm volatile("s_waitcnt vmcnt(0)" ::: "memory");
        } else {
            XB_SPIN(xb_ld(&bar[XB_XGEN(b.x)]) == gen, bar);
            __builtin_amdgcn_fence(__ATOMIC_ACQUIRE, "agent");
            asm volatile("s_waitcnt vmcnt(0)" ::: "memory");
        }
    }
    __syncthreads();
}

constexpr int NPHASE = 11;
template <int PH> __device__ __forceinline__ void run_phase(const Params& p, LAS unsigned char* lds) {
    unsigned char* ws = p.ws;
    pg8::StaticOrder S; pg8::Gemm g;
    if constexpr (PH == 0) { phase_prep(p, lds); }
    else if constexpr (PH == 1) {
        g.A = (const bf16_t*)(ws + OFF_U); g.Bt = (const bf16_t*)(ws + OFF_WIN) + (size_t)40 * 256 * DM; g.M = NTOK; g.N = 41 * 256; g.K = DM; S.init(g.M, g.N, gridDim.x, blockIdx.x);
        EpiRoute E{(bf16_t*)p.out, (bf16_t*)p.out + (size_t)NTOK * DM, (bf16_t*)(ws + OFF_BB), (bf16_t*)(ws + OFF_BC), (bf16_t*)(ws + OFF_BH), (bf16_t*)(ws + OFF_ZS), (bf16_t*)(ws + OFF_XBC), (float*)(ws + OFF_DT), p.dt_bias, 40};
        pg8::gemm_phase(lds, g, S, E); }
    else if constexpr (PH == 2) { phase_ssmconv(p); }
    else if constexpr (PH == 3) { phase_ssd_chunk(p, lds); }
    else if constexpr (PH == 4) {
        g.A = (const bf16_t*)(ws + OFF_U); g.Bt = (const bf16_t*)(ws + OFF_WIN); g.M = NTOK; g.N = 40 * 256; g.K = DM; S.init(g.M, g.N, gridDim.x, blockIdx.x);
        EpiRoute E{(bf16_t*)p.out, (bf16_t*)p.out + (size_t)NTOK * DM, (bf16_t*)(ws + OFF_BB), (bf16_t*)(ws + OFF_BC), (bf16_t*)(ws + OFF_BH), (bf16_t*)(ws + OFF_ZS), (bf16_t*)(ws + OFF_XBC), (float*)(ws + OFF_DT), p.dt_bias, 0};
        pg8::gemm_phase(lds, g, S, E);
        phase_gnorm(p); }
    else if constexpr (PH == 5) { phase_mixa(p); }
    else if constexpr (PH == 6) {
        g.A = (const bf16_t*)(ws + OFF_U); g.Bt = (const bf16_t*)(ws + OFF_WOA); g.M = NTOK; g.N = DM; g.K = DM; S.init(g.M, g.N, gridDim.x, blockIdx.x);
        EpiGate<false> Ea{(const bf16_t*)p.out, nullptr, (bf16_t*)(ws + OFF_BB)};
        pg8::gemm_phase(lds, g, S, Ea);
        g.A = (const bf16_t*)(ws + OFF_ZS); g.Bt = (const bf16_t*)(ws + OFF_WOS); g.K = DI;
        EpiGate<true> Eb{(const bf16_t*)p.out + (size_t)NTOK * DM, (const bf16_t*)(ws + OFF_BB), (bf16_t*)(ws + OFF_BC)};
        pg8::gemm_phase(lds, g, S, Eb); }
    else if constexpr (PH == 7) {
        g.A = (const bf16_t*)(ws + OFF_BC); g.Bt = (const bf16_t*)(ws + OFF_WO); g.M = NTOK; g.N = DM; g.K = DM; S.init(g.M, g.N, gridDim.x, blockIdx.x);
        EpiRes<true> E{p.x, p.out, (bf16_t*)(ws + OFF_BH), (float*)(ws + OFF_SSQ1)};
        pg8::gemm_phase(lds, g, S, E); }
    else if constexpr (PH == 8) {
        g.A = (const bf16_t*)(ws + OFF_BH); g.Bt = (const bf16_t*)(ws + OFF_WGU); g.M = NTOK; g.N = 2 * DFF; g.K = DM; S.init(g.M, g.N, gridDim.x, blockIdx.x);
        EpiSwiglu E{(const float*)(ws + OFF_SSQ1), (bf16_t*)(ws + OFF_ZS)};
        pg8::gemm_phase(lds, g, S, E); }
    else if constexpr (PH == 9) {
        g.A = (const bf16_t*)(ws + OFF_ZS); g.Bt = (const bf16_t*)(ws + OFF_WDN); g.M = NTOK; g.N = DM; g.K = DFF; S.init(g.M, g.N, gridDim.x, blockIdx.x);
        EpiRes<false> E{p.out, p.out, nullptr, (float*)(ws + OFF_SSQ2)};
        pg8::gemm_phase(lds, g, S, E); }
    else if constexpr (PH == 10) { phase_final(p); }
}

template <int PH> __global__ void __launch_bounds__(512, 2) k_one(Params p) {
    extern __shared__ __attribute__((aligned(16))) unsigned char lds_raw[];
    run_phase<PH>(p, (LAS unsigned char*)lds_raw);
}

#ifndef PROBE_MASK
#define PROBE_MASK 0
#endif
__global__ void __launch_bounds__(512, 2) k_mega(Params p) {
    extern __shared__ __attribute__((aligned(16))) unsigned char lds_raw[];
    LAS unsigned char* lds = (LAS unsigned char*)lds_raw;
    cg::grid_group grid = cg::this_grid();
    unsigned long long spin = 0, t0 = 0;
    volatile LAS unsigned* bst = (volatile LAS unsigned*)(lds + SS_END);
    if (threadIdx.x < 4) bst[threadIdx.x] = 0u;
    __syncthreads();
    const XcdBarrier xbar = xcd_barrier_post((unsigned*)(p.ws + OFF_BAR), bst);
#define PH_RUN(i, SYNC) do { if (PROBE_MASK) t0 = __builtin_amdgcn_s_memrealtime(); run_phase<i>(p, lds); if (SYNC == 1) grid.sync(); else if (SYNC == 2) xcd_barrier(xbar); \
        if (PROBE_MASK & (1 << i)) spin += __builtin_amdgcn_s_memrealtime() - t0; } while (0)
    PH_RUN(0, 1); PH_RUN(1, 2); PH_RUN(2, 2); PH_RUN(3, 2); PH_RUN(4, 2); PH_RUN(5, 2); PH_RUN(6, 2); PH_RUN(7, 2); PH_RUN(8, 2); PH_RUN(9, 2); PH_RUN(10, 0);
#ifdef PROBE_SYNCS
    for (int i = 0; i < PROBE_SYNCS; ++i) xcd_barrier(xbar);
#endif
    if (PROBE_MASK && blockIdx.x == 0) { t0 = __builtin_amdgcn_s_memrealtime(); while (__builtin_amdgcn_s_memrealtime() - t0 < spin) __builtin_amdgcn_s_sleep(8); }
}

constexpr int LDS_BYTES = SS_END + 16;

template <int PH> static void launch_one(const Params& p, int grid, hipStream_t stream) {
    static bool attr = false;
    if (!attr) { (void)hipFuncSetAttribute((const void*)k_one<PH>, hipFuncAttributeMaxDynamicSharedMemorySize, LDS_BYTES); attr = true; }
    hipLaunchKernelGGL(k_one<PH>, dim3(grid), dim3(512), LDS_BYTES, stream, p);
}

extern "C" void kernel_launch(void* const* d_in, const int* in_sizes, int n_in, void* d_out, int out_size, void* d_ws, size_t ws_size, hipStream_t stream) {
    static int grid = 0;
    if (grid == 0) {
        if (n_in != 18 || out_size != NTOK * DM || ws_size < WS_END) { fprintf(stderr, "kernel_launch: unexpected shapes: n_in %d out %d ws %zu (need %zu)\n", n_in, out_size, ws_size, (size_t)WS_END); grid = -1; return; }
        int dev = 0, cus = 0, per_cu = 0;
        (void)hipGetDevice(&dev); (void)hipDeviceGetAttribute(&cus, hipDeviceAttributeMultiprocessorCount, dev);
        (void)hipFuncSetAttribute((const void*)k_mega, hipFuncAttributeMaxDynamicSharedMemorySize, LDS_BYTES);
        (void)hipOccupancyMaxActiveBlocksPerMultiprocessor(&per_cu, (const void*)k_mega, 512, LDS_BYTES);
        if (per_cu < 1) { fprintf(stderr, "kernel_launch: occupancy query says %d blocks per CU\n", per_cu); per_cu = 1; }
        (void)hipGetLastError();
        grid = cus * per_cu;
        fprintf(stderr, "kernel_launch: cus %d per_cu %d grid %d ws %zu\n", cus, per_cu, grid, ws_size);
    }
    if (grid < 0) return;
    Params p{};
    const float** pp = (const float**)&p;
    for (int i = 0; i < 18; ++i) pp[i] = (const float*)d_in[i];
    p.out = (float*)d_out; p.ws = (unsigned char*)d_ws;
#if MEGA
    (void)hipMemsetAsync((unsigned char*)d_ws + OFF_BAR, 0, XCD_BAR_WORDS * 4, stream);
    void* args[] = {&p};
    hipError_t e = hipLaunchCooperativeKernel((const void*)k_mega, dim3(grid), dim3(512), args, LDS_BYTES, stream);
    if (e != hipSuccess) fprintf(stderr, "cooperative launch failed: %s (grid %d)\n", hipGetErrorString(e), grid);
#else
    launch_one<0>(p, grid, stream); launch_one<1>(p, grid, stream); launch_one<2>(p, grid, stream); launch_one<3>(p, grid, stream); launch_one<4>(p, grid, stream); launch_one<5>(p, grid, stream);
    launch_one<6>(p, grid, stream); launch_one<7>(p, grid, stream); launch_one<8>(p, grid, stream); launch_one<9>(p, grid, stream); launch_one<10>(p, grid, stream);
#endif
}
```

```cpp
#include <hip/hip_runtime.h>
#include <hip/hip_cooperative_groups.h>
#include <cstdio>
namespace cg = cooperative_groups;

#ifndef MEGA
#define MEGA 1
#endif

#define LAS __attribute__((address_space(3)))
typedef unsigned short bf16_t;
typedef short bf16x8 __attribute__((ext_vector_type(8)));
typedef float f32x4 __attribute__((ext_vector_type(4)));
typedef unsigned u32x4 __attribute__((ext_vector_type(4)));
typedef unsigned u32x2 __attribute__((ext_vector_type(2)));

constexpr int DM = 2048, NTOK = 16384, SEQ = 4096;
constexpr int IN_COLS = 20544, IN_TILES = 81;
constexpr int DI = 4096, NH = 64, HD = 64, NG = 8, NST = 128, CONVD = 6144;
constexpr int DFF = 5632;
constexpr float EPS = 1e-6f;

constexpr size_t MiB = 1024ull * 1024ull;
constexpr size_t OFF_WIN = 0;
constexpr size_t OFF_WOA = 81 * MiB;
constexpr size_t OFF_WOS = 89 * MiB;
constexpr size_t OFF_WO  = 105 * MiB;
constexpr size_t OFF_WGU = 113 * MiB;
constexpr size_t OFF_WDN = 157 * MiB;
constexpr size_t OFF_ZS  = 179 * MiB;
constexpr size_t OFF_U   = 307 * MiB;
constexpr size_t OFF_XBC = 371 * MiB;
constexpr size_t OFF_BB  = 371 * MiB, OFF_BC = 435 * MiB, OFF_BH = 499 * MiB;
constexpr size_t OFF_DT  = 563 * MiB;
constexpr size_t OFF_SSQH = 567 * MiB;
constexpr size_t OFF_SSQ1 = 571 * MiB;
constexpr size_t OFF_SSQ2 = 571 * MiB + 65536;
constexpr size_t OFF_BCS = 572 * MiB;
constexpr size_t OFF_BAR = 636 * MiB;
constexpr size_t WS_END = 637 * MiB;

struct Params {
    const float *x, *norm_mix_g, *w_in, *conv_a_w, *w_out_a, *ssm_conv_w, *ssm_conv_b, *dt_bias, *a_log, *d_skip, *ssm_norm_g, *w_out_ssm, *w_o, *norm_ffn_g, *w_ffn_gate, *w_ffn_up,
        *w_ffn_down, *norm_final_g;
    float* out; unsigned char* ws;
};

__device__ __forceinline__ unsigned f2bf(float f) { unsigned u = __builtin_bit_cast(unsigned, f); return (u + 0x7fffu + ((u >> 16) & 1u)) >> 16; }
__device__ __forceinline__ unsigned pk2(float lo, float hi) { unsigned r; asm("v_cvt_pk_bf16_f32 %0, %1, %2" : "=v"(r) : "v"(lo), "v"(hi)); return r; }
__device__ __forceinline__ float bflo(unsigned w) { return __builtin_bit_cast(float, w << 16); }
__device__ __forceinline__ float bfhi(unsigned w) { return __builtin_bit_cast(float, w & 0xffff0000u); }
__device__ __forceinline__ float bf2f(bf16_t v) { return __builtin_bit_cast(float, ((unsigned)v) << 16); }
__device__ __forceinline__ float sigmoidf_(float v) { return __builtin_amdgcn_rcpf(1.0f + __expf(-v)); }
__device__ __forceinline__ float siluf_(float v) { return v * sigmoidf_(v); }
__device__ __forceinline__ float softplusf_(float v) { return fmaxf(v, 0.f) + log1pf(__expf(-fabsf(v))); }
__device__ __forceinline__ u32x4 pack8(const f32x4& a, const f32x4& b) { u32x4 w; w.x = pk2(a[0], a[1]); w.y = pk2(a[2], a[3]); w.z = pk2(b[0], b[1]); w.w = pk2(b[2], b[3]); return w; }
__device__ __forceinline__ void unpack8(const u32x4& w, f32x4& a, f32x4& b) { a[0] = bflo(w.x); a[1] = bfhi(w.x); a[2] = bflo(w.y); a[3] = bfhi(w.y); b[0] = bflo(w.z); b[1] = bfhi(w.z); b[2] = bflo(w.w); b[3] = bfhi(w.w); }

namespace pg8 {
constexpr int BM = 256, BK = 64, HALF = 128, HTB = HALF * BK * 2, STAGE_BYTES = 8 * HTB, NXCD = 8, WGM = 8;
__host__ __device__ __forceinline__ int lds_byte(int r, int c) { const int st = (r >> 4) * 2 + (c >> 5), rr = r & 15, cc = c & 31, ob = rr * 64 + cc * 2; return st * 1024 + (ob ^ (((ob >> 9) & 1) << 5)); }
__host__ __device__ __forceinline__ void stage_rc(int b, int& R, int& C) { const int st = b / 1024, sb = b % 1024, swz = sb ^ (((sb >> 9) & 1) << 5); R = (st >> 1) * 16 + swz / 64; C = (st & 1) * 32 + (swz % 64) / 2; }
__host__ __device__ __forceinline__ int perm32(int rho) { const int n = rho >> 4, i = rho & 15; return 8 * (i >> 2) + 4 * n + (i & 3); }
struct Unit { int pm, pn; };
struct Gemm { const bf16_t* A; const bf16_t* Bt; int M, N, K; };
struct StaticOrder {
    int nM, nN, nwg, G, c;
    __host__ __device__ void init(int M, int N, int G_, int c_) { nM = M / BM; nN = N / BM; nwg = nM * nN; G = G_; c = c_; }
    __host__ __device__ bool next(int i, Unit& u) const {
        const long L = (long)i * G + c; if (L >= nwg) return false;
        int wgid = (int)L; { const int q = nwg / NXCD, r = nwg % NXCD, xcd = wgid % NXCD, off = wgid / NXCD; wgid = (xcd < r ? xcd * (q + 1) : r * (q + 1) + (xcd - r) * q) + off; }
        const int nig = WGM * nN, gid = wgid / nig, fm = gid * WGM, gsz = (nM - fm) < WGM ? (nM - fm) : WGM;
        u.pm = fm + ((wgid % nig) % gsz); u.pn = (wgid % nig) / gsz; return true;
    }
};

template <class Epi>
__device__ __forceinline__ void gemm_phase(LAS unsigned char* lds, const Gemm g, const StaticOrder& S, const Epi& E) {
    const int tid = threadIdx.x, wid = __builtin_amdgcn_readfirstlane(tid >> 6), lane = tid & 63, wr = wid >> 2, wc = wid & 3, fr = lane & 15, fq = lane >> 4;
    const int K = g.K, nt = K / BK;
    unsigned voffA[2];
#pragma unroll
    for (int i = 0; i < 2; ++i) { int R, C; stage_rc(tid * 16 + i * 8192, R, C); voffA[i] = (unsigned)(R * K + C) * 2u; }
    const size_t kstep = (size_t)(BK * 2);
    const size_t hstep = (size_t)HALF * K * 2;
    const size_t tstep = 2 * hstep;
    const unsigned ldsw = (unsigned)wid * 1024u;
    const int aoff = lds_byte(wr * 64 + fr, fq * 8), boff = lds_byte(wc * 32 + fr, fq * 8);
#define PG8_SA(b, h) (((b) * 2 + (h)) * HTB)
#define PG8_SB(b, h) ((4 + (b) * 2 + (h)) * HTB)
#define PG8_STAGE(bufoff, gbase, voff) do { _Pragma("unroll") for (int _i = 0; _i < 2; ++_i) \
        __builtin_amdgcn_global_load_lds((const unsigned*)((const char*)(gbase) + (voff)[_i]), (LAS unsigned*)(lds + (bufoff) + ldsw + _i * 8192), 16, 0, 0); } while (0)
#define PG8_LDA(dst, b, h) do { _Pragma("unroll") for (int m = 0; m < 4; ++m) _Pragma("unroll") for (int k = 0; k < 2; ++k) dst[m][k] = *(const LAS bf16x8*)(lds + PG8_SA(b, h) + aoff + m * 2048 + k * 1024); } while (0)
#define PG8_LDB(dst, b, h) do { _Pragma("unroll") for (int n = 0; n < 2; ++n) _Pragma("unroll") for (int k = 0; k < 2; ++k) dst[n][k] = *(const LAS bf16x8*)(lds + PG8_SB(b, h) + boff + n * 2048 + k * 1024); } while (0)
#define PG8_MMA(ai, bj, At, Bt) do { __builtin_amdgcn_s_setprio(1); _Pragma("unroll") for (int m = 0; m < 4; ++m) _Pragma("unroll") for (int n = 0; n < 2; ++n) _Pragma("unroll") for (int k = 0; k < 2; ++k) \
        acc[ai][bj][m][n] = __builtin_amdgcn_mfma_f32_16x16x32_bf16(Bt[n][k], At[m][k], acc[ai][bj][m][n], 0, 0, 0); __builtin_amdgcn_s_setprio(0); } while (0)
#define PG8_WAIT_V(n) asm volatile("s_waitcnt vmcnt(" #n ")" ::: "memory")
#define PG8_WAIT_L(n) asm volatile("s_waitcnt lgkmcnt(" #n ")" ::: "memory")
#define PG8_BAR __builtin_amdgcn_s_barrier()
#define PG8_SCHED __builtin_amdgcn_sched_barrier(0)
    Unit cur, nxt; int ui = 0;
    if (!S.next(0, cur)) return;
    f32x4 acc[2][2][4][2];
#pragma unroll
    for (int a = 0; a < 2; ++a)
#pragma unroll
        for (int b = 0; b < 2; ++b)
#pragma unroll
            for (int m = 0; m < 4; ++m)
#pragma unroll
                for (int n = 0; n < 2; ++n) acc[a][b][m][n] = (f32x4){0.f, 0.f, 0.f, 0.f};
    bf16x8 At[4][2], B0[2][2], B1[2][2];
    const char* cA = (const char*)g.A + (size_t)cur.pm * tstep; const char* cB = (const char*)g.Bt + (size_t)cur.pn * tstep;
    PG8_STAGE(PG8_SB(0, 0), cB, voffA); PG8_STAGE(PG8_SA(0, 0), cA, voffA); PG8_STAGE(PG8_SB(0, 1), cB + hstep, voffA); PG8_STAGE(PG8_SA(0, 1), cA + hstep, voffA);
    if (wr == 1) PG8_BAR;
    PG8_WAIT_V(4); PG8_BAR;
    PG8_STAGE(PG8_SB(1, 0), cB + kstep, voffA); PG8_STAGE(PG8_SA(1, 0), cA + kstep, voffA); PG8_STAGE(PG8_SB(1, 1), cB + hstep + kstep, voffA);
    PG8_WAIT_V(6); PG8_BAR;
    for (;;) {
        const bool has_next = S.next(ui + 1, nxt);
        const char* nA = has_next ? (const char*)g.A + (size_t)nxt.pm * tstep : cA; const char* nB = has_next ? (const char*)g.Bt + (size_t)nxt.pn * tstep : cB;
        for (int t = 0; t < nt; t += 2) {
            const bool last = (t == nt - 2);
            const char* a1 = cA + (size_t)(t + 1) * kstep;
            const char* a2 = last ? nA : cA + (size_t)(t + 2) * kstep; const char* b2 = last ? nB : cB + (size_t)(t + 2) * kstep;
            const char* a3 = a2 + kstep; const char* b3 = b2 + kstep;
            PG8_LDB(B0, 0, 0); PG8_SCHED; PG8_LDA(At, 0, 0); PG8_STAGE(PG8_SA(1, 1), a1 + hstep, voffA);
            PG8_WAIT_L(8); PG8_BAR; PG8_WAIT_L(0); PG8_MMA(0, 0, At, B0); PG8_BAR; PG8_SCHED;
            PG8_LDB(B1, 0, 1); PG8_STAGE(PG8_SB(0, 0), b2, voffA);
            PG8_BAR; PG8_WAIT_L(0); PG8_MMA(0, 1, At, B1); PG8_BAR;
            PG8_LDA(At, 0, 1); PG8_STAGE(PG8_SA(0, 0), a2, voffA);
            PG8_BAR; PG8_WAIT_L(0); PG8_MMA(1, 0, At, B0); PG8_BAR; PG8_SCHED;
            PG8_STAGE(PG8_SB(0, 1), b2 + hstep, voffA);
            PG8_WAIT_V(6); PG8_BAR; PG8_MMA(1, 1, At, B1); PG8_BAR;
            PG8_LDB(B0, 1, 0); PG8_SCHED; PG8_LDA(At, 1, 0); PG8_STAGE(PG8_SA(0, 1), a2 + hstep, voffA);
            PG8_WAIT_L(8); PG8_BAR; PG8_WAIT_L(0); PG8_MMA(0, 0, At, B0); PG8_BAR; PG8_SCHED;
            PG8_LDB(B1, 1, 1); PG8_STAGE(PG8_SB(1, 0), b3, voffA);
            PG8_BAR; PG8_WAIT_L(0); PG8_MMA(0, 1, At, B1); PG8_BAR;
            PG8_LDA(At, 1, 1); PG8_STAGE(PG8_SA(1, 0), a3, voffA);
            PG8_BAR; PG8_WAIT_L(0); PG8_MMA(1, 0, At, B0); PG8_BAR; PG8_SCHED;
            PG8_STAGE(PG8_SB(1, 1), b3 + hstep, voffA);
            PG8_WAIT_V(6); PG8_BAR; PG8_MMA(1, 1, At, B1); PG8_BAR;
        }
        E(acc, cur, wr, wc, fr, fq);
        if (!has_next) break;
#pragma unroll
        for (int a = 0; a < 2; ++a)
#pragma unroll
            for (int b = 0; b < 2; ++b)
#pragma unroll
                for (int m = 0; m < 4; ++m)
#pragma unroll
                    for (int n = 0; n < 2; ++n) acc[a][b][m][n] = (f32x4){0.f, 0.f, 0.f, 0.f};
        cur = nxt; cA = nA; cB = nB; ++ui;
    }
    PG8_WAIT_V(0);
    if (wr == 0) PG8_BAR;
    PG8_BAR;
#undef PG8_SA
#undef PG8_SB
#undef PG8_STAGE
#undef PG8_LDA
#undef PG8_LDB
#undef PG8_MMA
#undef PG8_WAIT_V
#undef PG8_WAIT_L
#undef PG8_BAR
#undef PG8_SCHED
}
}
using pg8::Unit;

struct EpiRoute {
    bf16_t *GA, *GB, *BB, *BC, *BH, *ZS, *XBC; float* DT; const float* dt_bias; int tile0;
    __device__ __forceinline__ void operator()(const f32x4 (&acc)[2][2][4][2], const Unit& u, int wr, int wc, int fr, int fq) const {
        const int gt = u.pn + tile0; const int row0 = u.pm * 256 + wr * 64 + fr;
        if (gt < 80) {
            bf16_t* base; int ldc, cb, act;
            if (gt < 40) { const int r = gt >> 3; base = (r == 0 ? GA : r == 1 ? GB : r == 2 ? BB : r == 3 ? BC : BH); ldc = DM; cb = (gt & 7) * 256; act = r < 2 ? 1 : 0; }
            else if (gt < 56) { base = ZS; ldc = DI; cb = (gt - 40) * 256; act = 2; }
            else { base = XBC; ldc = CONVD; cb = (gt - 56) * 256; act = 0; }
            const int col0 = cb + wc * 32 + 8 * fq;
#pragma unroll
            for (int ai = 0; ai < 2; ++ai)
#pragma unroll
                for (int m = 0; m < 4; ++m) { bf16_t* rowp = base + (size_t)(row0 + ai * 128 + m * 16) * ldc + col0;
#pragma unroll
                    for (int bj = 0; bj < 2; ++bj) { f32x4 v0 = acc[ai][bj][m][0], v1 = acc[ai][bj][m][1];
                        if (act == 1) {
#pragma unroll
                            for (int j = 0; j < 4; ++j) { v0[j] = sigmoidf_(v0[j]); v1[j] = sigmoidf_(v1[j]); } }
                        else if (act == 2) {
#pragma unroll
                            for (int j = 0; j < 4; ++j) { v0[j] = siluf_(v0[j]); v1[j] = siluf_(v1[j]); } }
                        *(u32x4*)(rowp + bj * 128) = pack8(v0, v1); } }
        } else if (wc < 2) {
            const int c0 = wc * 32 + 8 * fq;
            f32x4 b0 = *(const f32x4*)(dt_bias + c0), b1 = *(const f32x4*)(dt_bias + c0 + 4);
#pragma unroll
            for (int ai = 0; ai < 2; ++ai)
#pragma unroll
                for (int m = 0; m < 4; ++m) { float* rowp = DT + (size_t)(row0 + ai * 128 + m * 16) * NH + c0;
                    f32x4 v0 = acc[ai][0][m][0] + b0, v1 = acc[ai][0][m][1] + b1;
#pragma unroll
                    for (int j = 0; j < 4; ++j) { v0[j] = softplusf_(v0[j]); v1[j] = softplusf_(v1[j]); }
                    *(f32x4*)rowp = v0; *(f32x4*)(rowp + 4) = v1; }
        }
    }
};
template <bool ADD> struct EpiGate {
    const bf16_t* GATE; const bf16_t* PREV; bf16_t* O;
    __device__ __forceinline__ void operator()(const f32x4 (&acc)[2][2][4][2], const Unit& u, int wr, int wc, int fr, int fq) const {
        const int row0 = u.pm * 256 + wr * 64 + fr, col0 = u.pn * 256 + wc * 32 + 8 * fq;
#pragma unroll
        for (int ai = 0; ai < 2; ++ai)
#pragma unroll
            for (int m = 0; m < 4; ++m) { const size_t ro = (size_t)(row0 + ai * 128 + m * 16) * DM + col0;
#pragma unroll
                for (int bj = 0; bj < 2; ++bj) { const size_t idx = ro + bj * 128;
                    f32x4 g0, g1; unpack8(*(const u32x4*)(GATE + idx), g0, g1);
                    f32x4 v0 = g0 * acc[ai][bj][m][0], v1 = g1 * acc[ai][bj][m][1];
                    if (ADD) { f32x4 p0, p1; unpack8(*(const u32x4*)(PREV + idx), p0, p1); v0 += p0; v1 += p1; }
                    *(u32x4*)(O + idx) = pack8(v0, v1); } }
    }
};
template <bool WBF> struct EpiRes {
    const float* X; float* H; bf16_t* HBF; float* ssq;
    __device__ __forceinline__ void operator()(const f32x4 (&acc)[2][2][4][2], const Unit& u, int wr, int wc, int fr, int fq) const {
        const int row0 = u.pm * 256 + wr * 64 + fr, col0 = u.pn * 256 + wc * 32 + 8 * fq;
#pragma unroll
        for (int ai = 0; ai < 2; ++ai)
#pragma unroll
            for (int m = 0; m < 4; ++m) { const int row = row0 + ai * 128 + m * 16; const size_t ro = (size_t)row * DM + col0; float s = 0.f;
#pragma unroll
                for (int bj = 0; bj < 2; ++bj) { const size_t idx = ro + bj * 128;
                    f32x4 h0 = *(const f32x4*)(X + idx) + acc[ai][bj][m][0], h1 = *(const f32x4*)(X + idx + 4) + acc[ai][bj][m][1];
                    *(f32x4*)(H + idx) = h0; *(f32x4*)(H + idx + 4) = h1;
                    if (WBF) *(u32x4*)(HBF + idx) = pack8(h0, h1);
#pragma unroll
                    for (int j = 0; j < 4; ++j) s += h0[j] * h0[j] + h1[j] * h1[j]; }
                s += __shfl_xor(s, 16); s += __shfl_xor(s, 32);
                if (fq == 0) atomicAdd(ssq + row, s); }
    }
};
struct EpiSwiglu {
    const float* ssq; bf16_t* ACT;
    __device__ __forceinline__ void operator()(const f32x4 (&acc)[2][2][4][2], const Unit& u, int wr, int wc, int fr, int fq) const {
        const int row0 = u.pm * 256 + wr * 64 + fr, ch0 = u.pn * 128 + wc * 32 + 8 * fq;
#pragma unroll
        for (int ai = 0; ai < 2; ++ai)
#pragma unroll
            for (int m = 0; m < 4; ++m) { const int row = row0 + ai * 128 + m * 16; const float r = rsqrtf(ssq[row] * (1.0f / DM) + EPS);
                f32x4 v0, v1;
#pragma unroll
                for (int j = 0; j < 4; ++j) { v0[j] = siluf_(acc[ai][0][m][0][j] * r) * (acc[ai][1][m][0][j] * r); v1[j] = siluf_(acc[ai][0][m][1][j] * r) * (acc[ai][1][m][1][j] * r); }
                *(u32x4*)(ACT + (size_t)row * DFF + ch0) = pack8(v0, v1); }
    }
};

__device__ __forceinline__ int slot2lc(int slot) { return (slot & ~31) + pg8::perm32(slot & 31); }
__device__ __forceinline__ void conv_tile(LAS float* tile, const float* src0, const float* src1, int ldsrc, int nvalid, int K, bf16_t* dst, const float* kscale, int mode, int nt, int kt) {
    const int tid = threadIdx.x;
    { const int j = tid & 63, i0 = tid >> 6; const int nrow = nt * 64 + j, t256 = nrow >> 8, lc = slot2lc(nrow & 255);
      const float* s; int col; bool valid;
      if (mode == 0) { col = t256 * 256 + lc; s = src0; valid = col < nvalid; } else { col = t256 * 128 + (lc & 127); s = (lc >> 7) ? src1 : src0; valid = true; }
      if (!valid) col = 0;
      const float* sp = s + (size_t)(kt * 256 + i0) * ldsrc + col;
      float v[32];
#pragma unroll
      for (int ii = 0; ii < 32; ++ii) v[ii] = sp[(size_t)(8 * ii) * ldsrc];
#pragma unroll
      for (int ii = 0; ii < 32; ++ii) { const int kl = i0 + 8 * ii; float x = valid ? v[ii] : 0.f; if (kscale) x *= kscale[kt * 256 + kl]; tile[j * 257 + kl] = x; } }
    __syncthreads();
    { const int kk = (tid & 127) * 2, j0 = tid >> 7;
#pragma unroll
      for (int it = 0; it < 16; ++it) { const int j = j0 + 4 * it; *(unsigned*)(dst + (size_t)(nt * 64 + j) * K + kt * 256 + kk) = pk2(tile[j * 257 + kk], tile[j * 257 + kk + 1]); } }
    __syncthreads();
}

__device__ __forceinline__ void phase_prep(const Params& p, LAS unsigned char* lds) {
    LAS float* tile = (LAS float*)lds; unsigned char* ws = p.ws;
    constexpr int N0 = 324 * 8, N1 = N0 + 32 * 8, N2 = N1 + 32 * 16, N3 = N2 + 32 * 8, N4 = N3 + 176 * 8, N5 = N4 + 32 * 22;
    for (int it = blockIdx.x; it < N5; it += gridDim.x) {
        if (it < N0)      { const int i = it;      conv_tile(tile, p.w_in, nullptr, IN_COLS, IN_COLS, DM, (bf16_t*)(ws + OFF_WIN), nullptr, 0, i / 8, i % 8); }
        else if (it < N1) { const int i = it - N0; conv_tile(tile, p.w_out_a, nullptr, DM, DM, DM, (bf16_t*)(ws + OFF_WOA), nullptr, 0, i / 8, i % 8); }
        else if (it < N2) { const int i = it - N1; conv_tile(tile, p.w_out_ssm, nullptr, DM, DM, DI, (bf16_t*)(ws + OFF_WOS), nullptr, 0, i / 16, i % 16); }
        else if (it < N3) { const int i = it - N2; conv_tile(tile, p.w_o, nullptr, DM, DM, DM, (bf16_t*)(ws + OFF_WO), nullptr, 0, i / 8, i % 8); }
        else if (it < N4) { const int i = it - N3; conv_tile(tile, p.w_ffn_gate, p.w_ffn_up, DFF, DFF, DM, (bf16_t*)(ws + OFF_WGU), p.norm_ffn_g, 1, i / 8, i % 8); }
        else              { const int i = it - N4; conv_tile(tile, p.w_ffn_down, nullptr, DM, DM, DFF, (bf16_t*)(ws + OFF_WDN), nullptr, 0, i / 22, i % 22); }
    }
    { float* s1 = (float*)(ws + OFF_SSQ1); for (int i = blockIdx.x * 512 + threadIdx.x; i < 2 * NTOK; i += gridDim.x * 512) s1[i] = 0.f; }
    { const int wave = threadIdx.x >> 6, lane = threadIdx.x & 63; bf16_t* U = (bf16_t*)(ws + OFF_U);
      for (int row = (blockIdx.x * 8 + wave) * 2; row < NTOK; row += gridDim.x * 16) {
          const f32x4* xr = (const f32x4*)(p.x + (size_t)row * DM); f32x4 v[16]; float ss0 = 0.f, ss1 = 0.f;
#pragma unroll
          for (int i = 0; i < 16; ++i) v[i] = xr[lane + 64 * i];
#pragma unroll
          for (int i = 0; i < 8; ++i) { ss0 += v[i][0] * v[i][0] + v[i][1] * v[i][1] + v[i][2] * v[i][2] + v[i][3] * v[i][3]; ss1 += v[8 + i][0] * v[8 + i][0] + v[8 + i][1] * v[8 + i][1] + v[8 + i][2] * v[8 + i][2] + v[8 + i][3] * v[8 + i][3]; }
#pragma unroll
          for (int o = 32; o >= 1; o >>= 1) { ss0 += __shfl_xor(ss0, o); ss1 += __shfl_xor(ss1, o); }
          const float r0 = rsqrtf(ss0 * (1.0f / DM) + EPS), r1 = rsqrtf(ss1 * (1.0f / DM) + EPS);
#pragma unroll
          for (int i = 0; i < 16; ++i) { const float r = i < 8 ? r0 : r1; const f32x4 gg = ((const f32x4*)p.norm_mix_g)[lane + 64 * (i & 7)]; u32x2 w; w.x = pk2(v[i][0] * r * gg[0], v[i][1] * r * gg[1]); w.y = pk2(v[i][2] * r * gg[2], v[i][3] * r * gg[3]);
              *(u32x2*)(U + (size_t)row * DM + (lane + 64 * i) * 4) = w; } } }
}

__device__ __forceinline__ void phase_ssmconv(const Params& p) {
    const bf16_t* XBC = (const bf16_t*)(p.ws + OFF_XBC); bf16_t* XS = (bf16_t*)p.out; bf16_t* BCS = (bf16_t*)(p.ws + OFF_BCS);
    constexpr int TS = 16; const int total = (NTOK / TS) * 768;
    for (int idx = blockIdx.x * 512 + threadIdx.x; idx < total; idx += gridDim.x * 512) {
        const int t0 = (idx / 768) * TS, c = (idx % 768) * 8; const bool first = (t0 & (SEQ - 1)) == 0;
        u32x4 raw[TS + 3];
#pragma unroll
        for (int r = 0; r < TS + 3; ++r) raw[r] = (r < 3 && first) ? (u32x4){0u, 0u, 0u, 0u} : *(const u32x4*)(XBC + (size_t)(t0 - 3 + r) * CONVD + c);
        f32x4 w0[4], w1[4];
#pragma unroll
        for (int j = 0; j < 4; ++j) { w0[j] = *(const f32x4*)(p.ssm_conv_w + j * CONVD + c); w1[j] = *(const f32x4*)(p.ssm_conv_w + j * CONVD + c + 4); }
        const f32x4 b0 = *(const f32x4*)(p.ssm_conv_b + c), b1 = *(const f32x4*)(p.ssm_conv_b + c + 4);
        bf16_t* dst = (c < DI) ? XS + (size_t)t0 * DI + c : BCS + (size_t)t0 * 2048 + (c - DI); const int ldd = (c < DI) ? DI : 2048;
#pragma unroll
        for (int i = 0; i < TS; ++i) { f32x4 a0 = b0, a1 = b1;
#pragma unroll
            for (int j = 0; j < 4; ++j) { f32x4 r0, r1; unpack8(raw[i + j], r0, r1); a0 += w0[j] * r0; a1 += w1[j] * r1; }
#pragma unroll
            for (int j = 0; j < 4; ++j) { a0[j] = siluf_(a0[j]); a1[j] = siluf_(a1[j]); }
            *(u32x4*)(dst + (size_t)i * ldd) = pack8(a0, a1); }
    }
}

__device__ __forceinline__ void phase_ssd_seq(const Params& p, LAS unsigned char* lds) {
    LAS float* part = (LAS float*)lds;
    const int tid = threadIdx.x, pp = tid >> 3, ng = tid & 7, wave = tid >> 6, lane = tid & 63;
    const bf16_t* XS = (const bf16_t*)p.out; const bf16_t* BCS = (const bf16_t*)(p.ws + OFF_BCS); bf16_t* ZS = (bf16_t*)(p.ws + OFF_ZS);
    const float* DT = (const float*)(p.ws + OFF_DT); float* SSQH = (float*)(p.ws + OFF_SSQH);
    for (int item = blockIdx.x; item < 256; item += gridDim.x) {
        const int b = item >> 6, h = item & 63, g = h >> 3;
        const float a = -__expf(p.a_log[h]), Dk = p.d_skip[h];
        const bf16_t* xs = XS + (size_t)b * SEQ * DI + h * 64 + pp;
        const bf16_t* Bs = BCS + (size_t)b * SEQ * 2048 + g * 128 + ng * 16;
        const bf16_t* Cs = Bs + 1024;
        bf16_t* zs = ZS + (size_t)b * SEQ * DI + h * 64 + pp;
        const float* dt = DT + (size_t)b * SEQ * NH + h;
        float st[16];
#pragma unroll
        for (int i = 0; i < 16; ++i) st[i] = 0.f;
        for (int t0 = 0; t0 < SEQ; t0 += 64) {
#pragma unroll 4
            for (int tt = 0; tt < 64; ++tt) {
                const int t = t0 + tt;
                const float dtv = dt[(size_t)t * NH], xv = bf2f(xs[(size_t)t * DI]), zv = bf2f(zs[(size_t)t * DI]);
                f32x4 B0, B1, B2, B3, C0, C1, C2, C3;
                unpack8(*(const u32x4*)(Bs + (size_t)t * 2048), B0, B1); unpack8(*(const u32x4*)(Bs + (size_t)t * 2048 + 8), B2, B3);
                unpack8(*(const u32x4*)(Cs + (size_t)t * 2048), C0, C1); unpack8(*(const u32x4*)(Cs + (size_t)t * 2048 + 8), C2, C3);
                const float dA = __expf(dtv * a), xdt = xv * dtv; float y = 0.f;
#pragma unroll
                for (int i = 0; i < 4; ++i) {
                    st[i] = dA * st[i] + xdt * B0[i]; y += C0[i] * st[i];
                    st[4 + i] = dA * st[4 + i] + xdt * B1[i]; y += C1[i] * st[4 + i];
                    st[8 + i] = dA * st[8 + i] + xdt * B2[i]; y += C2[i] * st[8 + i];
                    st[12 + i] = dA * st[12 + i] + xdt * B3[i]; y += C3[i] * st[12 + i]; }
                y += __shfl_xor(y, 1); y += __shfl_xor(y, 2); y += __shfl_xor(y, 4);
                y += Dk * xv;
                const float yz = y * zv;
                if (ng == 0) zs[(size_t)t * DI] = (bf16_t)f2bf(yz);
                float sq = (ng == 0) ? yz * yz : 0.f;
                sq += __shfl_xor(sq, 8); sq += __shfl_xor(sq, 16); sq += __shfl_xor(sq, 32);
                if (lane == 0) part[tt * 8 + wave] = sq;
            }
            __syncthreads();
            if (tid < 64) { float s = 0.f;
#pragma unroll
                for (int w = 0; w < 8; ++w) s += part[tid * 8 + w];
                SSQH[(size_t)(b * SEQ + t0 + tid) * NH + h] = s; }
            __syncthreads();
        }
    }
}

typedef short s16x4 __attribute__((ext_vector_type(4)));
constexpr int SS_RSB = 272, SS_RSX = 144;
constexpr int SS_C = 0, SS_B = 34816, SS_X = 69632, SS_XW = 88064, SS_S = 106496, SS_SC = 123904, SS_M = 125952, SS_END = 160768;
__device__ __forceinline__ bf16x8 tr_frag(LAS unsigned char* lds, int addr, int step) {
    const s16x4 lo = __builtin_amdgcn_ds_read_tr16_b64_v4i16((LAS s16x4*)(lds + addr));
    const s16x4 hi = __builtin_amdgcn_ds_read_tr16_b64_v4i16((LAS s16x4*)(lds + addr + step));
    return __builtin_shufflevector(lo, hi, 0, 1, 2, 3, 4, 5, 6, 7);
}
#define MFMA16(a, b, c) __builtin_amdgcn_mfma_f32_16x16x32_bf16(a, b, c, 0, 0, 0)
#define WG_BAR() do { asm volatile("s_waitcnt lgkmcnt(0)" ::: "memory"); __builtin_amdgcn_s_barrier(); asm volatile("" ::: "memory"); } while (0)
__device__ __forceinline__ void phase_ssd_chunk(const Params& p, LAS unsigned char* lds) {
    const int tid = threadIdx.x, w = __builtin_amdgcn_readfirstlane(tid >> 6), lane = tid & 63, fr = lane & 15, g4 = lane >> 4, q = fr >> 2, pq = fr & 3;
    const bf16_t* XS = (const bf16_t*)p.out; const bf16_t* BCS = (const bf16_t*)(p.ws + OFF_BCS); bf16_t* ZS = (bf16_t*)(p.ws + OFF_ZS);
    const float* DT = (const float*)(p.ws + OFF_DT); float* SSQH = (float*)(p.ws + OFF_SSQH);
    LAS float* scal = (LAS float*)(lds + SS_SC);
    const int l = 16 * w + fr;
    for (int item = blockIdx.x; item < 256; item += gridDim.x) {
        const int b = item >> 6, grp = item & 7, h = grp * 8 + ((item >> 3) & 7);
        const float a = -__expf(p.a_log[h]), Dk = p.d_skip[h];
        f32x4 accS[4];
#pragma unroll
        for (int i = 0; i < 4; ++i) accS[i] = (f32x4){0.f, 0.f, 0.f, 0.f};
        u32x4 pb[4], pc[4], px[2]; float d0 = 0.f, d1 = 0.f;
        const bf16_t* bsrc = BCS + (size_t)(b * SEQ + (tid >> 4)) * 2048 + grp * 128 + (tid & 15) * 8;
        const bf16_t* xsrc = XS + (size_t)(b * SEQ + (tid >> 3)) * DI + h * 64 + (tid & 7) * 8;
        const float* dsrc = DT + (size_t)(b * SEQ + lane) * NH + h;
#define SSD_PREFETCH(c_) do { const size_t ro_ = (size_t)(c_) * 128; \
            _Pragma("unroll") for (int i = 0; i < 4; ++i) { pb[i] = *(const u32x4*)(bsrc + (ro_ + 32 * i) * 2048); pc[i] = *(const u32x4*)(bsrc + (ro_ + 32 * i) * 2048 + 1024); } \
            _Pragma("unroll") for (int i = 0; i < 2; ++i) px[i] = *(const u32x4*)(xsrc + (ro_ + 64 * i) * DI); \
            if (w == 0) { d0 = dsrc[ro_ * NH]; d1 = dsrc[(ro_ + 64) * NH]; } } while (0)
#define SSD_SCAN(buf_) do { if (w == 0) { float s0 = d0 * a, s1 = d1 * a; \
            _Pragma("unroll") for (int o = 1; o < 64; o <<= 1) { const float t0 = __shfl_up(s0, o), t1 = __shfl_up(s1, o); if (lane >= o) { s0 += t0; s1 += t1; } } \
            s1 += __shfl(s0, 63); LAS float* cs_ = scal + (buf_) * 256; cs_[lane] = s0; cs_[64 + lane] = s1; cs_[128 + lane] = d0; cs_[192 + lane] = d1; } } while (0)
        SSD_PREFETCH(0);
        for (int i = tid; i < 64 * SS_RSB / 16; i += 512) *(LAS u32x4*)(lds + SS_S + i * 16) = (u32x4){0u, 0u, 0u, 0u};
        SSD_SCAN(0);
        WG_BAR();
        for (int c = 0; c < 32; ++c) {
            const int tok0 = b * SEQ + c * 128;
            LAS float* csA = scal + (c & 1) * 256; LAS float* dtA = csA + 128;
            const float csend = csA[127];
#pragma unroll
            for (int i = 0; i < 4; ++i) { const int row = (tid >> 4) + 32 * i, ch = tid & 15; *(LAS u32x4*)(lds + SS_B + row * SS_RSB + ch * 16) = pb[i]; *(LAS u32x4*)(lds + SS_C + row * SS_RSB + ch * 16) = pc[i]; }
#pragma unroll
            for (int i = 0; i < 2; ++i) { const int row = (tid >> 3) + 64 * i, ch = tid & 7; *(LAS u32x4*)(lds + SS_X + row * SS_RSX + ch * 16) = px[i];
                const float wl = __expf(csend - csA[row]) * dtA[row]; f32x4 v0, v1; unpack8(px[i], v0, v1); v0 *= wl; v1 *= wl; *(LAS u32x4*)(lds + SS_XW + row * SS_RSX + ch * 16) = pack8(v0, v1); }
            WG_BAR();
            if (c + 1 < 32) SSD_PREFETCH(c + 1);
            const size_t tok = (size_t)(tok0 + l);
            bf16_t* zp = ZS + tok * DI + h * 64 + 4 * g4;
            u32x2 z2[4];
#pragma unroll
            for (int pt = 0; pt < 4; ++pt) z2[pt] = *(const u32x2*)(zp + 16 * pt);
            const float csl = csA[l];
            bf16x8 cf[4];
#pragma unroll
            for (int ks = 0; ks < 4; ++ks) cf[ks] = *(const LAS bf16x8*)(lds + SS_C + l * SS_RSB + (4 * ks + g4) * 16);
            f32x4 accY[4];
            { bf16x8 sf[4][4];
#pragma unroll
              for (int pt = 0; pt < 4; ++pt)
#pragma unroll
                  for (int ks = 0; ks < 4; ++ks) sf[pt][ks] = *(const LAS bf16x8*)(lds + SS_S + (16 * pt + fr) * SS_RSB + (4 * ks + g4) * 16);
#pragma unroll
              for (int pt = 0; pt < 4; ++pt) accY[pt] = (f32x4){0.f, 0.f, 0.f, 0.f};
#pragma unroll
              for (int ks = 0; ks < 4; ++ks)
#pragma unroll
                  for (int pt = 0; pt < 4; ++pt) accY[pt] = MFMA16(sf[pt][ks], cf[ks], accY[pt]);
              const float el = __expf(csl);
#pragma unroll
              for (int pt = 0; pt < 4; ++pt) accY[pt] *= el; }
#pragma unroll
            for (int sp = 0; sp < 4; ++sp) {
                if (2 * sp <= w) {
                    bf16x8 bfr[2][4];
#pragma unroll
                    for (int e = 0; e < 2; ++e)
#pragma unroll
                        for (int ks = 0; ks < 4; ++ks) bfr[e][ks] = *(const LAS bf16x8*)(lds + SS_B + (16 * (2 * sp + e) + fr) * SS_RSB + (4 * ks + g4) * 16);
                    f32x4 cs4[2], dt4[2];
#pragma unroll
                    for (int e = 0; e < 2; ++e) { cs4[e] = *(const LAS f32x4*)(csA + 16 * (2 * sp + e) + 4 * g4); dt4[e] = *(const LAS f32x4*)(dtA + 16 * (2 * sp + e) + 4 * g4); }
                    f32x4 a1[2] = {(f32x4){0.f, 0.f, 0.f, 0.f}, (f32x4){0.f, 0.f, 0.f, 0.f}};
#pragma unroll
                    for (int ks = 0; ks < 4; ++ks)
#pragma unroll
                        for (int e = 0; e < 2; ++e) a1[e] = MFMA16(bfr[e][ks], cf[ks], a1[e]);
#pragma unroll
                    for (int e = 0; e < 2; ++e) { float v[4];
#pragma unroll
                        for (int r = 0; r < 4; ++r) { const int s = 16 * (2 * sp + e) + 4 * g4 + r; const float t = a1[e][r] * __expf(fminf(csl - cs4[e][r], 0.f)) * dt4[e][r]; v[r] = (s <= l) ? t : 0.f; }
                        u32x2 pk; pk.x = pk2(v[0], v[1]); pk.y = pk2(v[2], v[3]); *(LAS u32x2*)(lds + SS_M + l * SS_RSB + (16 * (2 * sp + e) + 4 * g4) * 2) = pk; } } }
            { const float dec = __expf(csend);
#pragma unroll
              for (int pt = 0; pt < 4; ++pt) accS[pt] *= dec;
#pragma unroll
              for (int kp = 0; kp < 2; ++kp) { bf16x8 btf[2], xwf[2][4];
#pragma unroll
                  for (int e = 0; e < 2; ++e) { const int ks = 2 * kp + e; btf[e] = tr_frag(lds, SS_B + (32 * ks + 8 * g4 + q) * SS_RSB + (16 * w + 4 * pq) * 2, 4 * SS_RSB);
#pragma unroll
                      for (int pt = 0; pt < 4; ++pt) xwf[e][pt] = tr_frag(lds, SS_XW + (32 * ks + 8 * g4 + q) * SS_RSX + (16 * pt + 4 * pq) * 2, 4 * SS_RSX); }
#pragma unroll
                  for (int e = 0; e < 2; ++e)
#pragma unroll
                      for (int pt = 0; pt < 4; ++pt) accS[pt] = MFMA16(btf[e], xwf[e][pt], accS[pt]); } }
            if (c + 1 < 32) SSD_SCAN((c + 1) & 1);
#pragma unroll
            for (int ks = 0; ks < 4; ++ks) { if (2 * ks <= w) { const bf16x8 mf = *(const LAS bf16x8*)(lds + SS_M + l * SS_RSB + (4 * ks + g4) * 16); bf16x8 xf[4];
#pragma unroll
                for (int pt = 0; pt < 4; ++pt) xf[pt] = tr_frag(lds, SS_X + (32 * ks + 8 * g4 + q) * SS_RSX + (16 * pt + 4 * pq) * 2, 4 * SS_RSX);
#pragma unroll
                for (int pt = 0; pt < 4; ++pt) accY[pt] = MFMA16(xf[pt], mf, accY[pt]); } }
            { float sq = 0.f;
#pragma unroll
              for (int pt = 0; pt < 4; ++pt) { const u32x2 x2 = *(const LAS u32x2*)(lds + SS_X + l * SS_RSX + (16 * pt + 4 * g4) * 2);
                  const float y0 = (accY[pt][0] + Dk * bflo(x2.x)) * bflo(z2[pt].x), y1 = (accY[pt][1] + Dk * bfhi(x2.x)) * bfhi(z2[pt].x), y2 = (accY[pt][2] + Dk * bflo(x2.y)) * bflo(z2[pt].y), y3 = (accY[pt][3] + Dk * bfhi(x2.y)) * bfhi(z2[pt].y);
                  sq += y0 * y0 + y1 * y1 + y2 * y2 + y3 * y3; u32x2 o; o.x = pk2(y0, y1); o.y = pk2(y2, y3); *(u32x2*)(zp + 16 * pt) = o; }
              sq += __shfl_xor(sq, 16); sq += __shfl_xor(sq, 32);
              if (g4 == 0) SSQH[tok * NH + h] = sq; }
            WG_BAR();
#pragma unroll
            for (int pt = 0; pt < 4; ++pt) { u32x2 pk; pk.x = pk2(accS[pt][0], accS[pt][1]); pk.y = pk2(accS[pt][2], accS[pt][3]); *(LAS u32x2*)(lds + SS_S + (16 * pt + fr) * SS_RSB + (16 * w + 4 * g4) * 2) = pk; }
        }
        WG_BAR();
#undef SSD_PREFETCH
#undef SSD_SCAN
    }
}

__device__ __forceinline__ void phase_gnorm(const Params& p) {
    bf16_t* ZS = (bf16_t*)(p.ws + OFF_ZS); const float* SSQH = (const float*)(p.ws + OFF_SSQH);
    const int total = NTOK * 512 / 4;
    for (int idx = blockIdx.x * 512 + threadIdx.x; idx < total; idx += gridDim.x * 512) {
        const int t0 = (idx >> 9) * 4, cg8 = idx & 511, c = cg8 * 8, g = cg8 >> 6;
        u32x4 raw[4]; f32x4 s0[4], s1[4];
#pragma unroll
        for (int i = 0; i < 4; ++i) { raw[i] = *(const u32x4*)(ZS + (size_t)(t0 + i) * DI + c); s0[i] = *(const f32x4*)(SSQH + (size_t)(t0 + i) * NH + g * 8); s1[i] = *(const f32x4*)(SSQH + (size_t)(t0 + i) * NH + g * 8 + 4); }
        const f32x4 g0 = *(const f32x4*)(p.ssm_norm_g + c), g1 = *(const f32x4*)(p.ssm_norm_g + c + 4);
#pragma unroll
        for (int i = 0; i < 4; ++i) { const float ss = s0[i][0] + s0[i][1] + s0[i][2] + s0[i][3] + s1[i][0] + s1[i][1] + s1[i][2] + s1[i][3]; const float r = rsqrtf(ss * (1.0f / 512.0f) + EPS);
            f32x4 v0, v1; unpack8(raw[i], v0, v1); v0 = v0 * r * g0; v1 = v1 * r * g1; *(u32x4*)(ZS + (size_t)(t0 + i) * DI + c) = pack8(v0, v1); }
    }
}

__device__ __forceinline__ void phase_mixa(const Params& p) {
    const bf16_t* BB = (const bf16_t*)(p.ws + OFF_BB); const bf16_t* BC = (const bf16_t*)(p.ws + OFF_BC); const bf16_t* BH = (const bf16_t*)(p.ws + OFF_BH); bf16_t* YA = (bf16_t*)(p.ws + OFF_U);
    constexpr int TS = 8; const int total = (NTOK / TS) * 256;
    for (int idx = blockIdx.x * 512 + threadIdx.x; idx < total; idx += gridDim.x * 512) {
        const int t0 = (idx >> 8) * TS, c = (idx & 255) * 8; const bool first = (t0 & (SEQ - 1)) == 0;
        u32x4 rc[TS + 2], rh[TS + 2], rb[TS];
#pragma unroll
        for (int r = 0; r < TS + 2; ++r) { const size_t o = (size_t)(t0 - 2 + r) * DM + c; const bool z = (r < 2 && first); rc[r] = z ? (u32x4){0u, 0u, 0u, 0u} : *(const u32x4*)(BC + o); rh[r] = z ? (u32x4){0u, 0u, 0u, 0u} : *(const u32x4*)(BH + o); }
#pragma unroll
        for (int i = 0; i < TS; ++i) rb[i] = *(const u32x4*)(BB + (size_t)(t0 + i) * DM + c);
        f32x4 w0[3], w1[3];
#pragma unroll
        for (int j = 0; j < 3; ++j) { w0[j] = *(const f32x4*)(p.conv_a_w + j * DM + c); w1[j] = *(const f32x4*)(p.conv_a_w + j * DM + c + 4); }
        f32x4 q0[3], q1[3];
#pragma unroll
        for (int r = 0; r < 2; ++r) { f32x4 c0, c1, h0, h1; unpack8(rc[r], c0, c1); unpack8(rh[r], h0, h1); q0[r] = c0 * h0; q1[r] = c1 * h1; }
#pragma unroll
        for (int i = 0; i < TS; ++i) { { f32x4 c0, c1, h0, h1; unpack8(rc[i + 2], c0, c1); unpack8(rh[i + 2], h0, h1); q0[2] = c0 * h0; q1[2] = c1 * h1; }
            f32x4 a0 = w0[0] * q0[0] + w0[1] * q0[1] + w0[2] * q0[2], a1 = w1[0] * q1[0] + w1[1] * q1[1] + w1[2] * q1[2];
            f32x4 b0, b1; unpack8(rb[i], b0, b1);
            *(u32x4*)(YA + (size_t)(t0 + i) * DM + c) = pack8(a0 * b0, a1 * b1);
            q0[0] = q0[1]; q0[1] = q0[2]; q1[0] = q1[1]; q1[1] = q1[2]; }
    }
}

__device__ __forceinline__ void phase_final(const Params& p) {
    const float* SSQ2 = (const float*)(p.ws + OFF_SSQ2);
    const int total = NTOK * 512 / 4;
    for (int idx = blockIdx.x * 512 + threadIdx.x; idx < total; idx += gridDim.x * 512) {
        const int t0 = (idx >> 9) * 4, c = (idx & 511) * 4;
        f32x4 v[4]; float r[4];
#pragma unroll
        for (int i = 0; i < 4; ++i) { v[i] = *(const f32x4*)(p.out + (size_t)(t0 + i) * DM + c); r[i] = SSQ2[t0 + i]; }
        const f32x4 g = *(const f32x4*)(p.norm_final_g + c);
#pragma unroll
        for (int i = 0; i < 4; ++i) *(f32x4*)(p.out + (size_t)(t0 + i) * DM + c) = v[i] * rsqrtf(r[i] * (1.0f / DM) + EPS) * g;
    }
}

#define XB_TMO      128
#define XB_XCNT(j)  (256  + 64 * (j))
#define XB_XSUB(j)  (1280 + 64 * (j))
#define XB_XGEN(j)  (2304 + 64 * (j))
#define XB_TOP      3328
#define XB_TOPGEN   3392
#define XCD_BAR_WORDS 3456
#define XB_SPIN_CAP (1u << 18)

__device__ __forceinline__ unsigned xb_ld(unsigned* p)              { return __hip_atomic_load(p, __ATOMIC_RELAXED, __HIP_MEMORY_SCOPE_AGENT); }
__device__ __forceinline__ unsigned xb_add(unsigned* p, unsigned v) { return __hip_atomic_fetch_add(p, v, __ATOMIC_RELAXED, __HIP_MEMORY_SCOPE_AGENT); }
__device__ __forceinline__ unsigned xb_xcc_id() { return (unsigned)__builtin_amdgcn_s_getreg((3 << 11) | 20) & 0xFu; }
#define XB_SPIN(cond, bar) do { unsigned _sp = 0; while (cond) { __builtin_amdgcn_s_sleep(1); \
    if ((++_sp & 255u) == 0u) { if (xb_ld(&(bar)[XB_TMO])) break; if (_sp > XB_SPIN_CAP) { atomicAdd(&(bar)[XB_TMO], 1u); break; } } } } while (0)

struct XcdBarrier {
    unsigned* bar; unsigned x;
    volatile LAS unsigned* st;
};

__device__ __forceinline__ XcdBarrier xcd_barrier_post(unsigned* bar, volatile LAS unsigned* st) {
    XcdBarrier b; b.bar = bar; b.x = xb_xcc_id(); b.st = st;
    if (threadIdx.x == 0) (void)xb_add(&bar[XB_XCNT(b.x)], 1u);
    return b;
}
__device__ __forceinline__ void xcd_barrier_complete(unsigned* bar, unsigned x, unsigned& nloc, unsigned& nx) {
    const unsigned G = gridDim.x * gridDim.y * gridDim.z;
    unsigned sum, cnt, mine, sp = 0u;
    for (;;) {
        sum = 0u; cnt = 0u; mine = 0u;
#pragma unroll
        for (unsigned j = 0; j < 16; ++j) { const unsigned c = xb_ld(&bar[XB_XCNT(j)]); sum += c; cnt += (c > 0u) ? 1u : 0u; mine = (j == x) ? c : mine; }
        if (sum == G) break;
        __builtin_amdgcn_s_sleep(1);
        if ((++sp & 255u) == 0u) { if (xb_ld(&bar[XB_TMO])) break; if (sp > XB_SPIN_CAP) { atomicAdd(&bar[XB_TMO], 1u); break; } }
    }
    nloc = mine > 0u ? mine : 1u; nx = cnt > 0u ? cnt : 1u;
}

__device__ __forceinline__ void xcd_barrier(const XcdBarrier& b) {
    asm volatile("s_waitcnt vmcnt(0)" ::: "memory");
    __syncthreads();
    if (threadIdx.x == 0) {
        unsigned* bar = b.bar;
        __builtin_amdgcn_s_waitcnt(0);
        unsigned nloc = b.st[0], nx = b.st[1];
        if (nloc == 0u) { xcd_barrier_complete(bar, b.x, nloc, nx); b.st[0] = nloc; b.st[1] = nx; }
        const unsigned old = xb_add(&bar[XB_XSUB(b.x)], 1u);
        const unsigned gen = old / nloc;
        if (old + 1u == (gen + 1u) * nloc) {
            __builtin_amdgcn_fence(__ATOMIC_RELEASE, "agent");
            asm volatile("s_waitcnt vmcnt(0)" ::: "memory");
            const unsigned og = xb_add(&bar[XB_TOP], 1u);
            const unsigned tg = og / nx;
            if (og + 1u == (tg + 1u) * nx) xb_add(&bar[XB_TOPGEN], 1u);
            else XB_SPIN(xb_ld(&bar[XB_TOPGEN]) == tg, bar);
            __builtin_amdgcn_fence(__ATOMIC_ACQUIRE, "agent");
            xb_add(&bar[XB_XGEN(b.x)], 1u);
            asm volatile("s_waitcnt vmcnt(0)" ::: "memory");
        } else {
            XB_SPIN(xb_ld(&bar[XB_XGEN(b.x)]) == gen, bar);
            __builtin_amdgcn_fence(__ATOMIC_ACQUIRE, "agent");
            asm volatile("s_waitcnt vmcnt(0)" ::: "memory");
        }
    }
    __syncthreads();
}

constexpr int NPHASE = 11;
template <int PH> __device__ __forceinline__ void run_phase(const Params& p, LAS unsigned char* lds) {
    unsigned char* ws = p.ws;
    pg8::StaticOrder S; pg8::Gemm g;
    if constexpr (PH == 0) { phase_prep(p, lds); }
    else if constexpr (PH == 1) {
        g.A = (const bf16_t*)(ws + OFF_U); g.Bt = (const bf16_t*)(ws + OFF_WIN) + (size_t)40 * 256 * DM; g.M = NTOK; g.N = 41 * 256; g.K = DM; S.init(g.M, g.N, gridDim.x, blockIdx.x);
        EpiRoute E{(bf16_t*)p.out, (bf16_t*)p.out + (size_t)NTOK * DM, (bf16_t*)(ws + OFF_BB), (bf16_t*)(ws + OFF_BC), (bf16_t*)(ws + OFF_BH), (bf16_t*)(ws + OFF_ZS), (bf16_t*)(ws + OFF_XBC), (float*)(ws + OFF_DT), p.dt_bias, 40};
        pg8::gemm_phase(lds, g, S, E); }
    else if constexpr (PH == 2) { phase_ssmconv(p); }
    else if constexpr (PH == 3) { phase_ssd_chunk(p, lds); }
    else if constexpr (PH == 4) {
        g.A = (const bf16_t*)(ws + OFF_U); g.Bt = (const bf16_t*)(ws + OFF_WIN); g.M = NTOK; g.N = 40 * 256; g.K = DM; S.init(g.M, g.N, gridDim.x, blockIdx.x);
        EpiRoute E{(bf16_t*)p.out, (bf16_t*)p.out + (size_t)NTOK * DM, (bf16_t*)(ws + OFF_BB), (bf16_t*)(ws + OFF_BC), (bf16_t*)(ws + OFF_BH), (bf16_t*)(ws + OFF_ZS), (bf16_t*)(ws + OFF_XBC), (float*)(ws + OFF_DT), p.dt_bias, 0};
        pg8::gemm_phase(lds, g, S, E);
        phase_gnorm(p); }
    else if constexpr (PH == 5) { phase_mixa(p); }
    else if constexpr (PH == 6) {
        g.A = (const bf16_t*)(ws + OFF_U); g.Bt = (const bf16_t*)(ws + OFF_WOA); g.M = NTOK; g.N = DM; g.K = DM; S.init(g.M, g.N, gridDim.x, blockIdx.x);
        EpiGate<false> Ea{(const bf16_t*)p.out, nullptr, (bf16_t*)(ws + OFF_BB)};
        pg8::gemm_phase(lds, g, S, Ea);
        g.A = (const bf16_t*)(ws + OFF_ZS); g.Bt = (const bf16_t*)(ws + OFF_WOS); g.K = DI;
        EpiGate<true> Eb{(const bf16_t*)p.out + (size_t)NTOK * DM, (const bf16_t*)(ws + OFF_BB), (bf16_t*)(ws + OFF_BC)};
        pg8::gemm_phase(lds, g, S, Eb); }
    else if constexpr (PH == 7) {
        g.A = (const bf16_t*)(ws + OFF_BC); g.Bt = (const bf16_t*)(ws + OFF_WO); g.M = NTOK; g.N = DM; g.K = DM; S.init(g.M, g.N, gridDim.x, blockIdx.x);
        EpiRes<true> E{p.x, p.out, (bf16_t*)(ws + OFF_BH), (float*)(ws + OFF_SSQ1)};
        pg8::gemm_phase(lds, g, S, E); }
    else if constexpr (PH == 8) {
        g.A = (const bf16_t*)(ws + OFF_BH); g.Bt = (const bf16_t*)(ws + OFF_WGU); g.M = NTOK; g.N = 2 * DFF; g.K = DM; S.init(g.M, g.N, gridDim.x, blockIdx.x);
        EpiSwiglu E{(const float*)(ws + OFF_SSQ1), (bf16_t*)(ws + OFF_ZS)};
        pg8::gemm_phase(lds, g, S, E); }
    else if constexpr (PH == 9) {
        g.A = (const bf16_t*)(ws + OFF_ZS); g.Bt = (const bf16_t*)(ws + OFF_WDN); g.M = NTOK; g.N = DM; g.K = DFF; S.init(g.M, g.N, gridDim.x, blockIdx.x);
        EpiRes<false> E{p.out, p.out, nullptr, (float*)(ws + OFF_SSQ2)};
        pg8::gemm_phase(lds, g, S, E); }
    else if constexpr (PH == 10) { phase_final(p); }
}

template <int PH> __global__ void __launch_bounds__(512, 2) k_one(Params p) {
    extern __shared__ __attribute__((aligned(16))) unsigned char lds_raw[];
    run_phase<PH>(p, (LAS unsigned char*)lds_raw);
}

#ifndef PROBE_MASK
#define PROBE_MASK 0
#endif
__global__ void __launch_bounds__(512, 2) k_mega(Params p) {
    extern __shared__ __attribute__((aligned(16))) unsigned char lds_raw[];
    LAS unsigned char* lds = (LAS unsigned char*)lds_raw;
    cg::grid_group grid = cg::this_grid();
    unsigned long long spin = 0, t0 = 0;
    volatile LAS unsigned* bst = (volatile LAS unsigned*)(lds + SS_END);
    if (threadIdx.x < 4) bst[threadIdx.x] = 0u;
    __syncthreads();
    const XcdBarrier xbar = xcd_barrier_post((unsigned*)(p.ws + OFF_BAR), bst);
#define PH_RUN(i, SYNC) do { if (PROBE_MASK) t0 = __builtin_amdgcn_s_memrealtime(); run_phase<i>(p, lds); if (SYNC == 1) grid.sync(); else if (SYNC == 2) xcd_barrier(xbar); \
        if (PROBE_MASK & (1 << i)) spin += __builtin_amdgcn_s_memrealtime() - t0; } while (0)
    PH_RUN(0, 1); PH_RUN(1, 2); PH_RUN(2, 2); PH_RUN(3, 2); PH_RUN(4, 2); PH_RUN(5, 2); PH_RUN(6, 2); PH_RUN(7, 2); PH_RUN(8, 2); PH_RUN(9, 2); PH_RUN(10, 0);
#ifdef PROBE_SYNCS
    for (int i = 0; i < PROBE_SYNCS; ++i) xcd_barrier(xbar);
#endif
    if (PROBE_MASK && blockIdx.x == 0) { t0 = __builtin_amdgcn_s_memrealtime(); while (__builtin_amdgcn_s_memrealtime() - t0 < spin) __builtin_amdgcn_s_sleep(8); }
}

constexpr int LDS_BYTES = SS_END + 16;

template <int PH> static void launch_one(const Params& p, int grid, hipStream_t stream) {
    static bool attr = false;
    if (!attr) { (void)hipFuncSetAttribute((const void*)k_one<PH>, hipFuncAttributeMaxDynamicSharedMemorySize, LDS_BYTES); attr = true; }
    hipLaunchKernelGGL(k_one<PH>, dim3(grid), dim3(512), LDS_BYTES, stream, p);
}

extern "C" void kernel_launch(void* const* d_in, const int* in_sizes, int n_in, void* d_out, int out_size, void* d_ws, size_t ws_size, hipStream_t stream) {
    static int grid = 0;
    if (grid == 0) {
        if (n_in != 18 || out_size != NTOK * DM || ws_size < WS_END) { fprintf(stderr, "kernel_launch: unexpected shapes: n_in %d out %d ws %zu (need %zu)\n", n_in, out_size, ws_size, (size_t)WS_END); grid = -1; return; }
        int dev = 0, cus = 0, per_cu = 0;
        (void)hipGetDevice(&dev); (void)hipDeviceGetAttribute(&cus, hipDeviceAttributeMultiprocessorCount, dev);
        (void)hipFuncSetAttribute((const void*)k_mega, hipFuncAttributeMaxDynamicSharedMemorySize, LDS_BYTES);
        (void)hipOccupancyMaxActiveBlocksPerMultiprocessor(&per_cu, (const void*)k_mega, 512, LDS_BYTES);
        if (per_cu < 1) { fprintf(stderr, "kernel_launch: occupancy query says %d blocks per CU\n", per_cu); per_cu = 1; }
        (void)hipGetLastError();
        grid = cus * per_cu;
        fprintf(stderr, "kernel_launch: cus %d per_cu %d grid %d ws %zu\n", cus, per_cu, grid, ws_size);
    }
    if (grid < 0) return;
    Params p{};
    const float** pp = (const float**)&p;
    for (int i = 0; i < 18; ++i) pp[i] = (const float*)d_in[i];
    p.out = (float*)d_out; p.ws = (unsigned char*)d_ws;
#if MEGA
    (void)hipMemsetAsync((unsigned char*)d_ws + OFF_BAR, 0, XCD_BAR_WORDS * 4, stream);
    void* args[] = {&p};
    hipError_t e = hipLaunchCooperativeKernel((const void*)k_mega, dim3(grid), dim3(512), args, LDS_BYTES, stream);
    if (e != hipSuccess) fprintf(stderr, "cooperative launch failed: %s (grid %d)\n", hipGetErrorString(e), grid);
#else
    launch_one<0>(p, grid, stream); launch_one<1>(p, grid, stream); launch_one<2>(p, grid, stream); launch_one<3>(p, grid, stream); launch_one<4>(p, grid, stream); launch_one<5>(p, grid, stream);
    launch_one<6>(p, grid, stream); launch_one<7>(p, grid, stream); launch_one<8>(p, grid, stream); launch_one<9>(p, grid, stream); launch_one<10>(p, grid, stream);
#endif
}
```

```cpp
#include <hip/hip_runtime.h>
#include <hip/hip_cooperative_groups.h>
#include <cstdio>
namespace cg = cooperative_groups;

#ifndef MEGA
#define MEGA 1
#endif

#define LAS __attribute__((address_space(3)))
typedef unsigned short bf16_t;
typedef short bf16x8 __attribute__((ext_vector_type(8)));
typedef float f32x4 __attribute__((ext_vector_type(4)));
typedef unsigned u32x4 __attribute__((ext_vector_type(4)));
typedef unsigned u32x2 __attribute__((ext_vector_type(2)));

constexpr int DM = 2048, NTOK = 16384, SEQ = 4096;
constexpr int IN_COLS = 20544, IN_TILES = 81;
constexpr int DI = 4096, NH = 64, HD = 64, NG = 8, NST = 128, CONVD = 6144;
constexpr int DFF = 5632;
constexpr float EPS = 1e-6f;

constexpr size_t MiB = 1024ull * 1024ull;
constexpr size_t OFF_WIN = 0;
constexpr size_t OFF_WOA = 81 * MiB;
constexpr size_t OFF_WOS = 89 * MiB;
constexpr size_t OFF_WO  = 105 * MiB;
constexpr size_t OFF_WGU = 113 * MiB;
constexpr size_t OFF_WDN = 157 * MiB;
constexpr size_t OFF_ZS  = 179 * MiB;
constexpr size_t OFF_U   = 307 * MiB;
constexpr size_t OFF_XBC = 371 * MiB;
constexpr size_t OFF_BB  = 371 * MiB, OFF_BC = 435 * MiB, OFF_BH = 499 * MiB;
constexpr size_t OFF_DT  = 563 * MiB;
constexpr size_t OFF_SSQH = 567 * MiB;
constexpr size_t OFF_SSQ1 = 571 * MiB;
constexpr size_t OFF_SSQ2 = 571 * MiB + 65536;
constexpr size_t OFF_BCS = 572 * MiB;
constexpr size_t OFF_BAR = 636 * MiB;
constexpr size_t WS_END = 637 * MiB;

struct Params {
    const float *x, *norm_mix_g, *w_in, *conv_a_w, *w_out_a, *ssm_conv_w, *ssm_conv_b, *dt_bias, *a_log, *d_skip, *ssm_norm_g, *w_out_ssm, *w_o, *norm_ffn_g, *w_ffn_gate, *w_ffn_up,
        *w_ffn_down, *norm_final_g;
    float* out; unsigned char* ws;
};

__device__ __forceinline__ unsigned f2bf(float f) { unsigned u = __builtin_bit_cast(unsigned, f); return (u + 0x7fffu + ((u >> 16) & 1u)) >> 16; }
__device__ __forceinline__ unsigned pk2(float lo, float hi) { unsigned r; asm("v_cvt_pk_bf16_f32 %0, %1, %2" : "=v"(r) : "v"(lo), "v"(hi)); return r; }
__device__ __forceinline__ float bflo(unsigned w) { return __builtin_bit_cast(float, w << 16); }
__device__ __forceinline__ float bfhi(unsigned w) { return __builtin_bit_cast(float, w & 0xffff0000u); }
__device__ __forceinline__ float bf2f(bf16_t v) { return __builtin_bit_cast(float, ((unsigned)v) << 16); }
__device__ __forceinline__ float sigmoidf_(float v) { return __builtin_amdgcn_rcpf(1.0f + __expf(-v)); }
__device__ __forceinline__ float siluf_(float v) { return v * sigmoidf_(v); }
__device__ __forceinline__ float softplusf_(float v) { return fmaxf(v, 0.f) + log1pf(__expf(-fabsf(v))); }
__device__ __forceinline__ u32x4 pack8(const f32x4& a, const f32x4& b) { u32x4 w; w.x = pk2(a[0], a[1]); w.y = pk2(a[2], a[3]); w.z = pk2(b[0], b[1]); w.w = pk2(b[2], b[3]); return w; }
__device__ __forceinline__ void unpack8(const u32x4& w, f32x4& a, f32x4& b) { a[0] = bflo(w.x); a[1] = bfhi(w.x); a[2] = bflo(w.y); a[3] = bfhi(w.y); b[0] = bflo(w.z); b[1] = bfhi(w.z); b[2] = bflo(w.w); b[3] = bfhi(w.w); }

namespace pg8 {
constexpr int BM = 256, BK = 64, HALF = 128, HTB = HALF * BK * 2, STAGE_BYTES = 8 * HTB, NXCD = 8, WGM = 8;
__host__ __device__ __forceinline__ int lds_byte(int r, int c) { const int st = (r >> 4) * 2 + (c >> 5), rr = r & 15, cc = c & 31, ob = rr * 64 + cc * 2; return st * 1024 + (ob ^ (((ob >> 9) & 1) << 5)); }
__host__ __device__ __forceinline__ void stage_rc(int b, int& R, int& C) { const int st = b / 1024, sb = b % 1024, swz = sb ^ (((sb >> 9) & 1) << 5); R = (st >> 1) * 16 + swz / 64; C = (st & 1) * 32 + (swz % 64) / 2; }
__host__ __device__ __forceinline__ int perm32(int rho) { const int n = rho >> 4, i = rho & 15; return 8 * (i >> 2) + 4 * n + (i & 3); }
struct Unit { int pm, pn; };
struct Gemm { const bf16_t* A; const bf16_t* Bt; int M, N, K; };
struct StaticOrder {
    int nM, nN, nwg, G, c;
    __host__ __device__ void init(int M, int N, int G_, int c_) { nM = M / BM; nN = N / BM; nwg = nM * nN; G = G_; c = c_; }
    __host__ __device__ bool next(int i, Unit& u) const {
        const long L = (long)i * G + c; if (L >= nwg) return false;
        int wgid = (int)L; { const int q = nwg / NXCD, r = nwg % NXCD, xcd = wgid % NXCD, off = wgid / NXCD; wgid = (xcd < r ? xcd * (q + 1) : r * (q + 1) + (xcd - r) * q) + off; }
        const int nig = WGM * nN, gid = wgid / nig, fm = gid * WGM, gsz = (nM - fm) < WGM ? (nM - fm) : WGM;
        u.pm = fm + ((wgid % nig) % gsz); u.pn = (wgid % nig) / gsz; return true;
    }
};

template <class Epi>
__device__ __forceinline__ void gemm_phase(LAS unsigned char* lds, const Gemm g, const StaticOrder& S, const Epi& E) {
    const int tid = threadIdx.x, wid = __builtin_amdgcn_readfirstlane(tid >> 6), lane = tid & 63, wr = wid >> 2, wc = wid & 3, fr = lane & 15, fq = lane >> 4;
    const int K = g.K, nt = K / BK;
    unsigned voffA[2];
#pragma unroll
    for (int i = 0; i < 2; ++i) { int R, C; stage_rc(tid * 16 + i * 8192, R, C); voffA[i] = (unsigned)(R * K + C) * 2u; }
    const size_t kstep = (size_t)(BK * 2);
    const size_t hstep = (size_t)HALF * K * 2;
    const size_t tstep = 2 * hstep;
    const unsigned ldsw = (unsigned)wid * 1024u;
    const int aoff = lds_byte(wr * 64 + fr, fq * 8), boff = lds_byte(wc * 32 + fr, fq * 8);
#define PG8_SA(b, h) (((b) * 2 + (h)) * HTB)
#define PG8_SB(b, h) ((4 + (b) * 2 + (h)) * HTB)
#define PG8_STAGE(bufoff, gbase, voff) do { _Pragma("unroll") for (int _i = 0; _i < 2; ++_i) \
        __builtin_amdgcn_global_load_lds((const unsigned*)((const char*)(gbase) + (voff)[_i]), (LAS unsigned*)(lds + (bufoff) + ldsw + _i * 8192), 16, 0, 0); } while (0)
#define PG8_LDA(dst, b, h) do { _Pragma("unroll") for (int m = 0; m < 4; ++m) _Pragma("unroll") for (int k = 0; k < 2; ++k) dst[m][k] = *(const LAS bf16x8*)(lds + PG8_SA(b, h) + aoff + m * 2048 + k * 1024); } while (0)
#define PG8_LDB(dst, b, h) do { _Pragma("unroll") for (int n = 0; n < 2; ++n) _Pragma("unroll") for (int k = 0; k < 2; ++k) dst[n][k] = *(const LAS bf16x8*)(lds + PG8_SB(b, h) + boff + n * 2048 + k * 1024); } while (0)
#define PG8_MMA(ai, bj, At, Bt) do { __builtin_amdgcn_s_setprio(1); _Pragma("unroll") for (int m = 0; m < 4; ++m) _Pragma("unroll") for (int n = 0; n < 2; ++n) _Pragma("unroll") for (int k = 0; k < 2; ++k) \
        acc[ai][bj][m][n] = __builtin_amdgcn_mfma_f32_16x16x32_bf16(Bt[n][k], At[m][k], acc[ai][bj][m][n], 0, 0, 0); __builtin_amdgcn_s_setprio(0); } while (0)
#define PG8_WAIT_V(n) asm volatile("s_waitcnt vmcnt(" #n ")" ::: "memory")
#define PG8_WAIT_L(n) asm volatile("s_waitcnt lgkmcnt(" #n ")" ::: "memory")
#define PG8_BAR __builtin_amdgcn_s_barrier()
#define PG8_SCHED __builtin_amdgcn_sched_barrier(0)
    Unit cur, nxt; int ui = 0;
    if (!S.next(0, cur)) return;
    f32x4 acc[2][2][4][2];
#pragma unroll
    for (int a = 0; a < 2; ++a)
#pragma unroll
        for (int b = 0; b < 2; ++b)
#pragma unroll
            for (int m = 0; m < 4; ++m)
#pragma unroll
                for (int n = 0; n < 2; ++n) acc[a][b][m][n] = (f32x4){0.f, 0.f, 0.f, 0.f};
    bf16x8 At[4][2], B0[2][2], B1[2][2];
    const char* cA = (const char*)g.A + (size_t)cur.pm * tstep; const char* cB = (const char*)g.Bt + (size_t)cur.pn * tstep;
    PG8_STAGE(PG8_SB(0, 0), cB, voffA); PG8_STAGE(PG8_SA(0, 0), cA, voffA); PG8_STAGE(PG8_SB(0, 1), cB + hstep, voffA); PG8_STAGE(PG8_SA(0, 1), cA + hstep, voffA);
    if (wr == 1) PG8_BAR;
    PG8_WAIT_V(4); PG8_BAR;
    PG8_STAGE(PG8_SB(1, 0), cB + kstep, voffA); PG8_STAGE(PG8_SA(1, 0), cA + kstep, voffA); PG8_STAGE(PG8_SB(1, 1), cB + hstep + kstep, voffA);
    PG8_WAIT_V(6); PG8_BAR;
    for (;;) {
        const bool has_next = S.next(ui + 1, nxt);
        const char* nA = has_next ? (const char*)g.A + (size_t)nxt.pm * tstep : cA; const char* nB = has_next ? (const char*)g.Bt + (size_t)nxt.pn * tstep : cB;
        for (int t = 0; t < nt; t += 2) {
            const bool last = (t == nt - 2);
            const char* a1 = cA + (size_t)(t + 1) * kstep;
            const char* a2 = last ? nA : cA + (size_t)(t + 2) * kstep; const char* b2 = last ? nB : cB + (size_t)(t + 2) * kstep;
            const char* a3 = a2 + kstep; const char* b3 = b2 + kstep;
            PG8_LDB(B0, 0, 0); PG8_SCHED; PG8_LDA(At, 0, 0); PG8_STAGE(PG8_SA(1, 1), a1 + hstep, voffA);
            PG8_WAIT_L(8); PG8_BAR; PG8_WAIT_L(0); PG8_MMA(0, 0, At, B0); PG8_BAR; PG8_SCHED;
            PG8_LDB(B1, 0, 1); PG8_STAGE(PG8_SB(0, 0), b2, voffA);
            PG8_BAR; PG8_WAIT_L(0); PG8_MMA(0, 1, At, B1); PG8_BAR;
            PG8_LDA(At, 0, 1); PG8_STAGE(PG8_SA(0, 0), a2, voffA);
            PG8_BAR; PG8_WAIT_L(0); PG8_MMA(1, 0, At, B0); PG8_BAR; PG8_SCHED;
            PG8_STAGE(PG8_SB(0, 1), b2 + hstep, voffA);
            PG8_WAIT_V(6); PG8_BAR; PG8_MMA(1, 1, At, B1); PG8_BAR;
            PG8_LDB(B0, 1, 0); PG8_SCHED; PG8_LDA(At, 1, 0); PG8_STAGE(PG8_SA(0, 1), a2 + hstep, voffA);
            PG8_WAIT_L(8); PG8_BAR; PG8_WAIT_L(0); PG8_MMA(0, 0, At, B0); PG8_BAR; PG8_SCHED;
            PG8_LDB(B1, 1, 1); PG8_STAGE(PG8_SB(1, 0), b3, voffA);
            PG8_BAR; PG8_WAIT_L(0); PG8_MMA(0, 1, At, B1); PG8_BAR;
            PG8_LDA(At, 1, 1); PG8_STAGE(PG8_SA(1, 0), a3, voffA);
            PG8_BAR; PG8_WAIT_L(0); PG8_MMA(1, 0, At, B0); PG8_BAR; PG8_SCHED;
            PG8_STAGE(PG8_SB(1, 1), b3 + hstep, voffA);
            PG8_WAIT_V(6); PG8_BAR; PG8_MMA(1, 1, At, B1); PG8_BAR;
        }
        E(acc, cur, wr, wc, fr, fq);
        if (!has_next) break;
#pragma unroll
        for (int a = 0; a < 2; ++a)
#pragma unroll
            for (int b = 0; b < 2; ++b)
#pragma unroll
                for (int m = 0; m < 4; ++m)
#pragma unroll
                    for (int n = 0; n < 2; ++n) acc[a][b][m][n] = (f32x4){0.f, 0.f, 0.f, 0.f};
        cur = nxt; cA = nA; cB = nB; ++ui;
    }
    PG8_WAIT_V(0);
    if (wr == 0) PG8_BAR;
    PG8_BAR;
#undef PG8_SA
#undef PG8_SB
#undef PG8_STAGE
#undef PG8_LDA
#undef PG8_LDB
#undef PG8_MMA
#undef PG8_WAIT_V
#undef PG8_WAIT_L
#undef PG8_BAR
#undef PG8_SCHED
}
}
using pg8::Unit;

struct EpiRoute {
    bf16_t *GA, *GB, *BB, *BC, *BH, *ZS, *XBC; float* DT; const float* dt_bias; int tile0;
    __device__ __forceinline__ void operator()(const f32x4 (&acc)[2][2][4][2], const Unit& u, int wr, int wc, int fr, int fq) const {
        const int gt = u.pn + tile0; const int row0 = u.pm * 256 + wr * 64 + fr;
        if (gt < 80) {
            bf16_t* base; int ldc, cb, act;
            if (gt < 40) { const int r = gt >> 3; base = (r == 0 ? GA : r == 1 ? GB : r == 2 ? BB : r == 3 ? BC : BH); ldc = DM; cb = (gt & 7) * 256; act = r < 2 ? 1 : 0; }
            else if (gt < 56) { base = ZS; ldc = DI; cb = (gt - 40) * 256; act = 2; }
            else { base = XBC; ldc = CONVD; cb = (gt - 56) * 256; act = 0; }
            const int col0 = cb + wc * 32 + 8 * fq;
#pragma unroll
            for (int ai = 0; ai < 2; ++ai)
#pragma unroll
                for (int m = 0; m < 4; ++m) { bf16_t* rowp = base + (size_t)(row0 + ai * 128 + m * 16) * ldc + col0;
#pragma unroll
                    for (int bj = 0; bj < 2; ++bj) { f32x4 v0 = acc[ai][bj][m][0], v1 = acc[ai][bj][m][1];
                        if (act == 1) {
#pragma unroll
                            for (int j = 0; j < 4; ++j) { v0[j] = sigmoidf_(v0[j]); v1[j] = sigmoidf_(v1[j]); } }
                        else if (act == 2) {
#pragma unroll
                            for (int j = 0; j < 4; ++j) { v0[j] = siluf_(v0[j]); v1[j] = siluf_(v1[j]); } }
                        *(u32x4*)(rowp + bj * 128) = pack8(v0, v1); } }
        } else if (wc < 2) {
            const int c0 = wc * 32 + 8 * fq;
            f32x4 b0 = *(const f32x4*)(dt_bias + c0), b1 = *(const f32x4*)(dt_bias + c0 + 4);
#pragma unroll
            for (int ai = 0; ai < 2; ++ai)
#pragma unroll
                for (int m = 0; m < 4; ++m) { float* rowp = DT + (size_t)(row0 + ai * 128 + m * 16) * NH + c0;
                    f32x4 v0 = acc[ai][0][m][0] + b0, v1 = acc[ai][0][m][1] + b1;
#pragma unroll
                    for (int j = 0; j < 4; ++j) { v0[j] = softplusf_(v0[j]); v1[j] = softplusf_(v1[j]); }
                    *(f32x4*)rowp = v0; *(f32x4*)(rowp + 4) = v1; }
        }
    }
};
template <bool ADD> struct EpiGate {
    const bf16_t* GATE; const bf16_t* PREV; bf16_t* O;
    __device__ __forceinline__ void operator()(const f32x4 (&acc)[2][2][4][2], const Unit& u, int wr, int wc, int fr, int fq) const {
        const int row0 = u.pm * 256 + wr * 64 + fr, col0 = u.pn * 256 + wc * 32 + 8 * fq;
        constexpr int MB = ADD ? 2 : 4;
#pragma unroll
        for (int ai = 0; ai < 2; ++ai)
#pragma unroll
            for (int m0 = 0; m0 < 4; m0 += MB) {
                u32x4 gv[MB][2], pv[MB][2];
#pragma unroll
                for (int mm = 0; mm < MB; ++mm)
#pragma unroll
                    for (int bj = 0; bj < 2; ++bj) { const size_t idx = (size_t)(row0 + ai * 128 + (m0 + mm) * 16) * DM + col0 + bj * 128; gv[mm][bj] = *(const u32x4*)(GATE + idx); if (ADD) pv[mm][bj] = *(const u32x4*)(PREV + idx); }
#pragma unroll
                for (int mm = 0; mm < MB; ++mm)
#pragma unroll
                    for (int bj = 0; bj < 2; ++bj) { const size_t idx = (size_t)(row0 + ai * 128 + (m0 + mm) * 16) * DM + col0 + bj * 128;
                        f32x4 g0, g1; unpack8(gv[mm][bj], g0, g1);
                        f32x4 v0 = g0 * acc[ai][bj][m0 + mm][0], v1 = g1 * acc[ai][bj][m0 + mm][1];
                        if (ADD) { f32x4 p0, p1; unpack8(pv[mm][bj], p0, p1); v0 += p0; v1 += p1; }
                        *(u32x4*)(O + idx) = pack8(v0, v1); } }
    }
};
template <bool XBF> struct EpiRes {
    const void* X; bf16_t* HBF; float* ssq;
    __device__ __forceinline__ void operator()(const f32x4 (&acc)[2][2][4][2], const Unit& u, int wr, int wc, int fr, int fq) const {
        const int row0 = u.pm * 256 + wr * 64 + fr, col0 = u.pn * 256 + wc * 32 + 8 * fq;
#pragma unroll
        for (int ai = 0; ai < 2; ++ai) {
            f32x4 xv[4][2][2];
#pragma unroll
            for (int m = 0; m < 4; ++m)
#pragma unroll
                for (int bj = 0; bj < 2; ++bj) { const size_t idx = (size_t)(row0 + ai * 128 + m * 16) * DM + col0 + bj * 128;
                    if (XBF) { const u32x4 r = *(const u32x4*)((const bf16_t*)X + idx); unpack8(r, xv[m][bj][0], xv[m][bj][1]); }
                    else { xv[m][bj][0] = *(const f32x4*)((const float*)X + idx); xv[m][bj][1] = *(const f32x4*)((const float*)X + idx + 4); } }
#pragma unroll
            for (int m = 0; m < 4; ++m) { const int row = row0 + ai * 128 + m * 16; const size_t ro = (size_t)row * DM + col0; float s = 0.f;
#pragma unroll
                for (int bj = 0; bj < 2; ++bj) { const size_t idx = ro + bj * 128;
                    const f32x4 h0 = xv[m][bj][0] + acc[ai][bj][m][0], h1 = xv[m][bj][1] + acc[ai][bj][m][1];
                    *(u32x4*)(HBF + idx) = pack8(h0, h1);
#pragma unroll
                    for (int j = 0; j < 4; ++j) s += h0[j] * h0[j] + h1[j] * h1[j]; }
                s += __shfl_xor(s, 16); s += __shfl_xor(s, 32);
                if (fq == 0) atomicAdd(ssq + row, s); } }
    }
};
struct EpiSwiglu {
    const float* ssq; bf16_t* ACT;
    __device__ __forceinline__ void operator()(const f32x4 (&acc)[2][2][4][2], const Unit& u, int wr, int wc, int fr, int fq) const {
        const int row0 = u.pm * 256 + wr * 64 + fr, ch0 = u.pn * 128 + wc * 32 + 8 * fq;
        float rs[2][4];
#pragma unroll
        for (int ai = 0; ai < 2; ++ai)
#pragma unroll
            for (int m = 0; m < 4; ++m) rs[ai][m] = ssq[row0 + ai * 128 + m * 16];
#pragma unroll
        for (int ai = 0; ai < 2; ++ai)
#pragma unroll
            for (int m = 0; m < 4; ++m) rs[ai][m] = rsqrtf(rs[ai][m] * (1.0f / DM) + EPS);
#pragma unroll
        for (int ai = 0; ai < 2; ++ai)
#pragma unroll
            for (int m = 0; m < 4; ++m) { const int row = row0 + ai * 128 + m * 16; const float r = rs[ai][m];
                f32x4 v0, v1;
#pragma unroll
                for (int j = 0; j < 4; ++j) { v0[j] = siluf_(acc[ai][0][m][0][j] * r) * (acc[ai][1][m][0][j] * r); v1[j] = siluf_(acc[ai][0][m][1][j] * r) * (acc[ai][1][m][1][j] * r); }
                *(u32x4*)(ACT + (size_t)row * DFF + ch0) = pack8(v0, v1); }
    }
};

__device__ __forceinline__ int slot2lc(int slot) { return (slot & ~31) + pg8::perm32(slot & 31); }
__device__ __forceinline__ void conv_tile(LAS float* tile, const float* src0, const float* src1, int ldsrc, int nvalid, int K, bf16_t* dst, const float* kscale, int mode, int nt, int kt) {
    const int tid = threadIdx.x;
    { const int j = tid & 63, i0 = tid >> 6; const int nrow = nt * 64 + j, t256 = nrow >> 8, lc = slot2lc(nrow & 255);
      const float* s; int col; bool valid;
      if (mode == 0) { col = t256 * 256 + lc; s = src0; valid = col < nvalid; } else { col = t256 * 128 + (lc & 127); s = (lc >> 7) ? src1 : src0; valid = true; }
      if (!valid) col = 0;
      const float* sp = s + (size_t)(kt * 256 + i0) * ldsrc + col;
      float v[32];
#pragma unroll
      for (int ii = 0; ii < 32; ++ii) v[ii] = sp[(size_t)(8 * ii) * ldsrc];
#pragma unroll
      for (int ii = 0; ii < 32; ++ii) { const int kl = i0 + 8 * ii; float x = valid ? v[ii] : 0.f; if (kscale) x *= kscale[kt * 256 + kl]; tile[j * 257 + kl] = x; } }
    __syncthreads();
    { const int kk = (tid & 127) * 2, j0 = tid >> 7;
#pragma unroll
      for (int it = 0; it < 16; ++it) { const int j = j0 + 4 * it; *(unsigned*)(dst + (size_t)(nt * 64 + j) * K + kt * 256 + kk) = pk2(tile[j * 257 + kk], tile[j * 257 + kk + 1]); } }
    __syncthreads();
}

__device__ __forceinline__ void phase_prep(const Params& p, LAS unsigned char* lds) {
    LAS float* tile = (LAS float*)lds; unsigned char* ws = p.ws;
    constexpr int N0 = 324 * 8, N1 = N0 + 32 * 8, N2 = N1 + 32 * 16, N3 = N2 + 32 * 8, N4 = N3 + 176 * 8, N5 = N4 + 32 * 22;
    for (int it = blockIdx.x; it < N5; it += gridDim.x) {
        if (it < N0)      { const int i = it;      conv_tile(tile, p.w_in, nullptr, IN_COLS, IN_COLS, DM, (bf16_t*)(ws + OFF_WIN), nullptr, 0, i / 8, i % 8); }
        else if (it < N1) { const int i = it - N0; conv_tile(tile, p.w_out_a, nullptr, DM, DM, DM, (bf16_t*)(ws + OFF_WOA), nullptr, 0, i / 8, i % 8); }
        else if (it < N2) { const int i = it - N1; conv_tile(tile, p.w_out_ssm, nullptr, DM, DM, DI, (bf16_t*)(ws + OFF_WOS), nullptr, 0, i / 16, i % 16); }
        else if (it < N3) { const int i = it - N2; conv_tile(tile, p.w_o, nullptr, DM, DM, DM, (bf16_t*)(ws + OFF_WO), nullptr, 0, i / 8, i % 8); }
        else if (it < N4) { const int i = it - N3; conv_tile(tile, p.w_ffn_gate, p.w_ffn_up, DFF, DFF, DM, (bf16_t*)(ws + OFF_WGU), p.norm_ffn_g, 1, i / 8, i % 8); }
        else              { const int i = it - N4; conv_tile(tile, p.w_ffn_down, nullptr, DM, DM, DFF, (bf16_t*)(ws + OFF_WDN), nullptr, 0, i / 22, i % 22); }
    }
    { float* s1 = (float*)(ws + OFF_SSQ1); for (int i = blockIdx.x * 512 + threadIdx.x; i < 2 * NTOK; i += gridDim.x * 512) s1[i] = 0.f; }
    { const int wave = threadIdx.x >> 6, lane = threadIdx.x & 63; bf16_t* U = (bf16_t*)(ws + OFF_U);
      for (int row = (blockIdx.x * 8 + wave) * 2; row < NTOK; row += gridDim.x * 16) {
          const f32x4* xr = (const f32x4*)(p.x + (size_t)row * DM); f32x4 v[16]; float ss0 = 0.f, ss1 = 0.f;
#pragma unroll
          for (int i = 0; i < 16; ++i) v[i] = xr[lane + 64 * i];
#pragma unroll
          for (int i = 0; i < 8; ++i) { ss0 += v[i][0] * v[i][0] + v[i][1] * v[i][1] + v[i][2] * v[i][2] + v[i][3] * v[i][3]; ss1 += v[8 + i][0] * v[8 + i][0] + v[8 + i][1] * v[8 + i][1] + v[8 + i][2] * v[8 + i][2] + v[8 + i][3] * v[8 + i][3]; }
#pragma unroll
          for (int o = 32; o >= 1; o >>= 1) { ss0 += __shfl_xor(ss0, o); ss1 += __shfl_xor(ss1, o); }
          const float r0 = rsqrtf(ss0 * (1.0f / DM) + EPS), r1 = rsqrtf(ss1 * (1.0f / DM) + EPS);
#pragma unroll
          for (int i = 0; i < 16; ++i) { const float r = i < 8 ? r0 : r1; const f32x4 gg = ((const f32x4*)p.norm_mix_g)[lane + 64 * (i & 7)]; u32x2 w; w.x = pk2(v[i][0] * r * gg[0], v[i][1] * r * gg[1]); w.y = pk2(v[i][2] * r * gg[2], v[i][3] * r * gg[3]);
              *(u32x2*)(U + (size_t)row * DM + (lane + 64 * i) * 4) = w; } } }
}

__device__ __forceinline__ void phase_ssmconv(const Params& p) {
    const bf16_t* XBC = (const bf16_t*)(p.ws + OFF_XBC); bf16_t* XS = (bf16_t*)p.out; bf16_t* BCS = (bf16_t*)(p.ws + OFF_BCS);
    constexpr int TS = 16; const int total = (NTOK / TS) * 768;
    for (int idx = blockIdx.x * 512 + threadIdx.x; idx < total; idx += gridDim.x * 512) {
        const int t0 = (idx / 768) * TS, c = (idx % 768) * 8; const bool first = (t0 & (SEQ - 1)) == 0;
        u32x4 raw[TS + 3];
#pragma unroll
        for (int r = 0; r < TS + 3; ++r) raw[r] = (r < 3 && first) ? (u32x4){0u, 0u, 0u, 0u} : *(const u32x4*)(XBC + (size_t)(t0 - 3 + r) * CONVD + c);
        f32x4 w0[4], w1[4];
#pragma unroll
        for (int j = 0; j < 4; ++j) { w0[j] = *(const f32x4*)(p.ssm_conv_w + j * CONVD + c); w1[j] = *(const f32x4*)(p.ssm_conv_w + j * CONVD + c + 4); }
        const f32x4 b0 = *(const f32x4*)(p.ssm_conv_b + c), b1 = *(const f32x4*)(p.ssm_conv_b + c + 4);
        bf16_t* dst = (c < DI) ? XS + (size_t)t0 * DI + c : BCS + (size_t)t0 * 2048 + (c - DI); const int ldd = (c < DI) ? DI : 2048;
#pragma unroll
        for (int i = 0; i < TS; ++i) { f32x4 a0 = b0, a1 = b1;
#pragma unroll
            for (int j = 0; j < 4; ++j) { f32x4 r0, r1; unpack8(raw[i + j], r0, r1); a0 += w0[j] * r0; a1 += w1[j] * r1; }
#pragma unroll
            for (int j = 0; j < 4; ++j) { a0[j] = siluf_(a0[j]); a1[j] = siluf_(a1[j]); }
            *(u32x4*)(dst + (size_t)i * ldd) = pack8(a0, a1); }
    }
}

__device__ __forceinline__ void phase_ssd_seq(const Params& p, LAS unsigned char* lds) {
    LAS float* part = (LAS float*)lds;
    const int tid = threadIdx.x, pp = tid >> 3, ng = tid & 7, wave = tid >> 6, lane = tid & 63;
    const bf16_t* XS = (const bf16_t*)p.out; const bf16_t* BCS = (const bf16_t*)(p.ws + OFF_BCS); bf16_t* ZS = (bf16_t*)(p.ws + OFF_ZS);
    const float* DT = (const float*)(p.ws + OFF_DT); float* SSQH = (float*)(p.ws + OFF_SSQH);
    for (int item = blockIdx.x; item < 256; item += gridDim.x) {
        const int b = item >> 6, h = item & 63, g = h >> 3;
        const float a = -__expf(p.a_log[h]), Dk = p.d_skip[h];
        const bf16_t* xs = XS + (size_t)b * SEQ * DI + h * 64 + pp;
        const bf16_t* Bs = BCS + (size_t)b * SEQ * 2048 + g * 128 + ng * 16;
        const bf16_t* Cs = Bs + 1024;
        bf16_t* zs = ZS + (size_t)b * SEQ * DI + h * 64 + pp;
        const float* dt = DT + (size_t)b * SEQ * NH + h;
        float st[16];
#pragma unroll
        for (int i = 0; i < 16; ++i) st[i] = 0.f;
        for (int t0 = 0; t0 < SEQ; t0 += 64) {
#pragma unroll 4
            for (int tt = 0; tt < 64; ++tt) {
                const int t = t0 + tt;
                const float dtv = dt[(size_t)t * NH], xv = bf2f(xs[(size_t)t * DI]), zv = bf2f(zs[(size_t)t * DI]);
                f32x4 B0, B1, B2, B3, C0, C1, C2, C3;
                unpack8(*(const u32x4*)(Bs + (size_t)t * 2048), B0, B1); unpack8(*(const u32x4*)(Bs + (size_t)t * 2048 + 8), B2, B3);
                unpack8(*(const u32x4*)(Cs + (size_t)t * 2048), C0, C1); unpack8(*(const u32x4*)(Cs + (size_t)t * 2048 + 8), C2, C3);
                const float dA = __expf(dtv * a), xdt = xv * dtv; float y = 0.f;
#pragma unroll
                for (int i = 0; i < 4; ++i) {
                    st[i] = dA * st[i] + xdt * B0[i]; y += C0[i] * st[i];
                    st[4 + i] = dA * st[4 + i] + xdt * B1[i]; y += C1[i] * st[4 + i];
                    st[8 + i] = dA * st[8 + i] + xdt * B2[i]; y += C2[i] * st[8 + i];
                    st[12 + i] = dA * st[12 + i] + xdt * B3[i]; y += C3[i] * st[12 + i]; }
                y += __shfl_xor(y, 1); y += __shfl_xor(y, 2); y += __shfl_xor(y, 4);
                y += Dk * xv;
                const float yz = y * zv;
                if (ng == 0) zs[(size_t)t * DI] = (bf16_t)f2bf(yz);
                float sq = (ng == 0) ? yz * yz : 0.f;
                sq += __shfl_xor(sq, 8); sq += __shfl_xor(sq, 16); sq += __shfl_xor(sq, 32);
                if (lane == 0) part[tt * 8 + wave] = sq;
            }
            __syncthreads();
            if (tid < 64) { float s = 0.f;
#pragma unroll
                for (int w = 0; w < 8; ++w) s += part[tid * 8 + w];
                SSQH[(size_t)(b * SEQ + t0 + tid) * NH + h] = s; }
            __syncthreads();
        }
    }
}

typedef short s16x4 __attribute__((ext_vector_type(4)));
constexpr int SS_RSB = 272, SS_RSX = 144;
constexpr int SS_C = 0, SS_B = 34816, SS_X = 69632, SS_XW = 88064, SS_S = 106496, SS_SC = 123904, SS_M = 125952, SS_END = 160768;
__device__ __forceinline__ bf16x8 tr_frag(LAS unsigned char* lds, int addr, int step) {
    const s16x4 lo = __builtin_amdgcn_ds_read_tr16_b64_v4i16((LAS s16x4*)(lds + addr));
    const s16x4 hi = __builtin_amdgcn_ds_read_tr16_b64_v4i16((LAS s16x4*)(lds + addr + step));
    return __builtin_shufflevector(lo, hi, 0, 1, 2, 3, 4, 5, 6, 7);
}
#define MFMA16(a, b, c) __builtin_amdgcn_mfma_f32_16x16x32_bf16(a, b, c, 0, 0, 0)
#define WG_BAR() do { asm volatile("s_waitcnt lgkmcnt(0)" ::: "memory"); __builtin_amdgcn_s_barrier(); asm volatile("" ::: "memory"); } while (0)
__device__ __forceinline__ void phase_ssd_chunk(const Params& p, LAS unsigned char* lds) {
    const int tid = threadIdx.x, w = __builtin_amdgcn_readfirstlane(tid >> 6), lane = tid & 63, fr = lane & 15, g4 = lane >> 4, q = fr >> 2, pq = fr & 3;
    const bf16_t* XS = (const bf16_t*)p.out; const bf16_t* BCS = (const bf16_t*)(p.ws + OFF_BCS); bf16_t* ZS = (bf16_t*)(p.ws + OFF_ZS);
    const float* DT = (const float*)(p.ws + OFF_DT); float* SSQH = (float*)(p.ws + OFF_SSQH);
    LAS float* scal = (LAS float*)(lds + SS_SC);
    const int l = 16 * w + fr;
    for (int item = blockIdx.x; item < 256; item += gridDim.x) {
        const int b = item >> 6, grp = item & 7, h = grp * 8 + ((item >> 3) & 7);
        const float a = -__expf(p.a_log[h]), Dk = p.d_skip[h];
        f32x4 accS[4];
#pragma unroll
        for (int i = 0; i < 4; ++i) accS[i] = (f32x4){0.f, 0.f, 0.f, 0.f};
        u32x4 pb[4], pc[4], px[2]; float d0 = 0.f, d1 = 0.f;
        const bf16_t* bsrc = BCS + (size_t)(b * SEQ + (tid >> 4)) * 2048 + grp * 128 + (tid & 15) * 8;
        const bf16_t* xsrc = XS + (size_t)(b * SEQ + (tid >> 3)) * DI + h * 64 + (tid & 7) * 8;
        const float* dsrc = DT + (size_t)(b * SEQ + lane) * NH + h;
#define SSD_PREFETCH(c_) do { const size_t ro_ = (size_t)(c_) * 128; \
            _Pragma("unroll") for (int i = 0; i < 4; ++i) { pb[i] = *(const u32x4*)(bsrc + (ro_ + 32 * i) * 2048); pc[i] = *(const u32x4*)(bsrc + (ro_ + 32 * i) * 2048 + 1024); } \
            _Pragma("unroll") for (int i = 0; i < 2; ++i) px[i] = *(const u32x4*)(xsrc + (ro_ + 64 * i) * DI); \
            if (w == 0) { d0 = dsrc[ro_ * NH]; d1 = dsrc[(ro_ + 64) * NH]; } } while (0)
#define SSD_SCAN(buf_) do { if (w == 0) { float s0 = d0 * a, s1 = d1 * a; \
            _Pragma("unroll") for (int o = 1; o < 64; o <<= 1) { const float t0 = __shfl_up(s0, o), t1 = __shfl_up(s1, o); if (lane >= o) { s0 += t0; s1 += t1; } } \
            s1 += __shfl(s0, 63); LAS float* cs_ = scal + (buf_) * 256; cs_[lane] = s0; cs_[64 + lane] = s1; cs_[128 + lane] = d0; cs_[192 + lane] = d1; } } while (0)
        SSD_PREFETCH(0);
        for (int i = tid; i < 64 * SS_RSB / 16; i += 512) *(LAS u32x4*)(lds + SS_S + i * 16) = (u32x4){0u, 0u, 0u, 0u};
        SSD_SCAN(0);
        WG_BAR();
        for (int c = 0; c < 32; ++c) {
            const int tok0 = b * SEQ + c * 128;
            LAS float* csA = scal + (c & 1) * 256; LAS float* dtA = csA + 128;
            const float csend = csA[127];
#pragma unroll
            for (int i = 0; i < 4; ++i) { const int row = (tid >> 4) + 32 * i, ch = tid & 15; *(LAS u32x4*)(lds + SS_B + row * SS_RSB + ch * 16) = pb[i]; *(LAS u32x4*)(lds + SS_C + row * SS_RSB + ch * 16) = pc[i]; }
#pragma unroll
            for (int i = 0; i < 2; ++i) { const int row = (tid >> 3) + 64 * i, ch = tid & 7; *(LAS u32x4*)(lds + SS_X + row * SS_RSX + ch * 16) = px[i];
                const float wl = __expf(csend - csA[row]) * dtA[row]; f32x4 v0, v1; unpack8(px[i], v0, v1); v0 *= wl; v1 *= wl; *(LAS u32x4*)(lds + SS_XW + row * SS_RSX + ch * 16) = pack8(v0, v1); }
            WG_BAR();
            if (c + 1 < 32) SSD_PREFETCH(c + 1);
            const size_t tok = (size_t)(tok0 + l);
            bf16_t* zp = ZS + tok * DI + h * 64 + 4 * g4;
            u32x2 z2[4];
#pragma unroll
            for (int pt = 0; pt < 4; ++pt) z2[pt] = *(const u32x2*)(zp + 16 * pt);
            const float csl = csA[l];
            bf16x8 cf[4];
#pragma unroll
            for (int ks = 0; ks < 4; ++ks) cf[ks] = *(const LAS bf16x8*)(lds + SS_C + l * SS_RSB + (4 * ks + g4) * 16);
            f32x4 accY[4];
            { bf16x8 sf[4][4];
#pragma unroll
              for (int pt = 0; pt < 4; ++pt)
#pragma unroll
                  for (int ks = 0; ks < 4; ++ks) sf[pt][ks] = *(const LAS bf16x8*)(lds + SS_S + (16 * pt + fr) * SS_RSB + (4 * ks + g4) * 16);
#pragma unroll
              for (int pt = 0; pt < 4; ++pt) accY[pt] = (f32x4){0.f, 0.f, 0.f, 0.f};
#pragma unroll
              for (int ks = 0; ks < 4; ++ks)
#pragma unroll
                  for (int pt = 0; pt < 4; ++pt) accY[pt] = MFMA16(sf[pt][ks], cf[ks], accY[pt]);
              const float el = __expf(csl);
#pragma unroll
              for (int pt = 0; pt < 4; ++pt) accY[pt] *= el; }
#pragma unroll
            for (int sp = 0; sp < 4; ++sp) {
                if (2 * sp <= w) {
                    bf16x8 bfr[2][4];
#pragma unroll
                    for (int e = 0; e < 2; ++e)
#pragma unroll
                        for (int ks = 0; ks < 4; ++ks) bfr[e][ks] = *(const LAS bf16x8*)(lds + SS_B + (16 * (2 * sp + e) + fr) * SS_RSB + (4 * ks + g4) * 16);
                    f32x4 cs4[2], dt4[2];
#pragma unroll
                    for (int e = 0; e < 2; ++e) { cs4[e] = *(const LAS f32x4*)(csA + 16 * (2 * sp + e) + 4 * g4); dt4[e] = *(const LAS f32x4*)(dtA + 16 * (2 * sp + e) + 4 * g4); }
                    f32x4 a1[2] = {(f32x4){0.f, 0.f, 0.f, 0.f}, (f32x4){0.f, 0.f, 0.f, 0.f}};
#pragma unroll
                    for (int ks = 0; ks < 4; ++ks)
#pragma unroll
                        for (int e = 0; e < 2; ++e) a1[e] = MFMA16(bfr[e][ks], cf[ks], a1[e]);
#pragma unroll
                    for (int e = 0; e < 2; ++e) { float v[4];
#pragma unroll
                        for (int r = 0; r < 4; ++r) { const int s = 16 * (2 * sp + e) + 4 * g4 + r; const float t = a1[e][r] * __expf(fminf(csl - cs4[e][r], 0.f)) * dt4[e][r]; v[r] = (s <= l) ? t : 0.f; }
                        u32x2 pk; pk.x = pk2(v[0], v[1]); pk.y = pk2(v[2], v[3]); *(LAS u32x2*)(lds + SS_M + l * SS_RSB + (16 * (2 * sp + e) + 4 * g4) * 2) = pk; } } }
            { const float dec = __expf(csend);
#pragma unroll
              for (int pt = 0; pt < 4; ++pt) accS[pt] *= dec;
#pragma unroll
              for (int kp = 0; kp < 2; ++kp) { bf16x8 btf[2], xwf[2][4];
#pragma unroll
                  for (int e = 0; e < 2; ++e) { const int ks = 2 * kp + e; btf[e] = tr_frag(lds, SS_B + (32 * ks + 8 * g4 + q) * SS_RSB + (16 * w + 4 * pq) * 2, 4 * SS_RSB);
#pragma unroll
                      for (int pt = 0; pt < 4; ++pt) xwf[e][pt] = tr_frag(lds, SS_XW + (32 * ks + 8 * g4 + q) * SS_RSX + (16 * pt + 4 * pq) * 2, 4 * SS_RSX); }
#pragma unroll
                  for (int e = 0; e < 2; ++e)
#pragma unroll
                      for (int pt = 0; pt < 4; ++pt) accS[pt] = MFMA16(btf[e], xwf[e][pt], accS[pt]); } }
            if (c + 1 < 32) SSD_SCAN((c + 1) & 1);
#pragma unroll
            for (int ks = 0; ks < 4; ++ks) { if (2 * ks <= w) { const bf16x8 mf = *(const LAS bf16x8*)(lds + SS_M + l * SS_RSB + (4 * ks + g4) * 16); bf16x8 xf[4];
#pragma unroll
                for (int pt = 0; pt < 4; ++pt) xf[pt] = tr_frag(lds, SS_X + (32 * ks + 8 * g4 + q) * SS_RSX + (16 * pt + 4 * pq) * 2, 4 * SS_RSX);
#pragma unroll
                for (int pt = 0; pt < 4; ++pt) accY[pt] = MFMA16(xf[pt], mf, accY[pt]); } }
            { float sq = 0.f;
#pragma unroll
              for (int pt = 0; pt < 4; ++pt) { const u32x2 x2 = *(const LAS u32x2*)(lds + SS_X + l * SS_RSX + (16 * pt + 4 * g4) * 2);
                  const float y0 = (accY[pt][0] + Dk * bflo(x2.x)) * bflo(z2[pt].x), y1 = (accY[pt][1] + Dk * bfhi(x2.x)) * bfhi(z2[pt].x), y2 = (accY[pt][2] + Dk * bflo(x2.y)) * bflo(z2[pt].y), y3 = (accY[pt][3] + Dk * bfhi(x2.y)) * bfhi(z2[pt].y);
                  sq += y0 * y0 + y1 * y1 + y2 * y2 + y3 * y3; u32x2 o; o.x = pk2(y0, y1); o.y = pk2(y2, y3); *(u32x2*)(zp + 16 * pt) = o; }
              sq += __shfl_xor(sq, 16); sq += __shfl_xor(sq, 32);
              if (g4 == 0) SSQH[tok * NH + h] = sq; }
            WG_BAR();
#pragma unroll
            for (int pt = 0; pt < 4; ++pt) { u32x2 pk; pk.x = pk2(accS[pt][0], accS[pt][1]); pk.y = pk2(accS[pt][2], accS[pt][3]); *(LAS u32x2*)(lds + SS_S + (16 * pt + fr) * SS_RSB + (16 * w + 4 * g4) * 2) = pk; }
        }
        WG_BAR();
#undef SSD_PREFETCH
#undef SSD_SCAN
    }
}

__device__ __forceinline__ void phase_gnorm(const Params& p) {
    bf16_t* ZS = (bf16_t*)(p.ws + OFF_ZS); const float* SSQH = (const float*)(p.ws + OFF_SSQH);
    const int total = NTOK * 512 / 4;
    for (int idx = blockIdx.x * 512 + threadIdx.x; idx < total; idx += gridDim.x * 512) {
        const int t0 = (idx >> 9) * 4, cg8 = idx & 511, c = cg8 * 8, g = cg8 >> 6;
        u32x4 raw[4]; f32x4 s0[4], s1[4];
#pragma unroll
        for (int i = 0; i < 4; ++i) { raw[i] = *(const u32x4*)(ZS + (size_t)(t0 + i) * DI + c); s0[i] = *(const f32x4*)(SSQH + (size_t)(t0 + i) * NH + g * 8); s1[i] = *(const f32x4*)(SSQH + (size_t)(t0 + i) * NH + g * 8 + 4); }
        const f32x4 g0 = *(const f32x4*)(p.ssm_norm_g + c), g1 = *(const f32x4*)(p.ssm_norm_g + c + 4);
#pragma unroll
        for (int i = 0; i < 4; ++i) { const float ss = s0[i][0] + s0[i][1] + s0[i][2] + s0[i][3] + s1[i][0] + s1[i][1] + s1[i][2] + s1[i][3]; const float r = rsqrtf(ss * (1.0f / 512.0f) + EPS);
            f32x4 v0, v1; unpack8(raw[i], v0, v1); v0 = v0 * r * g0; v1 = v1 * r * g1; *(u32x4*)(ZS + (size_t)(t0 + i) * DI + c) = pack8(v0, v1); }
    }
}

__device__ __forceinline__ void phase_mixa(const Params& p) {
    const bf16_t* BB = (const bf16_t*)(p.ws + OFF_BB); const bf16_t* BC = (const bf16_t*)(p.ws + OFF_BC); const bf16_t* BH = (const bf16_t*)(p.ws + OFF_BH); bf16_t* YA = (bf16_t*)(p.ws + OFF_U);
    constexpr int TS = 8; const int total = (NTOK / TS) * 256;
    for (int idx = blockIdx.x * 512 + threadIdx.x; idx < total; idx += gridDim.x * 512) {
        const int t0 = (idx >> 8) * TS, c = (idx & 255) * 8; const bool first = (t0 & (SEQ - 1)) == 0;
        u32x4 rc[TS + 2], rh[TS + 2], rb[TS];
#pragma unroll
        for (int r = 0; r < TS + 2; ++r) { const size_t o = (size_t)(t0 - 2 + r) * DM + c; const bool z = (r < 2 && first); rc[r] = z ? (u32x4){0u, 0u, 0u, 0u} : *(const u32x4*)(BC + o); rh[r] = z ? (u32x4){0u, 0u, 0u, 0u} : *(const u32x4*)(BH + o); }
#pragma unroll
        for (int i = 0; i < TS; ++i) rb[i] = *(const u32x4*)(BB + (size_t)(t0 + i) * DM + c);
        f32x4 w0[3], w1[3];
#pragma unroll
        for (int j = 0; j < 3; ++j) { w0[j] = *(const f32x4*)(p.conv_a_w + j * DM + c); w1[j] = *(const f32x4*)(p.conv_a_w + j * DM + c + 4); }
        f32x4 q0[3], q1[3];
#pragma unroll
        for (int r = 0; r < 2; ++r) { f32x4 c0, c1, h0, h1; unpack8(rc[r], c0, c1); unpack8(rh[r], h0, h1); q0[r] = c0 * h0; q1[r] = c1 * h1; }
#pragma unroll
        for (int i = 0; i < TS; ++i) { { f32x4 c0, c1, h0, h1; unpack8(rc[i + 2], c0, c1); unpack8(rh[i + 2], h0, h1); q0[2] = c0 * h0; q1[2] = c1 * h1; }
            f32x4 a0 = w0[0] * q0[0] + w0[1] * q0[1] + w0[2] * q0[2], a1 = w1[0] * q1[0] + w1[1] * q1[1] + w1[2] * q1[2];
            f32x4 b0, b1; unpack8(rb[i], b0, b1);
            *(u32x4*)(YA + (size_t)(t0 + i) * DM + c) = pack8(a0 * b0, a1 * b1);
            q0[0] = q0[1]; q0[1] = q0[2]; q1[0] = q1[1]; q1[1] = q1[2]; }
    }
}

__device__ __forceinline__ void phase_final(const Params& p) {
    const float* SSQ2 = (const float*)(p.ws + OFF_SSQ2); const bf16_t* H2 = (const bf16_t*)(p.ws + OFF_BB);
    const int total = NTOK * 256 / 4;
    for (int idx = blockIdx.x * 512 + threadIdx.x; idx < total; idx += gridDim.x * 512) {
        const int t0 = (idx >> 8) * 4, c = (idx & 255) * 8;
        u32x4 v[4]; float r[4];
#pragma unroll
        for (int i = 0; i < 4; ++i) { v[i] = *(const u32x4*)(H2 + (size_t)(t0 + i) * DM + c); r[i] = SSQ2[t0 + i]; }
        const f32x4 g0 = *(const f32x4*)(p.norm_final_g + c), g1 = *(const f32x4*)(p.norm_final_g + c + 4);
#pragma unroll
        for (int i = 0; i < 4; ++i) { const float rr = rsqrtf(r[i] * (1.0f / DM) + EPS); f32x4 a0, a1; unpack8(v[i], a0, a1);
            *(f32x4*)(p.out + (size_t)(t0 + i) * DM + c) = a0 * rr * g0; *(f32x4*)(p.out + (size_t)(t0 + i) * DM + c + 4) = a1 * rr * g1; }
    }
}

#define XB_TMO      128
#define XB_XCNT(j)  (256  + 64 * (j))
#define XB_XSUB(j)  (1280 + 64 * (j))
#define XB_XGEN(j)  (2304 + 64 * (j))
#define XB_TOP      3328
#define XB_TOPGEN   3392
#define XCD_BAR_WORDS 3456
#define XB_SPIN_CAP (1u << 18)

__device__ __forceinline__ unsigned xb_ld(unsigned* p)              { return __hip_atomic_load(p, __ATOMIC_RELAXED, __HIP_MEMORY_SCOPE_AGENT); }
__device__ __forceinline__ unsigned xb_add(unsigned* p, unsigned v) { return __hip_atomic_fetch_add(p, v, __ATOMIC_RELAXED, __HIP_MEMORY_SCOPE_AGENT); }
__device__ __forceinline__ unsigned xb_xcc_id() { return (unsigned)__builtin_amdgcn_s_getreg((3 << 11) | 20) & 0xFu; }
#define XB_SPIN(cond, bar) do { unsigned _sp = 0; while (cond) { __builtin_amdgcn_s_sleep(1); \
    if ((++_sp & 255u) == 0u) { if (xb_ld(&(bar)[XB_TMO])) break; if (_sp > XB_SPIN_CAP) { atomicAdd(&(bar)[XB_TMO], 1u); break; } } } } while (0)

struct XcdBarrier {
    unsigned* bar; unsigned x;
    volatile LAS unsigned* st;
};

__device__ __forceinline__ XcdBarrier xcd_barrier_post(unsigned* bar, volatile LAS unsigned* st) {
    XcdBarrier b; b.bar = bar; b.x = xb_xcc_id(); b.st = st;
    if (threadIdx.x == 0) (void)xb_add(&bar[XB_XCNT(b.x)], 1u);
    return b;
}
__device__ __forceinline__ void xcd_barrier_complete(unsigned* bar, unsigned x, unsigned& nloc, unsigned& nx) {
    const unsigned G = gridDim.x * gridDim.y * gridDim.z;
    unsigned sum, cnt, mine, sp = 0u;
    for (;;) {
        sum = 0u; cnt = 0u; mine = 0u;
#pragma unroll
        for (unsigned j = 0; j < 16; ++j) { const unsigned c = xb_ld(&bar[XB_XCNT(j)]); sum += c; cnt += (c > 0u) ? 1u : 0u; mine = (j == x) ? c : mine; }
        if (sum == G) break;
        __builtin_amdgcn_s_sleep(1);
        if ((++sp & 255u) == 0u) { if (xb_ld(&bar[XB_TMO])) break; if (sp > XB_SPIN_CAP) { atomicAdd(&bar[XB_TMO], 1u); break; } }
    }
    nloc = mine > 0u ? mine : 1u; nx = cnt > 0u ? cnt : 1u;
}

__device__ __forceinline__ void xcd_barrier(const XcdBarrier& b) {
    asm volatile("s_waitcnt vmcnt(0)" ::: "memory");
    __syncthreads();
    if (threadIdx.x == 0) {
        unsigned* bar = b.bar;
        __builtin_amdgcn_s_waitcnt(0);
        unsigned nloc = b.st[0], nx = b.st[1];
        if (nloc == 0u) { xcd_barrier_complete(bar, b.x, nloc, nx); b.st[0] = nloc; b.st[1] = nx; }
        const unsigned old = xb_add(&bar[XB_XSUB(b.x)], 1u);
        const unsigned gen = old / nloc;
        if (old + 1u == (gen + 1u) * nloc) {
            __builtin_amdgcn_fence(__ATOMIC_RELEASE, "agent");
            asm volatile("s_waitcnt vmcnt(0)" ::: "memory");
            const unsigned og = xb_add(&bar[XB_TOP], 1u);
            const unsigned tg = og / nx;
            if (og + 1u == (tg + 1u) * nx) xb_add(&bar[XB_TOPGEN], 1u);
            else XB_SPIN(xb_ld(&bar[XB_TOPGEN]) == tg, bar);
            __builtin_amdgcn_fence(__ATOMIC_ACQUIRE, "agent");
            xb_add(&bar[XB_XGEN(b.x)], 1u);
            asm volatile("s_waitcnt vmcnt(0)" ::: "memory");
        } else {
            XB_SPIN(xb_ld(&bar[XB_XGEN(b.x)]) == gen, bar);
            __builtin_amdgcn_fence(__ATOMIC_ACQUIRE, "agent");
            asm volatile("s_waitcnt vmcnt(0)" ::: "memory");
        }
    }
    __syncthreads();
}

constexpr int NPHASE = 11;
template <int PH> __device__ __forceinline__ void run_phase(const Params& p, LAS unsigned char* lds) {
    unsigned char* ws = p.ws;
    pg8::StaticOrder S; pg8::Gemm g;
    if constexpr (PH == 0) { phase_prep(p, lds); }
    else if constexpr (PH == 1) {
        g.A = (const bf16_t*)(ws + OFF_U); g.Bt = (const bf16_t*)(ws + OFF_WIN) + (size_t)40 * 256 * DM; g.M = NTOK; g.N = 41 * 256; g.K = DM; S.init(g.M, g.N, gridDim.x, blockIdx.x);
        EpiRoute E{(bf16_t*)p.out, (bf16_t*)p.out + (size_t)NTOK * DM, (bf16_t*)(ws + OFF_BB), (bf16_t*)(ws + OFF_BC), (bf16_t*)(ws + OFF_BH), (bf16_t*)(ws + OFF_ZS), (bf16_t*)(ws + OFF_XBC), (float*)(ws + OFF_DT), p.dt_bias, 40};
        pg8::gemm_phase(lds, g, S, E); }
    else if constexpr (PH == 2) { phase_ssmconv(p); }
    else if constexpr (PH == 3) { phase_ssd_chunk(p, lds); }
    else if constexpr (PH == 4) {
        g.A = (const bf16_t*)(ws + OFF_U); g.Bt = (const bf16_t*)(ws + OFF_WIN); g.M = NTOK; g.N = 40 * 256; g.K = DM; S.init(g.M, g.N, gridDim.x, blockIdx.x);
        EpiRoute E{(bf16_t*)p.out, (bf16_t*)p.out + (size_t)NTOK * DM, (bf16_t*)(ws + OFF_BB), (bf16_t*)(ws + OFF_BC), (bf16_t*)(ws + OFF_BH), (bf16_t*)(ws + OFF_ZS), (bf16_t*)(ws + OFF_XBC), (float*)(ws + OFF_DT), p.dt_bias, 0};
        pg8::gemm_phase(lds, g, S, E);
        phase_gnorm(p); }
    else if constexpr (PH == 5) { phase_mixa(p); }
    else if constexpr (PH == 6) {
        g.A = (const bf16_t*)(ws + OFF_U); g.Bt = (const bf16_t*)(ws + OFF_WOA); g.M = NTOK; g.N = DM; g.K = DM; S.init(g.M, g.N, gridDim.x, blockIdx.x);
        EpiGate<false> Ea{(const bf16_t*)p.out, nullptr, (bf16_t*)(ws + OFF_BB)};
        pg8::gemm_phase(lds, g, S, Ea);
        g.A = (const bf16_t*)(ws + OFF_ZS); g.Bt = (const bf16_t*)(ws + OFF_WOS); g.K = DI;
        EpiGate<true> Eb{(const bf16_t*)p.out + (size_t)NTOK * DM, (const bf16_t*)(ws + OFF_BB), (bf16_t*)(ws + OFF_BC)};
        pg8::gemm_phase(lds, g, S, Eb); }
    else if constexpr (PH == 7) {
        g.A = (const bf16_t*)(ws + OFF_BC); g.Bt = (const bf16_t*)(ws + OFF_WO); g.M = NTOK; g.N = DM; g.K = DM; S.init(g.M, g.N, gridDim.x, blockIdx.x);
        EpiRes<false> E{p.x, (bf16_t*)(ws + OFF_BH), (float*)(ws + OFF_SSQ1)};
        pg8::gemm_phase(lds, g, S, E); }
    else if constexpr (PH == 8) {
        g.A = (const bf16_t*)(ws + OFF_BH); g.Bt = (const bf16_t*)(ws + OFF_WGU); g.M = NTOK; g.N = 2 * DFF; g.K = DM; S.init(g.M, g.N, gridDim.x, blockIdx.x);
        EpiSwiglu E{(const float*)(ws + OFF_SSQ1), (bf16_t*)(ws + OFF_ZS)};
        pg8::gemm_phase(lds, g, S, E); }
    else if constexpr (PH == 9) {
        g.A = (const bf16_t*)(ws + OFF_ZS); g.Bt = (const bf16_t*)(ws + OFF_WDN); g.M = NTOK; g.N = DM; g.K = DFF; S.init(g.M, g.N, gridDim.x, blockIdx.x);
        EpiRes<true> E{(const void*)(ws + OFF_BH), (bf16_t*)(ws + OFF_BB), (float*)(ws + OFF_SSQ2)};
        pg8::gemm_phase(lds, g, S, E); }
    else if constexpr (PH == 10) { phase_final(p); }
}

template <int PH> __global__ void __launch_bounds__(512, 2) k_one(Params p) {
    extern __shared__ __attribute__((aligned(16))) unsigned char lds_raw[];
    run_phase<PH>(p, (LAS unsigned char*)lds_raw);
}

#ifndef PROBE_MASK
#define PROBE_MASK 0
#endif
__global__ void __launch_bounds__(512, 2) k_mega(Params p) {
    extern __shared__ __attribute__((aligned(16))) unsigned char lds_raw[];
    LAS unsigned char* lds = (LAS unsigned char*)lds_raw;
    cg::grid_group grid = cg::this_grid();
    unsigned long long spin = 0, t0 = 0;
    volatile LAS unsigned* bst = (volatile LAS unsigned*)(lds + SS_END);
    if (threadIdx.x < 4) bst[threadIdx.x] = 0u;
    __syncthreads();
    const XcdBarrier xbar = xcd_barrier_post((unsigned*)(p.ws + OFF_BAR), bst);
#define PH_RUN(i, SYNC) do { if (PROBE_MASK) t0 = __builtin_amdgcn_s_memrealtime(); run_phase<i>(p, lds); if (SYNC == 1) grid.sync(); else if (SYNC == 2) xcd_barrier(xbar); \
        if (PROBE_MASK & (1 << i)) spin += __builtin_amdgcn_s_memrealtime() - t0; } while (0)
    PH_RUN(0, 1); PH_RUN(1, 2); PH_RUN(2, 2); PH_RUN(3, 2); PH_RUN(4, 2); PH_RUN(5, 2); PH_RUN(6, 2); PH_RUN(7, 2); PH_RUN(8, 2); PH_RUN(9, 2); PH_RUN(10, 0);
#ifdef PROBE_SYNCS
    for (int i = 0; i < PROBE_SYNCS; ++i) xcd_barrier(xbar);
#endif
    if (PROBE_MASK && blockIdx.x == 0) { t0 = __builtin_amdgcn_s_memrealtime(); while (__builtin_amdgcn_s_memrealtime() - t0 < spin) __builtin_amdgcn_s_sleep(8); }
}

constexpr int LDS_BYTES = SS_END + 16;

template <int PH> static void launch_one(const Params& p, int grid, hipStream_t stream) {
    static bool attr = false;
    if (!attr) { (void)hipFuncSetAttribute((const void*)k_one<PH>, hipFuncAttributeMaxDynamicSharedMemorySize, LDS_BYTES); attr = true; }
    hipLaunchKernelGGL(k_one<PH>, dim3(grid), dim3(512), LDS_BYTES, stream, p);
}

extern "C" void kernel_launch(void* const* d_in, const int* in_sizes, int n_in, void* d_out, int out_size, void* d_ws, size_t ws_size, hipStream_t stream) {
    static int grid = 0;
    if (grid == 0) {
        if (n_in != 18 || out_size != NTOK * DM || ws_size < WS_END) { fprintf(stderr, "kernel_launch: unexpected shapes: n_in %d out %d ws %zu (need %zu)\n", n_in, out_size, ws_size, (size_t)WS_END); grid = -1; return; }
        int dev = 0, cus = 0, per_cu = 0;
        (void)hipGetDevice(&dev); (void)hipDeviceGetAttribute(&cus, hipDeviceAttributeMultiprocessorCount, dev);
        (void)hipFuncSetAttribute((const void*)k_mega, hipFuncAttributeMaxDynamicSharedMemorySize, LDS_BYTES);
        (void)hipOccupancyMaxActiveBlocksPerMultiprocessor(&per_cu, (const void*)k_mega, 512, LDS_BYTES);
        if (per_cu < 1) { fprintf(stderr, "kernel_launch: occupancy query says %d blocks per CU\n", per_cu); per_cu = 1; }
        (void)hipGetLastError();
        grid = cus * per_cu;
        fprintf(stderr, "kernel_launch: cus %d per_cu %d grid %d ws %zu\n", cus, per_cu, grid, ws_size);
    }
    if (grid < 0) return;
    Params p{};
    const float** pp = (const float**)&p;
    for (int i = 0; i < 18; ++i) pp[i] = (const float*)d_in[i];
    p.out = (float*)d_out; p.ws = (unsigned char*)d_ws;
#if MEGA
    (void)hipMemsetAsync((unsigned char*)d_ws + OFF_BAR, 0, XCD_BAR_WORDS * 4, stream);
    void* args[] = {&p};
    hipError_t e = hipLaunchCooperativeKernel((const void*)k_mega, dim3(grid), dim3(512), args, LDS_BYTES, stream);
    if (e != hipSuccess) fprintf(stderr, "cooperative launch failed: %s (grid %d)\n", hipGetErrorString(e), grid);
#else
    launch_one<0>(p, grid, stream); launch_one<1>(p, grid, stream); launch_one<2>(p, grid, stream); launch_one<3>(p, grid, stream); launch_one<4>(p, grid, stream); launch_one<5>(p, grid, stream);
    launch_one<6>(p, grid, stream); launch_one<7>(p, grid, stream); launch_one<8>(p, grid, stream); launch_one<9>(p, grid, stream); launch_one<10>(p, grid, stream);
#endif
}
```

```cpp
#include <hip/hip_runtime.h>
#include <hip/hip_cooperative_groups.h>
#include <cstdio>
namespace cg = cooperative_groups;

#ifndef MEGA
#define MEGA 1
#endif

#define LAS __attribute__((address_space(3)))
typedef unsigned short bf16_t;
typedef short bf16x8 __attribute__((ext_vector_type(8)));
typedef float f32x4 __attribute__((ext_vector_type(4)));
typedef unsigned u32x4 __attribute__((ext_vector_type(4)));
typedef unsigned u32x2 __attribute__((ext_vector_type(2)));

constexpr int DM = 2048, NTOK = 16384, SEQ = 4096;
constexpr int IN_COLS = 20544, IN_TILES = 81;
constexpr int DI = 4096, NH = 64, HD = 64, NG = 8, NST = 128, CONVD = 6144;
constexpr int DFF = 5632;
constexpr float EPS = 1e-6f;

constexpr size_t MiB = 1024ull * 1024ull;
constexpr size_t OFF_WIN = 0;
constexpr size_t OFF_WOA = 81 * MiB;
constexpr size_t OFF_WOS = 89 * MiB;
constexpr size_t OFF_WO  = 105 * MiB;
constexpr size_t OFF_WGU = 113 * MiB;
constexpr size_t OFF_WDN = 157 * MiB;
constexpr size_t OFF_ZS  = 179 * MiB;
constexpr size_t OFF_U   = 307 * MiB;
constexpr size_t OFF_XBC = 371 * MiB;
constexpr size_t OFF_BB  = 371 * MiB, OFF_BC = 435 * MiB, OFF_BH = 499 * MiB;
constexpr size_t OFF_DT  = 563 * MiB;
constexpr size_t OFF_SSQH = 567 * MiB;
constexpr size_t OFF_SSQ1 = 571 * MiB;
constexpr size_t OFF_SSQ2 = 571 * MiB + 65536;
constexpr size_t OFF_BCS = 572 * MiB;
constexpr size_t OFF_BAR = 636 * MiB;
constexpr size_t WS_END = 637 * MiB;

struct Params {
    const float *x, *norm_mix_g, *w_in, *conv_a_w, *w_out_a, *ssm_conv_w, *ssm_conv_b, *dt_bias, *a_log, *d_skip, *ssm_norm_g, *w_out_ssm, *w_o, *norm_ffn_g, *w_ffn_gate, *w_ffn_up,
        *w_ffn_down, *norm_final_g;
    float* out; unsigned char* ws;
};

__device__ __forceinline__ unsigned f2bf(float f) { unsigned u = __builtin_bit_cast(unsigned, f); return (u + 0x7fffu + ((u >> 16) & 1u)) >> 16; }
__device__ __forceinline__ unsigned pk2(float lo, float hi) { unsigned r; asm("v_cvt_pk_bf16_f32 %0, %1, %2" : "=v"(r) : "v"(lo), "v"(hi)); return r; }
__device__ __forceinline__ float bflo(unsigned w) { return __builtin_bit_cast(float, w << 16); }
__device__ __forceinline__ float bfhi(unsigned w) { return __builtin_bit_cast(float, w & 0xffff0000u); }
__device__ __forceinline__ float bf2f(bf16_t v) { return __builtin_bit_cast(float, ((unsigned)v) << 16); }
__device__ __forceinline__ float sigmoidf_(float v) { return __builtin_amdgcn_rcpf(1.0f + __expf(-v)); }
__device__ __forceinline__ float siluf_(float v) { return v * sigmoidf_(v); }
__device__ __forceinline__ float softplusf_(float v) { return fmaxf(v, 0.f) + log1pf(__expf(-fabsf(v))); }
__device__ __forceinline__ u32x4 pack8(const f32x4& a, const f32x4& b) { u32x4 w; w.x = pk2(a[0], a[1]); w.y = pk2(a[2], a[3]); w.z = pk2(b[0], b[1]); w.w = pk2(b[2], b[3]); return w; }
__device__ __forceinline__ void unpack8(const u32x4& w, f32x4& a, f32x4& b) { a[0] = bflo(w.x); a[1] = bfhi(w.x); a[2] = bflo(w.y); a[3] = bfhi(w.y); b[0] = bflo(w.z); b[1] = bfhi(w.z); b[2] = bflo(w.w); b[3] = bfhi(w.w); }

#ifndef PROBE_KMASK
#define PROBE_KMASK 0
#endif
#ifndef STAGGER_TICKS
#define STAGGER_TICKS 0
#endif
namespace pg8 {
constexpr int BM = 256, BK = 64, HALF = 128, HTB = HALF * BK * 2, STAGE_BYTES = 8 * HTB, NXCD = 8, WGM = 8;
__host__ __device__ __forceinline__ int lds_byte(int r, int c) { const int st = (r >> 4) * 2 + (c >> 5), rr = r & 15, cc = c & 31, ob = rr * 64 + cc * 2; return st * 1024 + (ob ^ (((ob >> 9) & 1) << 5)); }
__host__ __device__ __forceinline__ void stage_rc(int b, int& R, int& C) { const int st = b / 1024, sb = b % 1024, swz = sb ^ (((sb >> 9) & 1) << 5); R = (st >> 1) * 16 + swz / 64; C = (st & 1) * 32 + (swz % 64) / 2; }
__host__ __device__ __forceinline__ int perm32(int rho) { const int n = rho >> 4, i = rho & 15; return 8 * (i >> 2) + 4 * n + (i & 3); }
struct Unit { int pm, pn; };
struct Gemm { const bf16_t* A; const bf16_t* Bt; int M, N, K; };
struct StaticOrder {
    int nM, nN, nwg, G, c;
    __host__ __device__ void init(int M, int N, int G_, int c_) { nM = M / BM; nN = N / BM; nwg = nM * nN; G = G_; c = c_; }
    __host__ __device__ bool next(int i, Unit& u) const {
        const long L = (long)i * G + c; if (L >= nwg) return false;
        int wgid = (int)L; { const int q = nwg / NXCD, r = nwg % NXCD, xcd = wgid % NXCD, off = wgid / NXCD; wgid = (xcd < r ? xcd * (q + 1) : r * (q + 1) + (xcd - r) * q) + off; }
        const int nig = WGM * nN, gid = wgid / nig, fm = gid * WGM, gsz = (nM - fm) < WGM ? (nM - fm) : WGM;
        u.pm = fm + ((wgid % nig) % gsz); u.pn = (wgid % nig) / gsz; return true;
    }
};

template <class Epi>
__device__ __forceinline__ void gemm_phase(LAS unsigned char* lds, const Gemm g, const StaticOrder& S, const Epi& E) {
    const int tid = threadIdx.x, wid = __builtin_amdgcn_readfirstlane(tid >> 6), lane = tid & 63, wr = wid >> 2, wc = wid & 3, fr = lane & 15, fq = lane >> 4;
    const int K = g.K, nt = K / BK;
    unsigned voffA[2];
#pragma unroll
    for (int i = 0; i < 2; ++i) { int R, C; stage_rc(tid * 16 + i * 8192, R, C); voffA[i] = (unsigned)(R * K + C) * 2u; }
    const size_t kstep = (size_t)(BK * 2);
    const size_t hstep = (size_t)HALF * K * 2;
    const size_t tstep = 2 * hstep;
    const unsigned ldsw = (unsigned)wid * 1024u;
    const int aoff = lds_byte(wr * 64 + fr, fq * 8), boff = lds_byte(wc * 32 + fr, fq * 8);
#define PG8_SA(b, h) (((b) * 2 + (h)) * HTB)
#define PG8_SB(b, h) ((4 + (b) * 2 + (h)) * HTB)
#define PG8_STAGE(bufoff, gbase, voff) do { _Pragma("unroll") for (int _i = 0; _i < 2; ++_i) \
        __builtin_amdgcn_global_load_lds((const unsigned*)((const char*)(gbase) + (voff)[_i]), (LAS unsigned*)(lds + (bufoff) + ldsw + _i * 8192), 16, 0, 0); } while (0)
#define PG8_LDA(dst, b, h) do { _Pragma("unroll") for (int m = 0; m < 4; ++m) _Pragma("unroll") for (int k = 0; k < 2; ++k) dst[m][k] = *(const LAS bf16x8*)(lds + PG8_SA(b, h) + aoff + m * 2048 + k * 1024); } while (0)
#define PG8_LDB(dst, b, h) do { _Pragma("unroll") for (int n = 0; n < 2; ++n) _Pragma("unroll") for (int k = 0; k < 2; ++k) dst[n][k] = *(const LAS bf16x8*)(lds + PG8_SB(b, h) + boff + n * 2048 + k * 1024); } while (0)
#define PG8_MMA(ai, bj, At, Bt) do { __builtin_amdgcn_s_setprio(1); _Pragma("unroll") for (int m = 0; m < 4; ++m) _Pragma("unroll") for (int n = 0; n < 2; ++n) _Pragma("unroll") for (int k = 0; k < 2; ++k) \
        acc[ai][bj][m][n] = __builtin_amdgcn_mfma_f32_16x16x32_bf16(Bt[n][k], At[m][k], acc[ai][bj][m][n], 0, 0, 0); __builtin_amdgcn_s_setprio(0); } while (0)
#define PG8_WAIT_V(n) asm volatile("s_waitcnt vmcnt(" #n ")" ::: "memory")
#define PG8_WAIT_L(n) asm volatile("s_waitcnt lgkmcnt(" #n ")" ::: "memory")
#define PG8_BAR __builtin_amdgcn_s_barrier()
#define PG8_SCHED __builtin_amdgcn_sched_barrier(0)
    Unit cur, nxt; int ui = 0;
    if (!S.next(0, cur)) return;
    if (STAGGER_TICKS) { const unsigned long long t0 = __builtin_amdgcn_s_memrealtime(), d = (unsigned long long)(blockIdx.x & 7) * STAGGER_TICKS; while (__builtin_amdgcn_s_memrealtime() - t0 < d) __builtin_amdgcn_s_sleep(4); }
    f32x4 acc[2][2][4][2];
#pragma unroll
    for (int a = 0; a < 2; ++a)
#pragma unroll
        for (int b = 0; b < 2; ++b)
#pragma unroll
            for (int m = 0; m < 4; ++m)
#pragma unroll
                for (int n = 0; n < 2; ++n) acc[a][b][m][n] = (f32x4){0.f, 0.f, 0.f, 0.f};
    bf16x8 At[4][2], B0[2][2], B1[2][2];
    const char* cA = (const char*)g.A + (size_t)cur.pm * tstep; const char* cB = (const char*)g.Bt + (size_t)cur.pn * tstep;
    PG8_STAGE(PG8_SB(0, 0), cB, voffA); PG8_STAGE(PG8_SA(0, 0), cA, voffA); PG8_STAGE(PG8_SB(0, 1), cB + hstep, voffA); PG8_STAGE(PG8_SA(0, 1), cA + hstep, voffA);
    if (wr == 1) PG8_BAR;
    PG8_WAIT_V(4); PG8_BAR;
    PG8_STAGE(PG8_SB(1, 0), cB + kstep, voffA); PG8_STAGE(PG8_SA(1, 0), cA + kstep, voffA); PG8_STAGE(PG8_SB(1, 1), cB + hstep + kstep, voffA);
    PG8_WAIT_V(6); PG8_BAR;
    for (;;) {
        const bool has_next = S.next(ui + 1, nxt);
        const char* nA = has_next ? (const char*)g.A + (size_t)nxt.pm * tstep : cA; const char* nB = has_next ? (const char*)g.Bt + (size_t)nxt.pn * tstep : cB;
        unsigned long long kt0_ = 0; if (PROBE_KMASK) kt0_ = __builtin_amdgcn_s_memrealtime();
        for (int t = 0; t < nt; t += 2) {
            const bool last = (t == nt - 2);
            const char* a1 = cA + (size_t)(t + 1) * kstep;
            const char* a2 = last ? nA : cA + (size_t)(t + 2) * kstep; const char* b2 = last ? nB : cB + (size_t)(t + 2) * kstep;
            const char* a3 = a2 + kstep; const char* b3 = b2 + kstep;
            PG8_LDB(B0, 0, 0); PG8_SCHED; PG8_LDA(At, 0, 0); PG8_STAGE(PG8_SA(1, 1), a1 + hstep, voffA);
            PG8_WAIT_L(8); PG8_BAR; PG8_WAIT_L(0); PG8_MMA(0, 0, At, B0); PG8_BAR; PG8_SCHED;
            PG8_LDB(B1, 0, 1); PG8_STAGE(PG8_SB(0, 0), b2, voffA);
            PG8_BAR; PG8_WAIT_L(0); PG8_MMA(0, 1, At, B1); PG8_BAR;
            PG8_LDA(At, 0, 1); PG8_STAGE(PG8_SA(0, 0), a2, voffA);
            PG8_BAR; PG8_WAIT_L(0); PG8_MMA(1, 0, At, B0); PG8_BAR; PG8_SCHED;
            PG8_STAGE(PG8_SB(0, 1), b2 + hstep, voffA);
            PG8_WAIT_V(6); PG8_BAR; PG8_MMA(1, 1, At, B1); PG8_BAR;
            PG8_LDB(B0, 1, 0); PG8_SCHED; PG8_LDA(At, 1, 0); PG8_STAGE(PG8_SA(0, 1), a2 + hstep, voffA);
            PG8_WAIT_L(8); PG8_BAR; PG8_WAIT_L(0); PG8_MMA(0, 0, At, B0); PG8_BAR; PG8_SCHED;
            PG8_LDB(B1, 1, 1); PG8_STAGE(PG8_SB(1, 0), b3, voffA);
            PG8_BAR; PG8_WAIT_L(0); PG8_MMA(0, 1, At, B1); PG8_BAR;
            PG8_LDA(At, 1, 1); PG8_STAGE(PG8_SA(1, 0), a3, voffA);
            PG8_BAR; PG8_WAIT_L(0); PG8_MMA(1, 0, At, B0); PG8_BAR; PG8_SCHED;
            PG8_STAGE(PG8_SB(1, 1), b3 + hstep, voffA);
            PG8_WAIT_V(6); PG8_BAR; PG8_MMA(1, 1, At, B1); PG8_BAR;
        }
        if (PROBE_KMASK && tid == 0) *(LAS unsigned long long*)(lds + 160768 + 8) += __builtin_amdgcn_s_memrealtime() - kt0_;
        E(acc, cur, wr, wc, fr, fq);
        if (!has_next) break;
#pragma unroll
        for (int a = 0; a < 2; ++a)
#pragma unroll
            for (int b = 0; b < 2; ++b)
#pragma unroll
                for (int m = 0; m < 4; ++m)
#pragma unroll
                    for (int n = 0; n < 2; ++n) acc[a][b][m][n] = (f32x4){0.f, 0.f, 0.f, 0.f};
        cur = nxt; cA = nA; cB = nB; ++ui;
    }
    PG8_WAIT_V(0);
    if (wr == 0) PG8_BAR;
    PG8_BAR;
#undef PG8_SA
#undef PG8_SB
#undef PG8_STAGE
#undef PG8_LDA
#undef PG8_LDB
#undef PG8_MMA
#undef PG8_WAIT_V
#undef PG8_WAIT_L
#undef PG8_BAR
#undef PG8_SCHED
}
}
using pg8::Unit;

struct EpiRoute {
    bf16_t *GA, *GB, *BB, *BC, *BH, *ZS, *XBC; float* DT; const float* dt_bias; int tile0;
    __device__ __forceinline__ void operator()(const f32x4 (&acc)[2][2][4][2], const Unit& u, int wr, int wc, int fr, int fq) const {
        const int gt = u.pn + tile0; const int row0 = u.pm * 256 + wr * 64 + fr;
        if (gt < 80) {
            bf16_t* base; int ldc, cb, act;
            if (gt < 40) { const int r = gt >> 3; base = (r == 0 ? GA : r == 1 ? GB : r == 2 ? BB : r == 3 ? BC : BH); ldc = DM; cb = (gt & 7) * 256; act = r < 2 ? 1 : 0; }
            else if (gt < 56) { base = ZS; ldc = DI; cb = (gt - 40) * 256; act = 2; }
            else { base = XBC; ldc = CONVD; cb = (gt - 56) * 256; act = 0; }
            const int col0 = cb + wc * 32 + 8 * fq;
#pragma unroll
            for (int ai = 0; ai < 2; ++ai)
#pragma unroll
                for (int m = 0; m < 4; ++m) { bf16_t* rowp = base + (size_t)(row0 + ai * 128 + m * 16) * ldc + col0;
#pragma unroll
                    for (int bj = 0; bj < 2; ++bj) { f32x4 v0 = acc[ai][bj][m][0], v1 = acc[ai][bj][m][1];
                        if (act == 1) {
#pragma unroll
                            for (int j = 0; j < 4; ++j) { v0[j] = sigmoidf_(v0[j]); v1[j] = sigmoidf_(v1[j]); } }
                        else if (act == 2) {
#pragma unroll
                            for (int j = 0; j < 4; ++j) { v0[j] = siluf_(v0[j]); v1[j] = siluf_(v1[j]); } }
                        *(u32x4*)(rowp + bj * 128) = pack8(v0, v1); } }
        } else if (wc < 2) {
            const int c0 = wc * 32 + 8 * fq;
            f32x4 b0 = *(const f32x4*)(dt_bias + c0), b1 = *(const f32x4*)(dt_bias + c0 + 4);
#pragma unroll
            for (int ai = 0; ai < 2; ++ai)
#pragma unroll
                for (int m = 0; m < 4; ++m) { float* rowp = DT + (size_t)(row0 + ai * 128 + m * 16) * NH + c0;
                    f32x4 v0 = acc[ai][0][m][0] + b0, v1 = acc[ai][0][m][1] + b1;
#pragma unroll
                    for (int j = 0; j < 4; ++j) { v0[j] = softplusf_(v0[j]); v1[j] = softplusf_(v1[j]); }
                    *(f32x4*)rowp = v0; *(f32x4*)(rowp + 4) = v1; }
        }
    }
};
template <bool ADD> struct EpiGate {
    const bf16_t* GATE; const bf16_t* PREV; bf16_t* O;
    __device__ __forceinline__ void operator()(const f32x4 (&acc)[2][2][4][2], const Unit& u, int wr, int wc, int fr, int fq) const {
        const int row0 = u.pm * 256 + wr * 64 + fr, col0 = u.pn * 256 + wc * 32 + 8 * fq;
        constexpr int MB = ADD ? 2 : 4;
#pragma unroll
        for (int ai = 0; ai < 2; ++ai)
#pragma unroll
            for (int m0 = 0; m0 < 4; m0 += MB) {
                u32x4 gv[MB][2], pv[MB][2];
#pragma unroll
                for (int mm = 0; mm < MB; ++mm)
#pragma unroll
                    for (int bj = 0; bj < 2; ++bj) { const size_t idx = (size_t)(row0 + ai * 128 + (m0 + mm) * 16) * DM + col0 + bj * 128; gv[mm][bj] = *(const u32x4*)(GATE + idx); if (ADD) pv[mm][bj] = *(const u32x4*)(PREV + idx); }
#pragma unroll
                for (int mm = 0; mm < MB; ++mm)
#pragma unroll
                    for (int bj = 0; bj < 2; ++bj) { const size_t idx = (size_t)(row0 + ai * 128 + (m0 + mm) * 16) * DM + col0 + bj * 128;
                        f32x4 g0, g1; unpack8(gv[mm][bj], g0, g1);
                        f32x4 v0 = g0 * acc[ai][bj][m0 + mm][0], v1 = g1 * acc[ai][bj][m0 + mm][1];
                        if (ADD) { f32x4 p0, p1; unpack8(pv[mm][bj], p0, p1); v0 += p0; v1 += p1; }
                        *(u32x4*)(O + idx) = pack8(v0, v1); } }
    }
};
template <bool XBF> struct EpiRes {
    const void* X; bf16_t* HBF; float* ssq;
    __device__ __forceinline__ void operator()(const f32x4 (&acc)[2][2][4][2], const Unit& u, int wr, int wc, int fr, int fq) const {
        const int row0 = u.pm * 256 + wr * 64 + fr, col0 = u.pn * 256 + wc * 32 + 8 * fq;
#pragma unroll
        for (int ai = 0; ai < 2; ++ai) {
            f32x4 xv[4][2][2];
#pragma unroll
            for (int m = 0; m < 4; ++m)
#pragma unroll
                for (int bj = 0; bj < 2; ++bj) { const size_t idx = (size_t)(row0 + ai * 128 + m * 16) * DM + col0 + bj * 128;
                    if (XBF) { const u32x4 r = *(const u32x4*)((const bf16_t*)X + idx); unpack8(r, xv[m][bj][0], xv[m][bj][1]); }
                    else { xv[m][bj][0] = *(const f32x4*)((const float*)X + idx); xv[m][bj][1] = *(const f32x4*)((const float*)X + idx + 4); } }
#pragma unroll
            for (int m = 0; m < 4; ++m) { const int row = row0 + ai * 128 + m * 16; const size_t ro = (size_t)row * DM + col0; float s = 0.f;
#pragma unroll
                for (int bj = 0; bj < 2; ++bj) { const size_t idx = ro + bj * 128;
                    const f32x4 h0 = xv[m][bj][0] + acc[ai][bj][m][0], h1 = xv[m][bj][1] + acc[ai][bj][m][1];
                    *(u32x4*)(HBF + idx) = pack8(h0, h1);
#pragma unroll
                    for (int j = 0; j < 4; ++j) s += h0[j] * h0[j] + h1[j] * h1[j]; }
                s += __shfl_xor(s, 16); s += __shfl_xor(s, 32);
                if (fq == 0) atomicAdd(ssq + row, s); } }
    }
};
struct EpiSwiglu {
    const float* ssq; bf16_t* ACT;
    __device__ __forceinline__ void operator()(const f32x4 (&acc)[2][2][4][2], const Unit& u, int wr, int wc, int fr, int fq) const {
        const int row0 = u.pm * 256 + wr * 64 + fr, ch0 = u.pn * 128 + wc * 32 + 8 * fq;
        float rs[2][4];
#pragma unroll
        for (int ai = 0; ai < 2; ++ai)
#pragma unroll
            for (int m = 0; m < 4; ++m) rs[ai][m] = ssq[row0 + ai * 128 + m * 16];
#pragma unroll
        for (int ai = 0; ai < 2; ++ai)
#pragma unroll
            for (int m = 0; m < 4; ++m) rs[ai][m] = rsqrtf(rs[ai][m] * (1.0f / DM) + EPS);
#pragma unroll
        for (int ai = 0; ai < 2; ++ai)
#pragma unroll
            for (int m = 0; m < 4; ++m) { const int row = row0 + ai * 128 + m * 16; const float r = rs[ai][m];
                f32x4 v0, v1;
#pragma unroll
                for (int j = 0; j < 4; ++j) { v0[j] = siluf_(acc[ai][0][m][0][j] * r) * (acc[ai][1][m][0][j] * r); v1[j] = siluf_(acc[ai][0][m][1][j] * r) * (acc[ai][1][m][1][j] * r); }
                *(u32x4*)(ACT + (size_t)row * DFF + ch0) = pack8(v0, v1); }
    }
};

__device__ __forceinline__ int slot2lc(int slot) { return (slot & ~31) + pg8::perm32(slot & 31); }
__device__ __forceinline__ void conv_tile(LAS float* tile, const float* src0, const float* src1, int ldsrc, int nvalid, int K, bf16_t* dst, const float* kscale, int mode, int nt, int kt) {
    const int tid = threadIdx.x;
    { const int j = tid & 63, i0 = tid >> 6; const int nrow = nt * 64 + j, t256 = nrow >> 8, lc = slot2lc(nrow & 255);
      const float* s; int col; bool valid;
      if (mode == 0) { col = t256 * 256 + lc; s = src0; valid = col < nvalid; } else { col = t256 * 128 + (lc & 127); s = (lc >> 7) ? src1 : src0; valid = true; }
      if (!valid) col = 0;
      const float* sp = s + (size_t)(kt * 256 + i0) * ldsrc + col;
      float v[32];
#pragma unroll
      for (int ii = 0; ii < 32; ++ii) v[ii] = sp[(size_t)(8 * ii) * ldsrc];
#pragma unroll
      for (int ii = 0; ii < 32; ++ii) { const int kl = i0 + 8 * ii; float x = valid ? v[ii] : 0.f; if (kscale) x *= kscale[kt * 256 + kl]; tile[j * 257 + kl] = x; } }
    __syncthreads();
    { const int kk = (tid & 127) * 2, j0 = tid >> 7;
#pragma unroll
      for (int it = 0; it < 16; ++it) { const int j = j0 + 4 * it; *(unsigned*)(dst + (size_t)(nt * 64 + j) * K + kt * 256 + kk) = pk2(tile[j * 257 + kk], tile[j * 257 + kk + 1]); } }
    __syncthreads();
}

__device__ __forceinline__ void phase_prep(const Params& p, LAS unsigned char* lds) {
    LAS float* tile = (LAS float*)lds; unsigned char* ws = p.ws;
    constexpr int N0 = 324 * 8, N1 = N0 + 32 * 8, N2 = N1 + 32 * 16, N3 = N2 + 32 * 8, N4 = N3 + 176 * 8, N5 = N4 + 32 * 22;
    for (int it = blockIdx.x; it < N5; it += gridDim.x) {
        if (it < N0)      { const int i = it;      conv_tile(tile, p.w_in, nullptr, IN_COLS, IN_COLS, DM, (bf16_t*)(ws + OFF_WIN), nullptr, 0, i / 8, i % 8); }
        else if (it < N1) { const int i = it - N0; conv_tile(tile, p.w_out_a, nullptr, DM, DM, DM, (bf16_t*)(ws + OFF_WOA), nullptr, 0, i / 8, i % 8); }
        else if (it < N2) { const int i = it - N1; conv_tile(tile, p.w_out_ssm, nullptr, DM, DM, DI, (bf16_t*)(ws + OFF_WOS), nullptr, 0, i / 16, i % 16); }
        else if (it < N3) { const int i = it - N2; conv_tile(tile, p.w_o, nullptr, DM, DM, DM, (bf16_t*)(ws + OFF_WO), nullptr, 0, i / 8, i % 8); }
        else if (it < N4) { const int i = it - N3; conv_tile(tile, p.w_ffn_gate, p.w_ffn_up, DFF, DFF, DM, (bf16_t*)(ws + OFF_WGU), p.norm_ffn_g, 1, i / 8, i % 8); }
        else              { const int i = it - N4; conv_tile(tile, p.w_ffn_down, nullptr, DM, DM, DFF, (bf16_t*)(ws + OFF_WDN), nullptr, 0, i / 22, i % 22); }
    }
    { float* s1 = (float*)(ws + OFF_SSQ1); for (int i = blockIdx.x * 512 + threadIdx.x; i < 2 * NTOK; i += gridDim.x * 512) s1[i] = 0.f; }
    { const int wave = threadIdx.x >> 6, lane = threadIdx.x & 63; bf16_t* U = (bf16_t*)(ws + OFF_U);
      for (int row = (blockIdx.x * 8 + wave) * 2; row < NTOK; row += gridDim.x * 16) {
          const f32x4* xr = (const f32x4*)(p.x + (size_t)row * DM); f32x4 v[16]; float ss0 = 0.f, ss1 = 0.f;
#pragma unroll
          for (int i = 0; i < 16; ++i) v[i] = xr[lane + 64 * i];
#pragma unroll
          for (int i = 0; i < 8; ++i) { ss0 += v[i][0] * v[i][0] + v[i][1] * v[i][1] + v[i][2] * v[i][2] + v[i][3] * v[i][3]; ss1 += v[8 + i][0] * v[8 + i][0] + v[8 + i][1] * v[8 + i][1] + v[8 + i][2] * v[8 + i][2] + v[8 + i][3] * v[8 + i][3]; }
#pragma unroll
          for (int o = 32; o >= 1; o >>= 1) { ss0 += __shfl_xor(ss0, o); ss1 += __shfl_xor(ss1, o); }
          const float r0 = rsqrtf(ss0 * (1.0f / DM) + EPS), r1 = rsqrtf(ss1 * (1.0f / DM) + EPS);
#pragma unroll
          for (int i = 0; i < 16; ++i) { const float r = i < 8 ? r0 : r1; const f32x4 gg = ((const f32x4*)p.norm_mix_g)[lane + 64 * (i & 7)]; u32x2 w; w.x = pk2(v[i][0] * r * gg[0], v[i][1] * r * gg[1]); w.y = pk2(v[i][2] * r * gg[2], v[i][3] * r * gg[3]);
              *(u32x2*)(U + (size_t)row * DM + (lane + 64 * i) * 4) = w; } } }
}

__device__ __forceinline__ void ssmconv_load(const bf16_t* XBC, int idx, u32x4 (&raw)[11]) {
    const int t0 = (idx / 768) * 8, c = (idx % 768) * 8; const bool first = (t0 & (SEQ - 1)) == 0;
#pragma unroll
    for (int r = 0; r < 11; ++r) raw[r] = (r < 3 && first) ? (u32x4){0u, 0u, 0u, 0u} : *(const u32x4*)(XBC + (size_t)(t0 - 3 + r) * CONVD + c);
}
__device__ __forceinline__ void ssmconv_compute(const Params& p, bf16_t* XS, bf16_t* BCS, int idx, const u32x4 (&raw)[11]) {
    const int t0 = (idx / 768) * 8, c = (idx % 768) * 8;
    f32x4 w0[4], w1[4];
#pragma unroll
    for (int j = 0; j < 4; ++j) { w0[j] = *(const f32x4*)(p.ssm_conv_w + j * CONVD + c); w1[j] = *(const f32x4*)(p.ssm_conv_w + j * CONVD + c + 4); }
    const f32x4 b0 = *(const f32x4*)(p.ssm_conv_b + c), b1 = *(const f32x4*)(p.ssm_conv_b + c + 4);
    bf16_t* dst = (c < DI) ? XS + (size_t)t0 * DI + c : BCS + (size_t)t0 * 2048 + (c - DI); const int ldd = (c < DI) ? DI : 2048;
#pragma unroll
    for (int i = 0; i < 8; ++i) { f32x4 a0 = b0, a1 = b1;
#pragma unroll
        for (int j = 0; j < 4; ++j) { f32x4 r0, r1; unpack8(raw[i + j], r0, r1); a0 += w0[j] * r0; a1 += w1[j] * r1; }
#pragma unroll
        for (int j = 0; j < 4; ++j) { a0[j] = siluf_(a0[j]); a1[j] = siluf_(a1[j]); }
        *(u32x4*)(dst + (size_t)i * ldd) = pack8(a0, a1); }
}
__device__ __forceinline__ void phase_ssmconv(const Params& p) {
    const bf16_t* XBC = (const bf16_t*)(p.ws + OFF_XBC); bf16_t* XS = (bf16_t*)p.out; bf16_t* BCS = (bf16_t*)(p.ws + OFF_BCS);
    const int total = (NTOK / 8) * 768, stride = gridDim.x * 512;
    int idx = blockIdx.x * 512 + threadIdx.x;
    u32x4 ra[11], rb[11];
    if (idx < total) ssmconv_load(XBC, idx, ra);
    while (idx < total) {
        const int i1 = idx + stride, i2 = idx + 2 * stride;
        if (i1 < total) ssmconv_load(XBC, i1, rb);
        ssmconv_compute(p, XS, BCS, idx, ra);
        if (i1 >= total) break;
        if (i2 < total) ssmconv_load(XBC, i2, ra);
        ssmconv_compute(p, XS, BCS, i1, rb);
        idx = i2;
    }
}

__device__ __forceinline__ void phase_ssd_seq(const Params& p, LAS unsigned char* lds) {
    LAS float* part = (LAS float*)lds;
    const int tid = threadIdx.x, pp = tid >> 3, ng = tid & 7, wave = tid >> 6, lane = tid & 63;
    const bf16_t* XS = (const bf16_t*)p.out; const bf16_t* BCS = (const bf16_t*)(p.ws + OFF_BCS); bf16_t* ZS = (bf16_t*)(p.ws + OFF_ZS);
    const float* DT = (const float*)(p.ws + OFF_DT); float* SSQH = (float*)(p.ws + OFF_SSQH);
    for (int item = blockIdx.x; item < 256; item += gridDim.x) {
        const int b = item >> 6, h = item & 63, g = h >> 3;
        const float a = -__expf(p.a_log[h]), Dk = p.d_skip[h];
        const bf16_t* xs = XS + (size_t)b * SEQ * DI + h * 64 + pp;
        const bf16_t* Bs = BCS + (size_t)b * SEQ * 2048 + g * 128 + ng * 16;
        const bf16_t* Cs = Bs + 1024;
        bf16_t* zs = ZS + (size_t)b * SEQ * DI + h * 64 + pp;
        const float* dt = DT + (size_t)b * SEQ * NH + h;
        float st[16];
#pragma unroll
        for (int i = 0; i < 16; ++i) st[i] = 0.f;
        for (int t0 = 0; t0 < SEQ; t0 += 64) {
#pragma unroll 4
            for (int tt = 0; tt < 64; ++tt) {
                const int t = t0 + tt;
                const float dtv = dt[(size_t)t * NH], xv = bf2f(xs[(size_t)t * DI]), zv = bf2f(zs[(size_t)t * DI]);
                f32x4 B0, B1, B2, B3, C0, C1, C2, C3;
                unpack8(*(const u32x4*)(Bs + (size_t)t * 2048), B0, B1); unpack8(*(const u32x4*)(Bs + (size_t)t * 2048 + 8), B2, B3);
                unpack8(*(const u32x4*)(Cs + (size_t)t * 2048), C0, C1); unpack8(*(const u32x4*)(Cs + (size_t)t * 2048 + 8), C2, C3);
                const float dA = __expf(dtv * a), xdt = xv * dtv; float y = 0.f;
#pragma unroll
                for (int i = 0; i < 4; ++i) {
                    st[i] = dA * st[i] + xdt * B0[i]; y += C0[i] * st[i];
                    st[4 + i] = dA * st[4 + i] + xdt * B1[i]; y += C1[i] * st[4 + i];
                    st[8 + i] = dA * st[8 + i] + xdt * B2[i]; y += C2[i] * st[8 + i];
                    st[12 + i] = dA * st[12 + i] + xdt * B3[i]; y += C3[i] * st[12 + i]; }
                y += __shfl_xor(y, 1); y += __shfl_xor(y, 2); y += __shfl_xor(y, 4);
                y += Dk * xv;
                const float yz = y * zv;
                if (ng == 0) zs[(size_t)t * DI] = (bf16_t)f2bf(yz);
                float sq = (ng == 0) ? yz * yz : 0.f;
                sq += __shfl_xor(sq, 8); sq += __shfl_xor(sq, 16); sq += __shfl_xor(sq, 32);
                if (lane == 0) part[tt * 8 + wave] = sq;
            }
            __syncthreads();
            if (tid < 64) { float s = 0.f;
#pragma unroll
                for (int w = 0; w < 8; ++w) s += part[tid * 8 + w];
                SSQH[(size_t)(b * SEQ + t0 + tid) * NH + h] = s; }
            __syncthreads();
        }
    }
}

typedef short s16x4 __attribute__((ext_vector_type(4)));
constexpr int SS_RSB = 272, SS_RSX = 144;
constexpr int SS_C = 0, SS_B = 34816, SS_X = 69632, SS_XW = 88064, SS_S = 106496, SS_SC = 123904, SS_M = 125952, SS_END = 160768;
__device__ __forceinline__ bf16x8 tr_frag(LAS unsigned char* lds, int addr, int step) {
    const s16x4 lo = __builtin_amdgcn_ds_read_tr16_b64_v4i16((LAS s16x4*)(lds + addr));
    const s16x4 hi = __builtin_amdgcn_ds_read_tr16_b64_v4i16((LAS s16x4*)(lds + addr + step));
    return __builtin_shufflevector(lo, hi, 0, 1, 2, 3, 4, 5, 6, 7);
}
#define MFMA16(a, b, c) __builtin_amdgcn_mfma_f32_16x16x32_bf16(a, b, c, 0, 0, 0)
#define WG_BAR() do { asm volatile("s_waitcnt lgkmcnt(0)" ::: "memory"); __builtin_amdgcn_s_barrier(); asm volatile("" ::: "memory"); } while (0)
__device__ __forceinline__ void phase_ssd_chunk(const Params& p, LAS unsigned char* lds) {
    const int tid = threadIdx.x, w = __builtin_amdgcn_readfirstlane(tid >> 6), lane = tid & 63, fr = lane & 15, g4 = lane >> 4, q = fr >> 2, pq = fr & 3;
    const bf16_t* XS = (const bf16_t*)p.out; const bf16_t* BCS = (const bf16_t*)(p.ws + OFF_BCS); bf16_t* ZS = (bf16_t*)(p.ws + OFF_ZS);
    const float* DT = (const float*)(p.ws + OFF_DT); float* SSQH = (float*)(p.ws + OFF_SSQH);
    LAS float* scal = (LAS float*)(lds + SS_SC);
    const int l = 16 * w + fr;
    for (int item = blockIdx.x; item < 256; item += gridDim.x) {
        const int b = item >> 6, grp = item & 7, h = grp * 8 + ((item >> 3) & 7);
        const float a = -__expf(p.a_log[h]), Dk = p.d_skip[h];
        f32x4 accS[4];
#pragma unroll
        for (int i = 0; i < 4; ++i) accS[i] = (f32x4){0.f, 0.f, 0.f, 0.f};
        u32x4 pb[4], pc[4], px[2]; float d0 = 0.f, d1 = 0.f;
        const bf16_t* bsrc = BCS + (size_t)(b * SEQ + (tid >> 4)) * 2048 + grp * 128 + (tid & 15) * 8;
        const bf16_t* xsrc = XS + (size_t)(b * SEQ + (tid >> 3)) * DI + h * 64 + (tid & 7) * 8;
        const float* dsrc = DT + (size_t)(b * SEQ + lane) * NH + h;
#define SSD_PREFETCH(c_) do { const size_t ro_ = (size_t)(c_) * 128; \
            _Pragma("unroll") for (int i = 0; i < 4; ++i) { pb[i] = *(const u32x4*)(bsrc + (ro_ + 32 * i) * 2048); pc[i] = *(const u32x4*)(bsrc + (ro_ + 32 * i) * 2048 + 1024); } \
            _Pragma("unroll") for (int i = 0; i < 2; ++i) px[i] = *(const u32x4*)(xsrc + (ro_ + 64 * i) * DI); \
            if (w == 0) { d0 = dsrc[ro_ * NH]; d1 = dsrc[(ro_ + 64) * NH]; } } while (0)
#define SSD_SCAN(buf_) do { if (w == 0) { float s0 = d0 * a, s1 = d1 * a; \
            _Pragma("unroll") for (int o = 1; o < 64; o <<= 1) { const float t0 = __shfl_up(s0, o), t1 = __shfl_up(s1, o); if (lane >= o) { s0 += t0; s1 += t1; } } \
            s1 += __shfl(s0, 63); LAS float* cs_ = scal + (buf_) * 256; cs_[lane] = s0; cs_[64 + lane] = s1; cs_[128 + lane] = d0; cs_[192 + lane] = d1; } } while (0)
        SSD_PREFETCH(0);
        for (int i = tid; i < 64 * SS_RSB / 16; i += 512) *(LAS u32x4*)(lds + SS_S + i * 16) = (u32x4){0u, 0u, 0u, 0u};
        SSD_SCAN(0);
        WG_BAR();
        for (int c = 0; c < 32; ++c) {
            const int tok0 = b * SEQ + c * 128;
            LAS float* csA = scal + (c & 1) * 256; LAS float* dtA = csA + 128;
            const float csend = csA[127];
#pragma unroll
            for (int i = 0; i < 4; ++i) { const int row = (tid >> 4) + 32 * i, ch = tid & 15; *(LAS u32x4*)(lds + SS_B + row * SS_RSB + ch * 16) = pb[i]; *(LAS u32x4*)(lds + SS_C + row * SS_RSB + ch * 16) = pc[i]; }
#pragma unroll
            for (int i = 0; i < 2; ++i) { const int row = (tid >> 3) + 64 * i, ch = tid & 7; *(LAS u32x4*)(lds + SS_X + row * SS_RSX + ch * 16) = px[i];
                const float wl = __expf(csend - csA[row]) * dtA[row]; f32x4 v0, v1; unpack8(px[i], v0, v1); v0 *= wl; v1 *= wl; *(LAS u32x4*)(lds + SS_XW + row * SS_RSX + ch * 16) = pack8(v0, v1); }
            WG_BAR();
            if (c + 1 < 32) SSD_PREFETCH(c + 1);
            const size_t tok = (size_t)(tok0 + l);
            bf16_t* zp = ZS + tok * DI + h * 64 + 4 * g4;
            u32x2 z2[4];
#pragma unroll
            for (int pt = 0; pt < 4; ++pt) z2[pt] = *(const u32x2*)(zp + 16 * pt);
            const float csl = csA[l];
            bf16x8 cf[4];
#pragma unroll
            for (int ks = 0; ks < 4; ++ks) cf[ks] = *(const LAS bf16x8*)(lds + SS_C + l * SS_RSB + (4 * ks + g4) * 16);
            f32x4 accY[4];
            { bf16x8 sf[4][4];
#pragma unroll
              for (int pt = 0; pt < 4; ++pt)
#pragma unroll
                  for (int ks = 0; ks < 4; ++ks) sf[pt][ks] = *(const LAS bf16x8*)(lds + SS_S + (16 * pt + fr) * SS_RSB + (4 * ks + g4) * 16);
#pragma unroll
              for (int pt = 0; pt < 4; ++pt) accY[pt] = (f32x4){0.f, 0.f, 0.f, 0.f};
#pragma unroll
              for (int ks = 0; ks < 4; ++ks)
#pragma unroll
                  for (int pt = 0; pt < 4; ++pt) accY[pt] = MFMA16(sf[pt][ks], cf[ks], accY[pt]);
              const float el = __expf(csl);
#pragma unroll
              for (int pt = 0; pt < 4; ++pt) accY[pt] *= el; }
#pragma unroll
            for (int sp = 0; sp < 4; ++sp) {
                if (2 * sp <= w) {
                    bf16x8 bfr[2][4];
#pragma unroll
                    for (int e = 0; e < 2; ++e)
#pragma unroll
                        for (int ks = 0; ks < 4; ++ks) bfr[e][ks] = *(const LAS bf16x8*)(lds + SS_B + (16 * (2 * sp + e) + fr) * SS_RSB + (4 * ks + g4) * 16);
                    f32x4 cs4[2], dt4[2];
#pragma unroll
                    for (int e = 0; e < 2; ++e) { cs4[e] = *(const LAS f32x4*)(csA + 16 * (2 * sp + e) + 4 * g4); dt4[e] = *(const LAS f32x4*)(dtA + 16 * (2 * sp + e) + 4 * g4); }
                    f32x4 a1[2] = {(f32x4){0.f, 0.f, 0.f, 0.f}, (f32x4){0.f, 0.f, 0.f, 0.f}};
#pragma unroll
                    for (int ks = 0; ks < 4; ++ks)
#pragma unroll
                        for (int e = 0; e < 2; ++e) a1[e] = MFMA16(bfr[e][ks], cf[ks], a1[e]);
#pragma unroll
                    for (int e = 0; e < 2; ++e) { float v[4];
#pragma unroll
                        for (int r = 0; r < 4; ++r) { const int s = 16 * (2 * sp + e) + 4 * g4 + r; const float t = a1[e][r] * __expf(fminf(csl - cs4[e][r], 0.f)) * dt4[e][r]; v[r] = (s <= l) ? t : 0.f; }
                        u32x2 pk; pk.x = pk2(v[0], v[1]); pk.y = pk2(v[2], v[3]); *(LAS u32x2*)(lds + SS_M + l * SS_RSB + (16 * (2 * sp + e) + 4 * g4) * 2) = pk; } } }
            { const float dec = __expf(csend);
#pragma unroll
              for (int pt = 0; pt < 4; ++pt) accS[pt] *= dec;
#pragma unroll
              for (int kp = 0; kp < 2; ++kp) { bf16x8 btf[2], xwf[2][4];
#pragma unroll
                  for (int e = 0; e < 2; ++e) { const int ks = 2 * kp + e; btf[e] = tr_frag(lds, SS_B + (32 * ks + 8 * g4 + q) * SS_RSB + (16 * w + 4 * pq) * 2, 4 * SS_RSB);
#pragma unroll
                      for (int pt = 0; pt < 4; ++pt) xwf[e][pt] = tr_frag(lds, SS_XW + (32 * ks + 8 * g4 + q) * SS_RSX + (16 * pt + 4 * pq) * 2, 4 * SS_RSX); }
#pragma unroll
                  for (int e = 0; e < 2; ++e)
#pragma unroll
                      for (int pt = 0; pt < 4; ++pt) accS[pt] = MFMA16(btf[e], xwf[e][pt], accS[pt]); } }
            if (c + 1 < 32) SSD_SCAN((c + 1) & 1);
#pragma unroll
            for (int ks = 0; ks < 4; ++ks) { if (2 * ks <= w) { const bf16x8 mf = *(const LAS bf16x8*)(lds + SS_M + l * SS_RSB + (4 * ks + g4) * 16); bf16x8 xf[4];
#pragma unroll
                for (int pt = 0; pt < 4; ++pt) xf[pt] = tr_frag(lds, SS_X + (32 * ks + 8 * g4 + q) * SS_RSX + (16 * pt + 4 * pq) * 2, 4 * SS_RSX);
#pragma unroll
                for (int pt = 0; pt < 4; ++pt) accY[pt] = MFMA16(xf[pt], mf, accY[pt]); } }
            { float sq = 0.f;
#pragma unroll
              for (int pt = 0; pt < 4; ++pt) { const u32x2 x2 = *(const LAS u32x2*)(lds + SS_X + l * SS_RSX + (16 * pt + 4 * g4) * 2);
                  const float y0 = (accY[pt][0] + Dk * bflo(x2.x)) * bflo(z2[pt].x), y1 = (accY[pt][1] + Dk * bfhi(x2.x)) * bfhi(z2[pt].x), y2 = (accY[pt][2] + Dk * bflo(x2.y)) * bflo(z2[pt].y), y3 = (accY[pt][3] + Dk * bfhi(x2.y)) * bfhi(z2[pt].y);
                  sq += y0 * y0 + y1 * y1 + y2 * y2 + y3 * y3; u32x2 o; o.x = pk2(y0, y1); o.y = pk2(y2, y3); *(u32x2*)(zp + 16 * pt) = o; }
              sq += __shfl_xor(sq, 16); sq += __shfl_xor(sq, 32);
              if (g4 == 0) SSQH[tok * NH + h] = sq; }
            WG_BAR();
#pragma unroll
            for (int pt = 0; pt < 4; ++pt) { u32x2 pk; pk.x = pk2(accS[pt][0], accS[pt][1]); pk.y = pk2(accS[pt][2], accS[pt][3]); *(LAS u32x2*)(lds + SS_S + (16 * pt + fr) * SS_RSB + (16 * w + 4 * g4) * 2) = pk; }
        }
        WG_BAR();
#undef SSD_PREFETCH
#undef SSD_SCAN
    }
}

__device__ __forceinline__ void phase_gnorm(const Params& p) {
    bf16_t* ZS = (bf16_t*)(p.ws + OFF_ZS); const float* SSQH = (const float*)(p.ws + OFF_SSQH);
    const int total = NTOK * 512 / 4;
    for (int idx = blockIdx.x * 512 + threadIdx.x; idx < total; idx += gridDim.x * 512) {
        const int t0 = (idx >> 9) * 4, cg8 = idx & 511, c = cg8 * 8, g = cg8 >> 6;
        u32x4 raw[4]; f32x4 s0[4], s1[4];
#pragma unroll
        for (int i = 0; i < 4; ++i) { raw[i] = *(const u32x4*)(ZS + (size_t)(t0 + i) * DI + c); s0[i] = *(const f32x4*)(SSQH + (size_t)(t0 + i) * NH + g * 8); s1[i] = *(const f32x4*)(SSQH + (size_t)(t0 + i) * NH + g * 8 + 4); }
        const f32x4 g0 = *(const f32x4*)(p.ssm_norm_g + c), g1 = *(const f32x4*)(p.ssm_norm_g + c + 4);
#pragma unroll
        for (int i = 0; i < 4; ++i) { const float ss = s0[i][0] + s0[i][1] + s0[i][2] + s0[i][3] + s1[i][0] + s1[i][1] + s1[i][2] + s1[i][3]; const float r = rsqrtf(ss * (1.0f / 512.0f) + EPS);
            f32x4 v0, v1; unpack8(raw[i], v0, v1); v0 = v0 * r * g0; v1 = v1 * r * g1; *(u32x4*)(ZS + (size_t)(t0 + i) * DI + c) = pack8(v0, v1); }
    }
}

__device__ __forceinline__ void phase_mixa(const Params& p) {
    const bf16_t* BB = (const bf16_t*)(p.ws + OFF_BB); const bf16_t* BC = (const bf16_t*)(p.ws + OFF_BC); const bf16_t* BH = (const bf16_t*)(p.ws + OFF_BH); bf16_t* YA = (bf16_t*)(p.ws + OFF_U);
    constexpr int TS = 8; const int total = (NTOK / TS) * 256;
    for (int idx = blockIdx.x * 512 + threadIdx.x; idx < total; idx += gridDim.x * 512) {
        const int t0 = (idx >> 8) * TS, c = (idx & 255) * 8; const bool first = (t0 & (SEQ - 1)) == 0;
        u32x4 rc[TS + 2], rh[TS + 2], rb[TS];
#pragma unroll
        for (int r = 0; r < TS + 2; ++r) { const size_t o = (size_t)(t0 - 2 + r) * DM + c; const bool z = (r < 2 && first); rc[r] = z ? (u32x4){0u, 0u, 0u, 0u} : *(const u32x4*)(BC + o); rh[r] = z ? (u32x4){0u, 0u, 0u, 0u} : *(const u32x4*)(BH + o); }
#pragma unroll
        for (int i = 0; i < TS; ++i) rb[i] = *(const u32x4*)(BB + (size_t)(t0 + i) * DM + c);
        f32x4 w0[3], w1[3];
#pragma unroll
        for (int j = 0; j < 3; ++j) { w0[j] = *(const f32x4*)(p.conv_a_w + j * DM + c); w1[j] = *(const f32x4*)(p.conv_a_w + j * DM + c + 4); }
        f32x4 q0[3], q1[3];
#pragma unroll
        for (int r = 0; r < 2; ++r) { f32x4 c0, c1, h0, h1; unpack8(rc[r], c0, c1); unpack8(rh[r], h0, h1); q0[r] = c0 * h0; q1[r] = c1 * h1; }
#pragma unroll
        for (int i = 0; i < TS; ++i) { { f32x4 c0, c1, h0, h1; unpack8(rc[i + 2], c0, c1); unpack8(rh[i + 2], h0, h1); q0[2] = c0 * h0; q1[2] = c1 * h1; }
            f32x4 a0 = w0[0] * q0[0] + w0[1] * q0[1] + w0[2] * q0[2], a1 = w1[0] * q1[0] + w1[1] * q1[1] + w1[2] * q1[2];
            f32x4 b0, b1; unpack8(rb[i], b0, b1);
            *(u32x4*)(YA + (size_t)(t0 + i) * DM + c) = pack8(a0 * b0, a1 * b1);
            q0[0] = q0[1]; q0[1] = q0[2]; q1[0] = q1[1]; q1[1] = q1[2]; }
    }
}

__device__ __forceinline__ void phase_final(const Params& p) {
    const float* SSQ2 = (const float*)(p.ws + OFF_SSQ2); const bf16_t* H2 = (const bf16_t*)(p.ws + OFF_BB);
    const int total = NTOK * 256 / 4;
    for (int idx = blockIdx.x * 512 + threadIdx.x; idx < total; idx += gridDim.x * 512) {
        const int t0 = (idx >> 8) * 4, c = (idx & 255) * 8;
        u32x4 v[4]; float r[4];
#pragma unroll
        for (int i = 0; i < 4; ++i) { v[i] = *(const u32x4*)(H2 + (size_t)(t0 + i) * DM + c); r[i] = SSQ2[t0 + i]; }
        const f32x4 g0 = *(const f32x4*)(p.norm_final_g + c), g1 = *(const f32x4*)(p.norm_final_g + c + 4);
#pragma unroll
        for (int i = 0; i < 4; ++i) { const float rr = rsqrtf(r[i] * (1.0f / DM) + EPS); f32x4 a0, a1; unpack8(v[i], a0, a1);
            *(f32x4*)(p.out + (size_t)(t0 + i) * DM + c) = a0 * rr * g0; *(f32x4*)(p.out + (size_t)(t0 + i) * DM + c + 4) = a1 * rr * g1; }
    }
}

#define XB_TMO      128
#define XB_XCNT(j)  (256  + 64 * (j))
#define XB_XSUB(j)  (1280 + 64 * (j))
#define XB_XGEN(j)  (2304 + 64 * (j))
#define XB_TOP      3328
#define XB_TOPGEN   3392
#define XCD_BAR_WORDS 3456
#define XB_SPIN_CAP (1u << 18)

__device__ __forceinline__ unsigned xb_ld(unsigned* p)              { return __hip_atomic_load(p, __ATOMIC_RELAXED, __HIP_MEMORY_SCOPE_AGENT); }
__device__ __forceinline__ unsigned xb_add(unsigned* p, unsigned v) { return __hip_atomic_fetch_add(p, v, __ATOMIC_RELAXED, __HIP_MEMORY_SCOPE_AGENT); }
__device__ __forceinline__ unsigned xb_xcc_id() { return (unsigned)__builtin_amdgcn_s_getreg((3 << 11) | 20) & 0xFu; }
#define XB_SPIN(cond, bar) do { unsigned _sp = 0; while (cond) { __builtin_amdgcn_s_sleep(1); \
    if ((++_sp & 255u) == 0u) { if (xb_ld(&(bar)[XB_TMO])) break; if (_sp > XB_SPIN_CAP) { atomicAdd(&(bar)[XB_TMO], 1u); break; } } } } while (0)

struct XcdBarrier {
    unsigned* bar; unsigned x;
    volatile LAS unsigned* st;
};

__device__ __forceinline__ XcdBarrier xcd_barrier_post(unsigned* bar, volatile LAS unsigned* st) {
    XcdBarrier b; b.bar = bar; b.x = xb_xcc_id(); b.st = st;
    if (threadIdx.x == 0) (void)xb_add(&bar[XB_XCNT(b.x)], 1u);
    return b;
}
__device__ __forceinline__ void xcd_barrier_complete(unsigned* bar, unsigned x, unsigned& nloc, unsigned& nx) {
    const unsigned G = gridDim.x * gridDim.y * gridDim.z;
    unsigned sum, cnt, mine, sp = 0u;
    for (;;) {
        sum = 0u; cnt = 0u; mine = 0u;
#pragma unroll
        for (unsigned j = 0; j < 16; ++j) { const unsigned c = xb_ld(&bar[XB_XCNT(j)]); sum += c; cnt += (c > 0u) ? 1u : 0u; mine = (j == x) ? c : mine; }
        if (sum == G) break;
        __builtin_amdgcn_s_sleep(1);
        if ((++sp & 255u) == 0u) { if (xb_ld(&bar[XB_TMO])) break; if (sp > XB_SPIN_CAP) { atomicAdd(&bar[XB_TMO], 1u); break; } }
    }
    nloc = mine > 0u ? mine : 1u; nx = cnt > 0u ? cnt : 1u;
}

__device__ __forceinline__ void xcd_barrier(const XcdBarrier& b) {
    asm volatile("s_waitcnt vmcnt(0)" ::: "memory");
    __syncthreads();
    if (threadIdx.x == 0) {
        unsigned* bar = b.bar;
        __builtin_amdgcn_s_waitcnt(0);
        unsigned nloc = b.st[0], nx = b.st[1];
        if (nloc == 0u) { xcd_barrier_complete(bar, b.x, nloc, nx); b.st[0] = nloc; b.st[1] = nx; }
        const unsigned old = xb_add(&bar[XB_XSUB(b.x)], 1u);
        const unsigned gen = old / nloc;
        if (old + 1u == (gen + 1u) * nloc) {
            __builtin_amdgcn_fence(__ATOMIC_RELEASE, "agent");
            asm volatile("s_waitcnt vmcnt(0)" ::: "memory");
            const unsigned og = xb_add(&bar[XB_TOP], 1u);
            const unsigned tg = og / nx;
            if (og + 1u == (tg + 1u) * nx) xb_add(&bar[XB_TOPGEN], 1u);
            else XB_SPIN(xb_ld(&bar[XB_TOPGEN]) == tg, bar);
            __builtin_amdgcn_fence(__ATOMIC_ACQUIRE, "agent");
            xb_add(&bar[XB_XGEN(b.x)], 1u);
            asm volatile("s_waitcnt vmcnt(0)" ::: "memory");
        } else {
            XB_SPIN(xb_ld(&bar[XB_XGEN(b.x)]) == gen, bar);
            __builtin_amdgcn_fence(__ATOMIC_ACQUIRE, "agent");
            asm volatile("s_waitcnt vmcnt(0)" ::: "memory");
        }
    }
    __syncthreads();
}

constexpr int NPHASE = 11;
template <int PH> __device__ __forceinline__ void run_phase(const Params& p, LAS unsigned char* lds) {
    unsigned char* ws = p.ws;
    pg8::StaticOrder S; pg8::Gemm g;
    if constexpr (PH == 0) { phase_prep(p, lds); }
    else if constexpr (PH == 1) {
        g.A = (const bf16_t*)(ws + OFF_U); g.Bt = (const bf16_t*)(ws + OFF_WIN) + (size_t)40 * 256 * DM; g.M = NTOK; g.N = 41 * 256; g.K = DM; S.init(g.M, g.N, gridDim.x, blockIdx.x);
        EpiRoute E{(bf16_t*)p.out, (bf16_t*)p.out + (size_t)NTOK * DM, (bf16_t*)(ws + OFF_BB), (bf16_t*)(ws + OFF_BC), (bf16_t*)(ws + OFF_BH), (bf16_t*)(ws + OFF_ZS), (bf16_t*)(ws + OFF_XBC), (float*)(ws + OFF_DT), p.dt_bias, 40};
        pg8::gemm_phase(lds, g, S, E); }
    else if constexpr (PH == 2) { phase_ssmconv(p); }
    else if constexpr (PH == 3) { phase_ssd_chunk(p, lds); }
    else if constexpr (PH == 4) {
        g.A = (const bf16_t*)(ws + OFF_U); g.Bt = (const bf16_t*)(ws + OFF_WIN); g.M = NTOK; g.N = 40 * 256; g.K = DM; S.init(g.M, g.N, gridDim.x, blockIdx.x);
        EpiRoute E{(bf16_t*)p.out, (bf16_t*)p.out + (size_t)NTOK * DM, (bf16_t*)(ws + OFF_BB), (bf16_t*)(ws + OFF_BC), (bf16_t*)(ws + OFF_BH), (bf16_t*)(ws + OFF_ZS), (bf16_t*)(ws + OFF_XBC), (float*)(ws + OFF_DT), p.dt_bias, 0};
        pg8::gemm_phase(lds, g, S, E);
        phase_gnorm(p); }
    else if constexpr (PH == 5) { phase_mixa(p); }
    else if constexpr (PH == 6) {
        g.A = (const bf16_t*)(ws + OFF_U); g.Bt = (const bf16_t*)(ws + OFF_WOA); g.M = NTOK; g.N = DM; g.K = DM; S.init(g.M, g.N, gridDim.x, blockIdx.x);
        EpiGate<false> Ea{(const bf16_t*)p.out, nullptr, (bf16_t*)(ws + OFF_BB)};
        pg8::gemm_phase(lds, g, S, Ea);
        g.A = (const bf16_t*)(ws + OFF_ZS); g.Bt = (const bf16_t*)(ws + OFF_WOS); g.K = DI;
        EpiGate<true> Eb{(const bf16_t*)p.out + (size_t)NTOK * DM, (const bf16_t*)(ws + OFF_BB), (bf16_t*)(ws + OFF_BC)};
        pg8::gemm_phase(lds, g, S, Eb); }
    else if constexpr (PH == 7) {
        g.A = (const bf16_t*)(ws + OFF_BC); g.Bt = (const bf16_t*)(ws + OFF_WO); g.M = NTOK; g.N = DM; g.K = DM; S.init(g.M, g.N, gridDim.x, blockIdx.x);
        EpiRes<false> E{p.x, (bf16_t*)(ws + OFF_BH), (float*)(ws + OFF_SSQ1)};
        pg8::gemm_phase(lds, g, S, E); }
    else if constexpr (PH == 8) {
        g.A = (const bf16_t*)(ws + OFF_BH); g.Bt = (const bf16_t*)(ws + OFF_WGU); g.M = NTOK; g.N = 2 * DFF; g.K = DM; S.init(g.M, g.N, gridDim.x, blockIdx.x);
        EpiSwiglu E{(const float*)(ws + OFF_SSQ1), (bf16_t*)(ws + OFF_ZS)};
        pg8::gemm_phase(lds, g, S, E); }
    else if constexpr (PH == 9) {
        g.A = (const bf16_t*)(ws + OFF_ZS); g.Bt = (const bf16_t*)(ws + OFF_WDN); g.M = NTOK; g.N = DM; g.K = DFF; S.init(g.M, g.N, gridDim.x, blockIdx.x);
        EpiRes<true> E{(const void*)(ws + OFF_BH), (bf16_t*)(ws + OFF_BB), (float*)(ws + OFF_SSQ2)};
        pg8::gemm_phase(lds, g, S, E); }
    else if constexpr (PH == 10) { phase_final(p); }
}

template <int PH> __global__ void __launch_bounds__(512, 2) k_one(Params p) {
    extern __shared__ __attribute__((aligned(16))) unsigned char lds_raw[];
    run_phase<PH>(p, (LAS unsigned char*)lds_raw);
}

#ifndef PROBE_MASK
#define PROBE_MASK 0
#endif
__global__ void __launch_bounds__(512, 2) k_mega(Params p) {
    extern __shared__ __attribute__((aligned(16))) unsigned char lds_raw[];
    LAS unsigned char* lds = (LAS unsigned char*)lds_raw;
    cg::grid_group grid = cg::this_grid();
    unsigned long long spin = 0, t0 = 0;
    volatile LAS unsigned* bst = (volatile LAS unsigned*)(lds + SS_END);
    if (threadIdx.x < 4) bst[threadIdx.x] = 0u;
    __syncthreads();
    const XcdBarrier xbar = xcd_barrier_post((unsigned*)(p.ws + OFF_BAR), bst);
#define PH_RUN(i, SYNC) do { if (PROBE_MASK) t0 = __builtin_amdgcn_s_memrealtime(); if (PROBE_KMASK && threadIdx.x == 0) *(LAS unsigned long long*)(lds + SS_END + 8) = 0ull; run_phase<i>(p, lds); if ((PROBE_KMASK & (1 << i)) && threadIdx.x == 0) spin += *(LAS unsigned long long*)(lds + SS_END + 8); if (SYNC == 1) grid.sync(); else if (SYNC == 2) xcd_barrier(xbar); \
        if (PROBE_MASK & (1 << i)) spin += __builtin_amdgcn_s_memrealtime() - t0; } while (0)
    PH_RUN(0, 1); PH_RUN(1, 2); PH_RUN(2, 2); PH_RUN(3, 2); PH_RUN(4, 2); PH_RUN(5, 2); PH_RUN(6, 2); PH_RUN(7, 2); PH_RUN(8, 2); PH_RUN(9, 2); PH_RUN(10, 0);
#ifdef PROBE_SYNCS
    for (int i = 0; i < PROBE_SYNCS; ++i) xcd_barrier(xbar);
#endif
    if ((PROBE_MASK || PROBE_KMASK) && blockIdx.x == 0) { t0 = __builtin_amdgcn_s_memrealtime(); while (__builtin_amdgcn_s_memrealtime() - t0 < spin) __builtin_amdgcn_s_sleep(8); }
}

constexpr int LDS_BYTES = SS_END + 16;

template <int PH> static void launch_one(const Params& p, int grid, hipStream_t stream) {
    static bool attr = false;
    if (!attr) { (void)hipFuncSetAttribute((const void*)k_one<PH>, hipFuncAttributeMaxDynamicSharedMemorySize, LDS_BYTES); attr = true; }
    hipLaunchKernelGGL(k_one<PH>, dim3(grid), dim3(512), LDS_BYTES, stream, p);
}

extern "C" void kernel_launch(void* const* d_in, const int* in_sizes, int n_in, void* d_out, int out_size, void* d_ws, size_t ws_size, hipStream_t stream) {
    static int grid = 0;
    if (grid == 0) {
        if (n_in != 18 || out_size != NTOK * DM || ws_size < WS_END) { fprintf(stderr, "kernel_launch: unexpected shapes: n_in %d out %d ws %zu (need %zu)\n", n_in, out_size, ws_size, (size_t)WS_END); grid = -1; return; }
        int dev = 0, cus = 0, per_cu = 0;
        (void)hipGetDevice(&dev); (void)hipDeviceGetAttribute(&cus, hipDeviceAttributeMultiprocessorCount, dev);
        (void)hipFuncSetAttribute((const void*)k_mega, hipFuncAttributeMaxDynamicSharedMemorySize, LDS_BYTES);
        (void)hipOccupancyMaxActiveBlocksPerMultiprocessor(&per_cu, (const void*)k_mega, 512, LDS_BYTES);
        if (per_cu < 1) { fprintf(stderr, "kernel_launch: occupancy query says %d blocks per CU\n", per_cu); per_cu = 1; }
        (void)hipGetLastError();
        grid = cus * per_cu;
        fprintf(stderr, "kernel_launch: cus %d per_cu %d grid %d ws %zu\n", cus, per_cu, grid, ws_size);
    }
    if (grid < 0) return;
    Params p{};
    const float** pp = (const float**)&p;
    for (int i = 0; i < 18; ++i) pp[i] = (const float*)d_in[i];
    p.out = (float*)d_out; p.ws = (unsigned char*)d_ws;
#if MEGA
    (void)hipMemsetAsync((unsigned char*)d_ws + OFF_BAR, 0, XCD_BAR_WORDS * 4, stream);
    void* args[] = {&p};
    hipError_t e = hipLaunchCooperativeKernel((const void*)k_mega, dim3(grid), dim3(512), args, LDS_BYTES, stream);
    if (e != hipSuccess) fprintf(stderr, "cooperative launch failed: %s (grid %d)\n", hipGetErrorString(e), grid);
#else
    launch_one<0>(p, grid, stream); launch_one<1>(p, grid, stream); launch_one<2>(p, grid, stream); launch_one<3>(p, grid, stream); launch_one<4>(p, grid, stream); launch_one<5>(p, grid, stream);
    launch_one<6>(p, grid, stream); launch_one<7>(p, grid, stream); launch_one<8>(p, grid, stream); launch_one<9>(p, grid, stream); launch_one<10>(p, grid, stream);
#endif
}
```

```cpp
#include <hip/hip_runtime.h>
#include <hip/hip_cooperative_groups.h>
#include <cstdio>
namespace cg = cooperative_groups;

#ifndef MEGA
#define MEGA 1
#endif

#define LAS __attribute__((address_space(3)))
typedef unsigned short bf16_t;
typedef short bf16x8 __attribute__((ext_vector_type(8)));
typedef float f32x4 __attribute__((ext_vector_type(4)));
typedef unsigned u32x4 __attribute__((ext_vector_type(4)));
typedef unsigned u32x2 __attribute__((ext_vector_type(2)));

constexpr int DM = 2048, NTOK = 16384, SEQ = 4096;
constexpr int IN_COLS = 20544, IN_TILES = 81;
constexpr int DI = 4096, NH = 64, HD = 64, NG = 8, NST = 128, CONVD = 6144;
constexpr int DFF = 5632;
constexpr float EPS = 1e-6f;

constexpr size_t MiB = 1024ull * 1024ull;
constexpr size_t OFF_WIN = 0;
constexpr size_t OFF_WOA = 81 * MiB;
constexpr size_t OFF_WOS = 89 * MiB;
constexpr size_t OFF_WO  = 105 * MiB;
constexpr size_t OFF_WGU = 113 * MiB;
constexpr size_t OFF_WDN = 157 * MiB;
constexpr size_t OFF_ZS  = 179 * MiB;
constexpr size_t OFF_U   = 307 * MiB;
constexpr size_t OFF_XBC = 371 * MiB;
constexpr size_t OFF_BB  = 371 * MiB, OFF_BC = 435 * MiB, OFF_BH = 499 * MiB;
constexpr size_t OFF_DT  = 563 * MiB;
constexpr size_t OFF_SSQH = 567 * MiB;
constexpr size_t OFF_SSQ1 = 571 * MiB;
constexpr size_t OFF_SSQ2 = 571 * MiB + 65536;
constexpr size_t OFF_BCS = 572 * MiB;
constexpr size_t OFF_BAR = 636 * MiB;
constexpr size_t WS_END = 637 * MiB;

struct Params {
    const float *x, *norm_mix_g, *w_in, *conv_a_w, *w_out_a, *ssm_conv_w, *ssm_conv_b, *dt_bias, *a_log, *d_skip, *ssm_norm_g, *w_out_ssm, *w_o, *norm_ffn_g, *w_ffn_gate, *w_ffn_up,
        *w_ffn_down, *norm_final_g;
    float* out; unsigned char* ws;
};

__device__ __forceinline__ unsigned f2bf(float f) { unsigned u = __builtin_bit_cast(unsigned, f); return (u + 0x7fffu + ((u >> 16) & 1u)) >> 16; }
__device__ __forceinline__ unsigned pk2(float lo, float hi) { unsigned r; asm("v_cvt_pk_bf16_f32 %0, %1, %2" : "=v"(r) : "v"(lo), "v"(hi)); return r; }
__device__ __forceinline__ float bflo(unsigned w) { return __builtin_bit_cast(float, w << 16); }
__device__ __forceinline__ float bfhi(unsigned w) { return __builtin_bit_cast(float, w & 0xffff0000u); }
__device__ __forceinline__ float bf2f(bf16_t v) { return __builtin_bit_cast(float, ((unsigned)v) << 16); }
__device__ __forceinline__ float sigmoidf_(float v) { return __builtin_amdgcn_rcpf(1.0f + __expf(-v)); }
__device__ __forceinline__ float siluf_(float v) { return v * sigmoidf_(v); }
__device__ __forceinline__ float softplusf_(float v) { return fmaxf(v, 0.f) + log1pf(__expf(-fabsf(v))); }
__device__ __forceinline__ u32x4 pack8(const f32x4& a, const f32x4& b) { u32x4 w; w.x = pk2(a[0], a[1]); w.y = pk2(a[2], a[3]); w.z = pk2(b[0], b[1]); w.w = pk2(b[2], b[3]); return w; }
__device__ __forceinline__ void unpack8(const u32x4& w, f32x4& a, f32x4& b) { a[0] = bflo(w.x); a[1] = bfhi(w.x); a[2] = bflo(w.y); a[3] = bfhi(w.y); b[0] = bflo(w.z); b[1] = bfhi(w.z); b[2] = bflo(w.w); b[3] = bfhi(w.w); }

#ifndef PROBE_KMASK
#define PROBE_KMASK 0
#endif
#ifndef STAGGER_TICKS
#define STAGGER_TICKS 0
#endif
namespace pg8 {
constexpr int BM = 256, BK = 64, HALF = 128, HTB = HALF * BK * 2, STAGE_BYTES = 8 * HTB, NXCD = 8, WGM = 8;
__host__ __device__ __forceinline__ int lds_byte(int r, int c) { const int st = (r >> 4) * 2 + (c >> 5), rr = r & 15, cc = c & 31, ob = rr * 64 + cc * 2; return st * 1024 + (ob ^ (((ob >> 9) & 1) << 5)); }
__host__ __device__ __forceinline__ void stage_rc(int b, int& R, int& C) { const int st = b / 1024, sb = b % 1024, swz = sb ^ (((sb >> 9) & 1) << 5); R = (st >> 1) * 16 + swz / 64; C = (st & 1) * 32 + (swz % 64) / 2; }
__host__ __device__ __forceinline__ int perm32(int rho) { const int n = rho >> 4, i = rho & 15; return 8 * (i >> 2) + 4 * n + (i & 3); }
struct Unit { int pm, pn; };
struct Gemm { const bf16_t* A; const bf16_t* Bt; int M, N, K; };
struct StaticOrder {
    int nM, nN, nwg, G, c;
    __host__ __device__ void init(int M, int N, int G_, int c_) { nM = M / BM; nN = N / BM; nwg = nM * nN; G = G_; c = c_; }
    __host__ __device__ bool next(int i, Unit& u) const {
        const long L = (long)i * G + c; if (L >= nwg) return false;
        int wgid = (int)L; { const int q = nwg / NXCD, r = nwg % NXCD, xcd = wgid % NXCD, off = wgid / NXCD; wgid = (xcd < r ? xcd * (q + 1) : r * (q + 1) + (xcd - r) * q) + off; }
        const int nig = WGM * nN, gid = wgid / nig, fm = gid * WGM, gsz = (nM - fm) < WGM ? (nM - fm) : WGM;
        u.pm = fm + ((wgid % nig) % gsz); u.pn = (wgid % nig) / gsz; return true;
    }
};

template <class Epi>
__device__ __forceinline__ void gemm_phase(LAS unsigned char* lds, const Gemm g, const StaticOrder& S, const Epi& E) {
    const int tid = threadIdx.x, wid = __builtin_amdgcn_readfirstlane(tid >> 6), lane = tid & 63, wr = wid >> 2, wc = wid & 3, fr = lane & 15, fq = lane >> 4;
    const int K = g.K, nt = K / BK;
    unsigned voffA[2];
#pragma unroll
    for (int i = 0; i < 2; ++i) { int R, C; stage_rc(tid * 16 + i * 8192, R, C); voffA[i] = (unsigned)(R * K + C) * 2u; }
    const size_t kstep = (size_t)(BK * 2);
    const size_t hstep = (size_t)HALF * K * 2;
    const size_t tstep = 2 * hstep;
    const unsigned ldsw = (unsigned)wid * 1024u;
    const int aoff = lds_byte(wr * 64 + fr, fq * 8), boff = lds_byte(wc * 32 + fr, fq * 8);
#define PG8_SA(b, h) (((b) * 2 + (h)) * HTB)
#define PG8_SB(b, h) ((4 + (b) * 2 + (h)) * HTB)
#define PG8_STAGE(bufoff, gbase, voff) do { _Pragma("unroll") for (int _i = 0; _i < 2; ++_i) \
        __builtin_amdgcn_global_load_lds((const unsigned*)((const char*)(gbase) + (voff)[_i]), (LAS unsigned*)(lds + (bufoff) + ldsw + _i * 8192), 16, 0, 0); } while (0)
#define PG8_LDA(dst, b, h) do { _Pragma("unroll") for (int m = 0; m < 4; ++m) _Pragma("unroll") for (int k = 0; k < 2; ++k) dst[m][k] = *(const LAS bf16x8*)(lds + PG8_SA(b, h) + aoff + m * 2048 + k * 1024); } while (0)
#define PG8_LDB(dst, b, h) do { _Pragma("unroll") for (int n = 0; n < 2; ++n) _Pragma("unroll") for (int k = 0; k < 2; ++k) dst[n][k] = *(const LAS bf16x8*)(lds + PG8_SB(b, h) + boff + n * 2048 + k * 1024); } while (0)
#define PG8_MMA(ai, bj, At, Bt) do { __builtin_amdgcn_s_setprio(1); _Pragma("unroll") for (int m = 0; m < 4; ++m) _Pragma("unroll") for (int n = 0; n < 2; ++n) _Pragma("unroll") for (int k = 0; k < 2; ++k) \
        acc[ai][bj][m][n] = __builtin_amdgcn_mfma_f32_16x16x32_bf16(Bt[n][k], At[m][k], acc[ai][bj][m][n], 0, 0, 0); __builtin_amdgcn_s_setprio(0); } while (0)
#define PG8_WAIT_V(n) asm volatile("s_waitcnt vmcnt(" #n ")" ::: "memory")
#define PG8_WAIT_L(n) asm volatile("s_waitcnt lgkmcnt(" #n ")" ::: "memory")
#define PG8_BAR __builtin_amdgcn_s_barrier()
#define PG8_SCHED __builtin_amdgcn_sched_barrier(0)
    Unit cur, nxt; int ui = 0;
    if (!S.next(0, cur)) return;
    if (STAGGER_TICKS) { const unsigned long long t0 = __builtin_amdgcn_s_memrealtime(), d = (unsigned long long)(blockIdx.x & 7) * STAGGER_TICKS; while (__builtin_amdgcn_s_memrealtime() - t0 < d) __builtin_amdgcn_s_sleep(4); }
    f32x4 acc[2][2][4][2];
#pragma unroll
    for (int a = 0; a < 2; ++a)
#pragma unroll
        for (int b = 0; b < 2; ++b)
#pragma unroll
            for (int m = 0; m < 4; ++m)
#pragma unroll
                for (int n = 0; n < 2; ++n) acc[a][b][m][n] = (f32x4){0.f, 0.f, 0.f, 0.f};
    bf16x8 At[4][2], B0[2][2], B1[2][2];
    const char* cA = (const char*)g.A + (size_t)cur.pm * tstep; const char* cB = (const char*)g.Bt + (size_t)cur.pn * tstep;
    PG8_STAGE(PG8_SB(0, 0), cB, voffA); PG8_STAGE(PG8_SA(0, 0), cA, voffA); PG8_STAGE(PG8_SB(0, 1), cB + hstep, voffA); PG8_STAGE(PG8_SA(0, 1), cA + hstep, voffA);
    if (wr == 1) PG8_BAR;
    PG8_WAIT_V(4); PG8_BAR;
    PG8_STAGE(PG8_SB(1, 0), cB + kstep, voffA); PG8_STAGE(PG8_SA(1, 0), cA + kstep, voffA); PG8_STAGE(PG8_SB(1, 1), cB + hstep + kstep, voffA);
    PG8_WAIT_V(6); PG8_BAR;
    for (;;) {
        const bool has_next = S.next(ui + 1, nxt);
        const char* nA = has_next ? (const char*)g.A + (size_t)nxt.pm * tstep : cA; const char* nB = has_next ? (const char*)g.Bt + (size_t)nxt.pn * tstep : cB;
        unsigned long long kt0_ = 0; if (PROBE_KMASK) kt0_ = __builtin_amdgcn_s_memrealtime();
        for (int t = 0; t < nt; t += 2) {
            const bool last = (t == nt - 2);
            const char* a1 = cA + (size_t)(t + 1) * kstep;
            const char* a2 = last ? nA : cA + (size_t)(t + 2) * kstep; const char* b2 = last ? nB : cB + (size_t)(t + 2) * kstep;
            const char* a3 = a2 + kstep; const char* b3 = b2 + kstep;
            PG8_LDB(B0, 0, 0); PG8_SCHED; PG8_LDA(At, 0, 0); PG8_STAGE(PG8_SA(1, 1), a1 + hstep, voffA);
            PG8_WAIT_L(8); PG8_BAR; PG8_WAIT_L(0); PG8_MMA(0, 0, At, B0); PG8_BAR; PG8_SCHED;
            PG8_LDB(B1, 0, 1); PG8_STAGE(PG8_SB(0, 0), b2, voffA);
            PG8_BAR; PG8_WAIT_L(0); PG8_MMA(0, 1, At, B1); PG8_BAR;
            PG8_LDA(At, 0, 1); PG8_STAGE(PG8_SA(0, 0), a2, voffA);
            PG8_BAR; PG8_WAIT_L(0); PG8_MMA(1, 0, At, B0); PG8_BAR; PG8_SCHED;
            PG8_STAGE(PG8_SB(0, 1), b2 + hstep, voffA);
            PG8_WAIT_V(6); PG8_BAR; PG8_MMA(1, 1, At, B1); PG8_BAR;
            PG8_LDB(B0, 1, 0); PG8_SCHED; PG8_LDA(At, 1, 0); PG8_STAGE(PG8_SA(0, 1), a2 + hstep, voffA);
            PG8_WAIT_L(8); PG8_BAR; PG8_WAIT_L(0); PG8_MMA(0, 0, At, B0); PG8_BAR; PG8_SCHED;
            PG8_LDB(B1, 1, 1); PG8_STAGE(PG8_SB(1, 0), b3, voffA);
            PG8_BAR; PG8_WAIT_L(0); PG8_MMA(0, 1, At, B1); PG8_BAR;
            PG8_LDA(At, 1, 1); PG8_STAGE(PG8_SA(1, 0), a3, voffA);
            PG8_BAR; PG8_WAIT_L(0); PG8_MMA(1, 0, At, B0); PG8_BAR; PG8_SCHED;
            PG8_STAGE(PG8_SB(1, 1), b3 + hstep, voffA);
            PG8_WAIT_V(6); PG8_BAR; PG8_MMA(1, 1, At, B1); PG8_BAR;
        }
        if (PROBE_KMASK && tid == 0) *(LAS unsigned long long*)(lds + 160768 + 8) += __builtin_amdgcn_s_memrealtime() - kt0_;
        E(acc, cur, wr, wc, fr, fq);
        if (!has_next) break;
#pragma unroll
        for (int a = 0; a < 2; ++a)
#pragma unroll
            for (int b = 0; b < 2; ++b)
#pragma unroll
                for (int m = 0; m < 4; ++m)
#pragma unroll
                    for (int n = 0; n < 2; ++n) acc[a][b][m][n] = (f32x4){0.f, 0.f, 0.f, 0.f};
        cur = nxt; cA = nA; cB = nB; ++ui;
    }
    PG8_WAIT_V(0);
    if (wr == 0) PG8_BAR;
    PG8_BAR;
#undef PG8_SA
#undef PG8_SB
#undef PG8_STAGE
#undef PG8_LDA
#undef PG8_LDB
#undef PG8_MMA
#undef PG8_WAIT_V
#undef PG8_WAIT_L
#undef PG8_BAR
#undef PG8_SCHED
}
}
using pg8::Unit;

struct EpiRoute {
    bf16_t *GA, *GB, *BB, *BC, *BH, *ZS, *XBC; float* DT; const float* dt_bias; int tile0;
    __device__ __forceinline__ void operator()(const f32x4 (&acc)[2][2][4][2], const Unit& u, int wr, int wc, int fr, int fq) const {
        const int gt = u.pn + tile0; const int row0 = u.pm * 256 + wr * 64 + fr;
        if (gt >= 24 && gt < 40) {
            const int ch0 = (gt - 24) * 128 + wc * 32 + 8 * fq;
#pragma unroll
            for (int ai = 0; ai < 2; ++ai)
#pragma unroll
                for (int m = 0; m < 4; ++m) *(u32x4*)(BC + (size_t)(row0 + ai * 128 + m * 16) * DM + ch0) = pack8(acc[ai][0][m][0] * acc[ai][1][m][0], acc[ai][0][m][1] * acc[ai][1][m][1]);
        } else if (gt < 80) {
            bf16_t* base; int ldc, cb, act;
            if (gt < 40) { const int r = gt >> 3; base = (r == 0 ? GA : r == 1 ? GB : r == 2 ? BB : r == 3 ? BC : BH); ldc = DM; cb = (gt & 7) * 256; act = r < 2 ? 1 : 0; }
            else if (gt < 56) { base = ZS; ldc = DI; cb = (gt - 40) * 256; act = 2; }
            else { base = XBC; ldc = CONVD; cb = (gt - 56) * 256; act = 0; }
            const int col0 = cb + wc * 32 + 8 * fq;
#pragma unroll
            for (int ai = 0; ai < 2; ++ai)
#pragma unroll
                for (int m = 0; m < 4; ++m) { bf16_t* rowp = base + (size_t)(row0 + ai * 128 + m * 16) * ldc + col0;
#pragma unroll
                    for (int bj = 0; bj < 2; ++bj) { f32x4 v0 = acc[ai][bj][m][0], v1 = acc[ai][bj][m][1];
                        if (act == 1) {
#pragma unroll
                            for (int j = 0; j < 4; ++j) { v0[j] = sigmoidf_(v0[j]); v1[j] = sigmoidf_(v1[j]); } }
                        else if (act == 2) {
#pragma unroll
                            for (int j = 0; j < 4; ++j) { v0[j] = siluf_(v0[j]); v1[j] = siluf_(v1[j]); } }
                        *(u32x4*)(rowp + bj * 128) = pack8(v0, v1); } }
        } else if (wc < 2) {
            const int c0 = wc * 32 + 8 * fq;
            f32x4 b0 = *(const f32x4*)(dt_bias + c0), b1 = *(const f32x4*)(dt_bias + c0 + 4);
#pragma unroll
            for (int ai = 0; ai < 2; ++ai)
#pragma unroll
                for (int m = 0; m < 4; ++m) { float* rowp = DT + (size_t)(row0 + ai * 128 + m * 16) * NH + c0;
                    f32x4 v0 = acc[ai][0][m][0] + b0, v1 = acc[ai][0][m][1] + b1;
#pragma unroll
                    for (int j = 0; j < 4; ++j) { v0[j] = softplusf_(v0[j]); v1[j] = softplusf_(v1[j]); }
                    *(f32x4*)rowp = v0; *(f32x4*)(rowp + 4) = v1; }
        }
    }
};
template <bool ADD> struct EpiGate {
    const bf16_t* GATE; const bf16_t* PREV; bf16_t* O;
    __device__ __forceinline__ void operator()(const f32x4 (&acc)[2][2][4][2], const Unit& u, int wr, int wc, int fr, int fq) const {
        const int row0 = u.pm * 256 + wr * 64 + fr, col0 = u.pn * 256 + wc * 32 + 8 * fq;
        constexpr int MB = ADD ? 2 : 4;
#pragma unroll
        for (int ai = 0; ai < 2; ++ai)
#pragma unroll
            for (int m0 = 0; m0 < 4; m0 += MB) {
                u32x4 gv[MB][2], pv[MB][2];
#pragma unroll
                for (int mm = 0; mm < MB; ++mm)
#pragma unroll
                    for (int bj = 0; bj < 2; ++bj) { const size_t idx = (size_t)(row0 + ai * 128 + (m0 + mm) * 16) * DM + col0 + bj * 128; gv[mm][bj] = *(const u32x4*)(GATE + idx); if (ADD) pv[mm][bj] = *(const u32x4*)(PREV + idx); }
#pragma unroll
                for (int mm = 0; mm < MB; ++mm)
#pragma unroll
                    for (int bj = 0; bj < 2; ++bj) { const size_t idx = (size_t)(row0 + ai * 128 + (m0 + mm) * 16) * DM + col0 + bj * 128;
                        f32x4 g0, g1; unpack8(gv[mm][bj], g0, g1);
                        f32x4 v0 = g0 * acc[ai][bj][m0 + mm][0], v1 = g1 * acc[ai][bj][m0 + mm][1];
                        if (ADD) { f32x4 p0, p1; unpack8(pv[mm][bj], p0, p1); v0 += p0; v1 += p1; }
                        *(u32x4*)(O + idx) = pack8(v0, v1); } }
    }
};
template <bool XBF> struct EpiRes {
    const void* X; bf16_t* HBF; float* ssq;
    __device__ __forceinline__ void operator()(const f32x4 (&acc)[2][2][4][2], const Unit& u, int wr, int wc, int fr, int fq) const {
        const int row0 = u.pm * 256 + wr * 64 + fr, col0 = u.pn * 256 + wc * 32 + 8 * fq;
#pragma unroll
        for (int ai = 0; ai < 2; ++ai) {
            f32x4 xv[4][2][2];
#pragma unroll
            for (int m = 0; m < 4; ++m)
#pragma unroll
                for (int bj = 0; bj < 2; ++bj) { const size_t idx = (size_t)(row0 + ai * 128 + m * 16) * DM + col0 + bj * 128;
                    if (XBF) { const u32x4 r = *(const u32x4*)((const bf16_t*)X + idx); unpack8(r, xv[m][bj][0], xv[m][bj][1]); }
                    else { xv[m][bj][0] = *(const f32x4*)((const float*)X + idx); xv[m][bj][1] = *(const f32x4*)((const float*)X + idx + 4); } }
#pragma unroll
            for (int m = 0; m < 4; ++m) { const int row = row0 + ai * 128 + m * 16; const size_t ro = (size_t)row * DM + col0; float s = 0.f;
#pragma unroll
                for (int bj = 0; bj < 2; ++bj) { const size_t idx = ro + bj * 128;
                    const f32x4 h0 = xv[m][bj][0] + acc[ai][bj][m][0], h1 = xv[m][bj][1] + acc[ai][bj][m][1];
                    *(u32x4*)(HBF + idx) = pack8(h0, h1);
#pragma unroll
                    for (int j = 0; j < 4; ++j) s += h0[j] * h0[j] + h1[j] * h1[j]; }
                s += __shfl_xor(s, 16); s += __shfl_xor(s, 32);
                if (fq == 0) atomicAdd(ssq + row, s); } }
    }
};
struct EpiSwiglu {
    const float* ssq; bf16_t* ACT;
    __device__ __forceinline__ void operator()(const f32x4 (&acc)[2][2][4][2], const Unit& u, int wr, int wc, int fr, int fq) const {
        const int row0 = u.pm * 256 + wr * 64 + fr, ch0 = u.pn * 128 + wc * 32 + 8 * fq;
        float rs[2][4];
#pragma unroll
        for (int ai = 0; ai < 2; ++ai)
#pragma unroll
            for (int m = 0; m < 4; ++m) rs[ai][m] = ssq[row0 + ai * 128 + m * 16];
#pragma unroll
        for (int ai = 0; ai < 2; ++ai)
#pragma unroll
            for (int m = 0; m < 4; ++m) rs[ai][m] = rsqrtf(rs[ai][m] * (1.0f / DM) + EPS);
#pragma unroll
        for (int ai = 0; ai < 2; ++ai)
#pragma unroll
            for (int m = 0; m < 4; ++m) { const int row = row0 + ai * 128 + m * 16; const float r = rs[ai][m];
                f32x4 v0, v1;
#pragma unroll
                for (int j = 0; j < 4; ++j) { v0[j] = siluf_(acc[ai][0][m][0][j] * r) * (acc[ai][1][m][0][j] * r); v1[j] = siluf_(acc[ai][0][m][1][j] * r) * (acc[ai][1][m][1][j] * r); }
                *(u32x4*)(ACT + (size_t)row * DFF + ch0) = pack8(v0, v1); }
    }
};

__device__ __forceinline__ int slot2lc(int slot) { return (slot & ~31) + pg8::perm32(slot & 31); }
__device__ __forceinline__ void conv_tile(LAS float* tile, const float* src0, const float* src1, int ldsrc, int nvalid, int K, bf16_t* dst, const float* kscale, int mode, int nt, int kt) {
    const int tid = threadIdx.x;
    { const int j = tid & 63, i0 = tid >> 6; const int nrow = nt * 64 + j, t256 = nrow >> 8, lc = slot2lc(nrow & 255);
      const float* s; int col; bool valid;
      if (mode == 0) { col = t256 * 256 + lc; s = src0; valid = col < nvalid; } else { col = t256 * 128 + (lc & 127); s = (lc >> 7) ? src1 : src0; valid = true; }
      if (!valid) col = 0;
      const float* sp = s + (size_t)(kt * 256 + i0) * ldsrc + col;
      float v[32];
#pragma unroll
      for (int ii = 0; ii < 32; ++ii) v[ii] = sp[(size_t)(8 * ii) * ldsrc];
#pragma unroll
      for (int ii = 0; ii < 32; ++ii) { const int kl = i0 + 8 * ii; float x = valid ? v[ii] : 0.f; if (kscale) x *= kscale[kt * 256 + kl]; tile[j * 257 + kl] = x; } }
    __syncthreads();
    { const int kk = (tid & 127) * 2, j0 = tid >> 7;
#pragma unroll
      for (int it = 0; it < 16; ++it) { const int j = j0 + 4 * it; *(unsigned*)(dst + (size_t)(nt * 64 + j) * K + kt * 256 + kk) = pk2(tile[j * 257 + kk], tile[j * 257 + kk + 1]); } }
    __syncthreads();
}

__device__ __forceinline__ void phase_prep(const Params& p, LAS unsigned char* lds) {
    LAS float* tile = (LAS float*)lds; unsigned char* ws = p.ws;
    constexpr int N0 = 324 * 8, N1 = N0 + 32 * 8, N2 = N1 + 32 * 16, N3 = N2 + 32 * 8, N4 = N3 + 176 * 8, N5 = N4 + 32 * 22;
    for (int it = blockIdx.x; it < N5; it += gridDim.x) {
        if (it < N0)      { const int i = it, nt = i / 8, kt = i % 8;
            if (nt < 96 || nt >= 160) conv_tile(tile, p.w_in, nullptr, IN_COLS, IN_COLS, DM, (bf16_t*)(ws + OFF_WIN), nullptr, 0, nt, kt);
            else conv_tile(tile, p.w_in + 6144, p.w_in + 8192, IN_COLS, IN_COLS, DM, (bf16_t*)(ws + OFF_WIN) + (size_t)24 * 256 * DM, nullptr, 1, nt - 96, kt); }
        else if (it < N1) { const int i = it - N0; conv_tile(tile, p.w_out_a, nullptr, DM, DM, DM, (bf16_t*)(ws + OFF_WOA), nullptr, 0, i / 8, i % 8); }
        else if (it < N2) { const int i = it - N1; conv_tile(tile, p.w_out_ssm, nullptr, DM, DM, DI, (bf16_t*)(ws + OFF_WOS), nullptr, 0, i / 16, i % 16); }
        else if (it < N3) { const int i = it - N2; conv_tile(tile, p.w_o, nullptr, DM, DM, DM, (bf16_t*)(ws + OFF_WO), nullptr, 0, i / 8, i % 8); }
        else if (it < N4) { const int i = it - N3; conv_tile(tile, p.w_ffn_gate, p.w_ffn_up, DFF, DFF, DM, (bf16_t*)(ws + OFF_WGU), p.norm_ffn_g, 1, i / 8, i % 8); }
        else              { const int i = it - N4; conv_tile(tile, p.w_ffn_down, nullptr, DM, DM, DFF, (bf16_t*)(ws + OFF_WDN), nullptr, 0, i / 22, i % 22); }
    }
    { float* s1 = (float*)(ws + OFF_SSQ1); for (int i = blockIdx.x * 512 + threadIdx.x; i < 2 * NTOK; i += gridDim.x * 512) s1[i] = 0.f; }
    { const int wave = threadIdx.x >> 6, lane = threadIdx.x & 63; bf16_t* U = (bf16_t*)(ws + OFF_U);
      for (int row = (blockIdx.x * 8 + wave) * 2; row < NTOK; row += gridDim.x * 16) {
          const f32x4* xr = (const f32x4*)(p.x + (size_t)row * DM); f32x4 v[16]; float ss0 = 0.f, ss1 = 0.f;
#pragma unroll
          for (int i = 0; i < 16; ++i) v[i] = xr[lane + 64 * i];
#pragma unroll
          for (int i = 0; i < 8; ++i) { ss0 += v[i][0] * v[i][0] + v[i][1] * v[i][1] + v[i][2] * v[i][2] + v[i][3] * v[i][3]; ss1 += v[8 + i][0] * v[8 + i][0] + v[8 + i][1] * v[8 + i][1] + v[8 + i][2] * v[8 + i][2] + v[8 + i][3] * v[8 + i][3]; }
#pragma unroll
          for (int o = 32; o >= 1; o >>= 1) { ss0 += __shfl_xor(ss0, o); ss1 += __shfl_xor(ss1, o); }
          const float r0 = rsqrtf(ss0 * (1.0f / DM) + EPS), r1 = rsqrtf(ss1 * (1.0f / DM) + EPS);
#pragma unroll
          for (int i = 0; i < 16; ++i) { const float r = i < 8 ? r0 : r1; const f32x4 gg = ((const f32x4*)p.norm_mix_g)[lane + 64 * (i & 7)]; u32x2 w; w.x = pk2(v[i][0] * r * gg[0], v[i][1] * r * gg[1]); w.y = pk2(v[i][2] * r * gg[2], v[i][3] * r * gg[3]);
              *(u32x2*)(U + (size_t)row * DM + (lane + 64 * i) * 4) = w; } } }
}

__device__ __forceinline__ void ssmconv_load(const bf16_t* XBC, int idx, u32x4 (&raw)[11]) {
    const int t0 = (idx / 768) * 8, c = (idx % 768) * 8; const bool first = (t0 & (SEQ - 1)) == 0;
#pragma unroll
    for (int r = 0; r < 11; ++r) raw[r] = (r < 3 && first) ? (u32x4){0u, 0u, 0u, 0u} : *(const u32x4*)(XBC + (size_t)(t0 - 3 + r) * CONVD + c);
}
__device__ __forceinline__ void ssmconv_compute(const Params& p, bf16_t* XS, bf16_t* BCS, int idx, const u32x4 (&raw)[11]) {
    const int t0 = (idx / 768) * 8, c = (idx % 768) * 8;
    f32x4 w0[4], w1[4];
#pragma unroll
    for (int j = 0; j < 4; ++j) { w0[j] = *(const f32x4*)(p.ssm_conv_w + j * CONVD + c); w1[j] = *(const f32x4*)(p.ssm_conv_w + j * CONVD + c + 4); }
    const f32x4 b0 = *(const f32x4*)(p.ssm_conv_b + c), b1 = *(const f32x4*)(p.ssm_conv_b + c + 4);
    bf16_t* dst = (c < DI) ? XS + (size_t)t0 * DI + c : BCS + (size_t)t0 * 2048 + (c - DI); const int ldd = (c < DI) ? DI : 2048;
#pragma unroll
    for (int i = 0; i < 8; ++i) { f32x4 a0 = b0, a1 = b1;
#pragma unroll
        for (int j = 0; j < 4; ++j) { f32x4 r0, r1; unpack8(raw[i + j], r0, r1); a0 += w0[j] * r0; a1 += w1[j] * r1; }
#pragma unroll
        for (int j = 0; j < 4; ++j) { a0[j] = siluf_(a0[j]); a1[j] = siluf_(a1[j]); }
        *(u32x4*)(dst + (size_t)i * ldd) = pack8(a0, a1); }
}
__device__ __forceinline__ void phase_ssmconv(const Params& p) {
    const bf16_t* XBC = (const bf16_t*)(p.ws + OFF_XBC); bf16_t* XS = (bf16_t*)p.out; bf16_t* BCS = (bf16_t*)(p.ws + OFF_BCS);
    const int total = (NTOK / 8) * 768, stride = gridDim.x * 512;
    int idx = blockIdx.x * 512 + threadIdx.x;
    u32x4 ra[11], rb[11];
    if (idx < total) ssmconv_load(XBC, idx, ra);
    while (idx < total) {
        const int i1 = idx + stride, i2 = idx + 2 * stride;
        if (i1 < total) ssmconv_load(XBC, i1, rb);
        ssmconv_compute(p, XS, BCS, idx, ra);
        if (i1 >= total) break;
        if (i2 < total) ssmconv_load(XBC, i2, ra);
        ssmconv_compute(p, XS, BCS, i1, rb);
        idx = i2;
    }
}

__device__ __forceinline__ void phase_ssd_seq(const Params& p, LAS unsigned char* lds) {
    LAS float* part = (LAS float*)lds;
    const int tid = threadIdx.x, pp = tid >> 3, ng = tid & 7, wave = tid >> 6, lane = tid & 63;
    const bf16_t* XS = (const bf16_t*)p.out; const bf16_t* BCS = (const bf16_t*)(p.ws + OFF_BCS); bf16_t* ZS = (bf16_t*)(p.ws + OFF_ZS);
    const float* DT = (const float*)(p.ws + OFF_DT); float* SSQH = (float*)(p.ws + OFF_SSQH);
    for (int item = blockIdx.x; item < 256; item += gridDim.x) {
        const int b = item >> 6, h = item & 63, g = h >> 3;
        const float a = -__expf(p.a_log[h]), Dk = p.d_skip[h];
        const bf16_t* xs = XS + (size_t)b * SEQ * DI + h * 64 + pp;
        const bf16_t* Bs = BCS + (size_t)b * SEQ * 2048 + g * 128 + ng * 16;
        const bf16_t* Cs = Bs + 1024;
        bf16_t* zs = ZS + (size_t)b * SEQ * DI + h * 64 + pp;
        const float* dt = DT + (size_t)b * SEQ * NH + h;
        float st[16];
#pragma unroll
        for (int i = 0; i < 16; ++i) st[i] = 0.f;
        for (int t0 = 0; t0 < SEQ; t0 += 64) {
#pragma unroll 4
            for (int tt = 0; tt < 64; ++tt) {
                const int t = t0 + tt;
                const float dtv = dt[(size_t)t * NH], xv = bf2f(xs[(size_t)t * DI]), zv = bf2f(zs[(size_t)t * DI]);
                f32x4 B0, B1, B2, B3, C0, C1, C2, C3;
                unpack8(*(const u32x4*)(Bs + (size_t)t * 2048), B0, B1); unpack8(*(const u32x4*)(Bs + (size_t)t * 2048 + 8), B2, B3);
                unpack8(*(const u32x4*)(Cs + (size_t)t * 2048), C0, C1); unpack8(*(const u32x4*)(Cs + (size_t)t * 2048 + 8), C2, C3);
                const float dA = __expf(dtv * a), xdt = xv * dtv; float y = 0.f;
#pragma unroll
                for (int i = 0; i < 4; ++i) {
                    st[i] = dA * st[i] + xdt * B0[i]; y += C0[i] * st[i];
                    st[4 + i] = dA * st[4 + i] + xdt * B1[i]; y += C1[i] * st[4 + i];
                    st[8 + i] = dA * st[8 + i] + xdt * B2[i]; y += C2[i] * st[8 + i];
                    st[12 + i] = dA * st[12 + i] + xdt * B3[i]; y += C3[i] * st[12 + i]; }
                y += __shfl_xor(y, 1); y += __shfl_xor(y, 2); y += __shfl_xor(y, 4);
                y += Dk * xv;
                const float yz = y * zv;
                if (ng == 0) zs[(size_t)t * DI] = (bf16_t)f2bf(yz);
                float sq = (ng == 0) ? yz * yz : 0.f;
                sq += __shfl_xor(sq, 8); sq += __shfl_xor(sq, 16); sq += __shfl_xor(sq, 32);
                if (lane == 0) part[tt * 8 + wave] = sq;
            }
            __syncthreads();
            if (tid < 64) { float s = 0.f;
#pragma unroll
                for (int w = 0; w < 8; ++w) s += part[tid * 8 + w];
                SSQH[(size_t)(b * SEQ + t0 + tid) * NH + h] = s; }
            __syncthreads();
        }
    }
}

typedef short s16x4 __attribute__((ext_vector_type(4)));
constexpr int SS_RSB = 272, SS_RSX = 144;
constexpr int SS_C = 0, SS_B = 34816, SS_X = 69632, SS_XW = 88064, SS_S = 106496, SS_SC = 123904, SS_M = 125952, SS_END = 160768;
__device__ __forceinline__ bf16x8 tr_frag(LAS unsigned char* lds, int addr, int step) {
    const s16x4 lo = __builtin_amdgcn_ds_read_tr16_b64_v4i16((LAS s16x4*)(lds + addr));
    const s16x4 hi = __builtin_amdgcn_ds_read_tr16_b64_v4i16((LAS s16x4*)(lds + addr + step));
    return __builtin_shufflevector(lo, hi, 0, 1, 2, 3, 4, 5, 6, 7);
}
#define MFMA16(a, b, c) __builtin_amdgcn_mfma_f32_16x16x32_bf16(a, b, c, 0, 0, 0)
#define WG_BAR() do { asm volatile("s_waitcnt lgkmcnt(0)" ::: "memory"); __builtin_amdgcn_s_barrier(); asm volatile("" ::: "memory"); } while (0)
__device__ __forceinline__ void phase_ssd_chunk(const Params& p, LAS unsigned char* lds) {
    const int tid = threadIdx.x, w = __builtin_amdgcn_readfirstlane(tid >> 6), lane = tid & 63, fr = lane & 15, g4 = lane >> 4, q = fr >> 2, pq = fr & 3;
    const bf16_t* XS = (const bf16_t*)p.out; const bf16_t* BCS = (const bf16_t*)(p.ws + OFF_BCS); bf16_t* ZS = (bf16_t*)(p.ws + OFF_ZS);
    const float* DT = (const float*)(p.ws + OFF_DT); float* SSQH = (float*)(p.ws + OFF_SSQH);
    LAS float* scal = (LAS float*)(lds + SS_SC);
    const int l = 16 * w + fr;
    for (int item = blockIdx.x; item < 256; item += gridDim.x) {
        const int b = item >> 6, grp = item & 7, h = grp * 8 + ((item >> 3) & 7);
        const float a = -__expf(p.a_log[h]), Dk = p.d_skip[h];
        f32x4 accS[4];
#pragma unroll
        for (int i = 0; i < 4; ++i) accS[i] = (f32x4){0.f, 0.f, 0.f, 0.f};
        u32x4 pb[4], pc[4], px[2]; float d0 = 0.f, d1 = 0.f;
        const bf16_t* bsrc = BCS + (size_t)(b * SEQ + (tid >> 4)) * 2048 + grp * 128 + (tid & 15) * 8;
        const bf16_t* xsrc = XS + (size_t)(b * SEQ + (tid >> 3)) * DI + h * 64 + (tid & 7) * 8;
        const float* dsrc = DT + (size_t)(b * SEQ + lane) * NH + h;
#define SSD_PREFETCH(c_) do { const size_t ro_ = (size_t)(c_) * 128; \
            _Pragma("unroll") for (int i = 0; i < 4; ++i) { pb[i] = *(const u32x4*)(bsrc + (ro_ + 32 * i) * 2048); pc[i] = *(const u32x4*)(bsrc + (ro_ + 32 * i) * 2048 + 1024); } \
            _Pragma("unroll") for (int i = 0; i < 2; ++i) px[i] = *(const u32x4*)(xsrc + (ro_ + 64 * i) * DI); \
            if (w == 0) { d0 = dsrc[ro_ * NH]; d1 = dsrc[(ro_ + 64) * NH]; } } while (0)
#define SSD_SCAN(buf_) do { if (w == 0) { float s0 = d0 * a, s1 = d1 * a; \
            _Pragma("unroll") for (int o = 1; o < 64; o <<= 1) { const float t0 = __shfl_up(s0, o), t1 = __shfl_up(s1, o); if (lane >= o) { s0 += t0; s1 += t1; } } \
            s1 += __shfl(s0, 63); LAS float* cs_ = scal + (buf_) * 256; cs_[lane] = s0; cs_[64 + lane] = s1; cs_[128 + lane] = d0; cs_[192 + lane] = d1; } } while (0)
        SSD_PREFETCH(0);
        for (int i = tid; i < 64 * SS_RSB / 16; i += 512) *(LAS u32x4*)(lds + SS_S + i * 16) = (u32x4){0u, 0u, 0u, 0u};
        SSD_SCAN(0);
        WG_BAR();
        for (int c = 0; c < 32; ++c) {
            const int tok0 = b * SEQ + c * 128;
            LAS float* csA = scal + (c & 1) * 256; LAS float* dtA = csA + 128;
            const float csend = csA[127];
#pragma unroll
            for (int i = 0; i < 4; ++i) { const int row = (tid >> 4) + 32 * i, ch = tid & 15; *(LAS u32x4*)(lds + SS_B + row * SS_RSB + ch * 16) = pb[i]; *(LAS u32x4*)(lds + SS_C + row * SS_RSB + ch * 16) = pc[i]; }
#pragma unroll
            for (int i = 0; i < 2; ++i) { const int row = (tid >> 3) + 64 * i, ch = tid & 7; *(LAS u32x4*)(lds + SS_X + row * SS_RSX + ch * 16) = px[i];
                const float wl = __expf(csend - csA[row]) * dtA[row]; f32x4 v0, v1; unpack8(px[i], v0, v1); v0 *= wl; v1 *= wl; *(LAS u32x4*)(lds + SS_XW + row * SS_RSX + ch * 16) = pack8(v0, v1); }
            WG_BAR();
            if (c + 1 < 32) SSD_PREFETCH(c + 1);
            const size_t tok = (size_t)(tok0 + l);
            bf16_t* zp = ZS + tok * DI + h * 64 + 4 * g4;
            u32x2 z2[4];
#pragma unroll
            for (int pt = 0; pt < 4; ++pt) z2[pt] = *(const u32x2*)(zp + 16 * pt);
            const float csl = csA[l];
            bf16x8 cf[4];
#pragma unroll
            for (int ks = 0; ks < 4; ++ks) cf[ks] = *(const LAS bf16x8*)(lds + SS_C + l * SS_RSB + (4 * ks + g4) * 16);
            f32x4 accY[4];
            { bf16x8 sf[4][4];
#pragma unroll
              for (int pt = 0; pt < 4; ++pt)
#pragma unroll
                  for (int ks = 0; ks < 4; ++ks) sf[pt][ks] = *(const LAS bf16x8*)(lds + SS_S + (16 * pt + fr) * SS_RSB + (4 * ks + g4) * 16);
#pragma unroll
              for (int pt = 0; pt < 4; ++pt) accY[pt] = (f32x4){0.f, 0.f, 0.f, 0.f};
#pragma unroll
              for (int ks = 0; ks < 4; ++ks)
#pragma unroll
                  for (int pt = 0; pt < 4; ++pt) accY[pt] = MFMA16(sf[pt][ks], cf[ks], accY[pt]);
              const float el = __expf(csl);
#pragma unroll
              for (int pt = 0; pt < 4; ++pt) accY[pt] *= el; }
#pragma unroll
            for (int sp = 0; sp < 4; ++sp) {
                if (2 * sp <= w) {
                    bf16x8 bfr[2][4];
#pragma unroll
                    for (int e = 0; e < 2; ++e)
#pragma unroll
                        for (int ks = 0; ks < 4; ++ks) bfr[e][ks] = *(const LAS bf16x8*)(lds + SS_B + (16 * (2 * sp + e) + fr) * SS_RSB + (4 * ks + g4) * 16);
                    f32x4 cs4[2], dt4[2];
#pragma unroll
                    for (int e = 0; e < 2; ++e) { cs4[e] = *(const LAS f32x4*)(csA + 16 * (2 * sp + e) + 4 * g4); dt4[e] = *(const LAS f32x4*)(dtA + 16 * (2 * sp + e) + 4 * g4); }
                    f32x4 a1[2] = {(f32x4){0.f, 0.f, 0.f, 0.f}, (f32x4){0.f, 0.f, 0.f, 0.f}};
#pragma unroll
                    for (int ks = 0; ks < 4; ++ks)
#pragma unroll
                        for (int e = 0; e < 2; ++e) a1[e] = MFMA16(bfr[e][ks], cf[ks], a1[e]);
#pragma unroll
                    for (int e = 0; e < 2; ++e) { float v[4];
#pragma unroll
                        for (int r = 0; r < 4; ++r) { const int s = 16 * (2 * sp + e) + 4 * g4 + r; const float t = a1[e][r] * __expf(fminf(csl - cs4[e][r], 0.f)) * dt4[e][r]; v[r] = (s <= l) ? t : 0.f; }
                        u32x2 pk; pk.x = pk2(v[0], v[1]); pk.y = pk2(v[2], v[3]); *(LAS u32x2*)(lds + SS_M + l * SS_RSB + (16 * (2 * sp + e) + 4 * g4) * 2) = pk; } } }
            { const float dec = __expf(csend);
#pragma unroll
              for (int pt = 0; pt < 4; ++pt) accS[pt] *= dec;
#pragma unroll
              for (int kp = 0; kp < 2; ++kp) { bf16x8 btf[2], xwf[2][4];
#pragma unroll
                  for (int e = 0; e < 2; ++e) { const int ks = 2 * kp + e; btf[e] = tr_frag(lds, SS_B + (32 * ks + 8 * g4 + q) * SS_RSB + (16 * w + 4 * pq) * 2, 4 * SS_RSB);
#pragma unroll
                      for (int pt = 0; pt < 4; ++pt) xwf[e][pt] = tr_frag(lds, SS_XW + (32 * ks + 8 * g4 + q) * SS_RSX + (16 * pt + 4 * pq) * 2, 4 * SS_RSX); }
#pragma unroll
                  for (int e = 0; e < 2; ++e)
#pragma unroll
                      for (int pt = 0; pt < 4; ++pt) accS[pt] = MFMA16(btf[e], xwf[e][pt], accS[pt]); } }
            if (c + 1 < 32) SSD_SCAN((c + 1) & 1);
#pragma unroll
            for (int ks = 0; ks < 4; ++ks) { if (2 * ks <= w) { const bf16x8 mf = *(const LAS bf16x8*)(lds + SS_M + l * SS_RSB + (4 * ks + g4) * 16); bf16x8 xf[4];
#pragma unroll
                for (int pt = 0; pt < 4; ++pt) xf[pt] = tr_frag(lds, SS_X + (32 * ks + 8 * g4 + q) * SS_RSX + (16 * pt + 4 * pq) * 2, 4 * SS_RSX);
#pragma unroll
                for (int pt = 0; pt < 4; ++pt) accY[pt] = MFMA16(xf[pt], mf, accY[pt]); } }
            { float sq = 0.f;
#pragma unroll
              for (int pt = 0; pt < 4; ++pt) { const u32x2 x2 = *(const LAS u32x2*)(lds + SS_X + l * SS_RSX + (16 * pt + 4 * g4) * 2);
                  const float y0 = (accY[pt][0] + Dk * bflo(x2.x)) * bflo(z2[pt].x), y1 = (accY[pt][1] + Dk * bfhi(x2.x)) * bfhi(z2[pt].x), y2 = (accY[pt][2] + Dk * bflo(x2.y)) * bflo(z2[pt].y), y3 = (accY[pt][3] + Dk * bfhi(x2.y)) * bfhi(z2[pt].y);
                  sq += y0 * y0 + y1 * y1 + y2 * y2 + y3 * y3; u32x2 o; o.x = pk2(y0, y1); o.y = pk2(y2, y3); *(u32x2*)(zp + 16 * pt) = o; }
              sq += __shfl_xor(sq, 16); sq += __shfl_xor(sq, 32);
              if (g4 == 0) SSQH[tok * NH + h] = sq; }
            WG_BAR();
#pragma unroll
            for (int pt = 0; pt < 4; ++pt) { u32x2 pk; pk.x = pk2(accS[pt][0], accS[pt][1]); pk.y = pk2(accS[pt][2], accS[pt][3]); *(LAS u32x2*)(lds + SS_S + (16 * pt + fr) * SS_RSB + (16 * w + 4 * g4) * 2) = pk; }
        }
        WG_BAR();
#undef SSD_PREFETCH
#undef SSD_SCAN
    }
}

__device__ __forceinline__ void phase_gnorm(const Params& p) {
    bf16_t* ZS = (bf16_t*)(p.ws + OFF_ZS); const float* SSQH = (const float*)(p.ws + OFF_SSQH);
    const int total = NTOK * 512 / 4;
    for (int idx = blockIdx.x * 512 + threadIdx.x; idx < total; idx += gridDim.x * 512) {
        const int t0 = (idx >> 9) * 4, cg8 = idx & 511, c = cg8 * 8, g = cg8 >> 6;
        u32x4 raw[4]; f32x4 s0[4], s1[4];
#pragma unroll
        for (int i = 0; i < 4; ++i) { raw[i] = *(const u32x4*)(ZS + (size_t)(t0 + i) * DI + c); s0[i] = *(const f32x4*)(SSQH + (size_t)(t0 + i) * NH + g * 8); s1[i] = *(const f32x4*)(SSQH + (size_t)(t0 + i) * NH + g * 8 + 4); }
        const f32x4 g0 = *(const f32x4*)(p.ssm_norm_g + c), g1 = *(const f32x4*)(p.ssm_norm_g + c + 4);
#pragma unroll
        for (int i = 0; i < 4; ++i) { const float ss = s0[i][0] + s0[i][1] + s0[i][2] + s0[i][3] + s1[i][0] + s1[i][1] + s1[i][2] + s1[i][3]; const float r = rsqrtf(ss * (1.0f / 512.0f) + EPS);
            f32x4 v0, v1; unpack8(raw[i], v0, v1); v0 = v0 * r * g0; v1 = v1 * r * g1; *(u32x4*)(ZS + (size_t)(t0 + i) * DI + c) = pack8(v0, v1); }
    }
}

__device__ __forceinline__ void phase_mixa(const Params& p) {
    const bf16_t* BB = (const bf16_t*)(p.ws + OFF_BB); const bf16_t* CH = (const bf16_t*)(p.ws + OFF_BC); bf16_t* YA = (bf16_t*)(p.ws + OFF_U);
    constexpr int TS = 8; const int total = (NTOK / TS) * 256;
    for (int idx = blockIdx.x * 512 + threadIdx.x; idx < total; idx += gridDim.x * 512) {
        const int t0 = (idx >> 8) * TS, c = (idx & 255) * 8; const bool first = (t0 & (SEQ - 1)) == 0;
        u32x4 rq[TS + 2], rb[TS];
#pragma unroll
        for (int r = 0; r < TS + 2; ++r) rq[r] = (r < 2 && first) ? (u32x4){0u, 0u, 0u, 0u} : *(const u32x4*)(CH + (size_t)(t0 - 2 + r) * DM + c);
#pragma unroll
        for (int i = 0; i < TS; ++i) rb[i] = *(const u32x4*)(BB + (size_t)(t0 + i) * DM + c);
        f32x4 w0[3], w1[3];
#pragma unroll
        for (int j = 0; j < 3; ++j) { w0[j] = *(const f32x4*)(p.conv_a_w + j * DM + c); w1[j] = *(const f32x4*)(p.conv_a_w + j * DM + c + 4); }
        f32x4 q0[3], q1[3];
#pragma unroll
        for (int r = 0; r < 2; ++r) unpack8(rq[r], q0[r], q1[r]);
#pragma unroll
        for (int i = 0; i < TS; ++i) { unpack8(rq[i + 2], q0[2], q1[2]);
            f32x4 a0 = w0[0] * q0[0] + w0[1] * q0[1] + w0[2] * q0[2], a1 = w1[0] * q1[0] + w1[1] * q1[1] + w1[2] * q1[2];
            f32x4 b0, b1; unpack8(rb[i], b0, b1);
            *(u32x4*)(YA + (size_t)(t0 + i) * DM + c) = pack8(a0 * b0, a1 * b1);
            q0[0] = q0[1]; q0[1] = q0[2]; q1[0] = q1[1]; q1[1] = q1[2]; }
    }
}

__device__ __forceinline__ void phase_final(const Params& p) {
    const float* SSQ2 = (const float*)(p.ws + OFF_SSQ2); const bf16_t* H2 = (const bf16_t*)(p.ws + OFF_BB);
    const int total = NTOK * 256 / 4;
    for (int idx = blockIdx.x * 512 + threadIdx.x; idx < total; idx += gridDim.x * 512) {
        const int t0 = (idx >> 8) * 4, c = (idx & 255) * 8;
        u32x4 v[4]; float r[4];
#pragma unroll
        for (int i = 0; i < 4; ++i) { v[i] = *(const u32x4*)(H2 + (size_t)(t0 + i) * DM + c); r[i] = SSQ2[t0 + i]; }
        const f32x4 g0 = *(const f32x4*)(p.norm_final_g + c), g1 = *(const f32x4*)(p.norm_final_g + c + 4);
#pragma unroll
        for (int i = 0; i < 4; ++i) { const float rr = rsqrtf(r[i] * (1.0f / DM) + EPS); f32x4 a0, a1; unpack8(v[i], a0, a1);
            *(f32x4*)(p.out + (size_t)(t0 + i) * DM + c) = a0 * rr * g0; *(f32x4*)(p.out + (size_t)(t0 + i) * DM + c + 4) = a1 * rr * g1; }
    }
}

#define XB_TMO      128
#define XB_XCNT(j)  (256  + 64 * (j))
#define XB_XSUB(j)  (1280 + 64 * (j))
#define XB_XGEN(j)  (2304 + 64 * (j))
#define XB_TOP      3328
#define XB_TOPGEN   3392
#define XCD_BAR_WORDS 3456
#define XB_SPIN_CAP (1u << 18)

__device__ __forceinline__ unsigned xb_ld(unsigned* p)              { return __hip_atomic_load(p, __ATOMIC_RELAXED, __HIP_MEMORY_SCOPE_AGENT); }
__device__ __forceinline__ unsigned xb_add(unsigned* p, unsigned v) { return __hip_atomic_fetch_add(p, v, __ATOMIC_RELAXED, __HIP_MEMORY_SCOPE_AGENT); }
__device__ __forceinline__ unsigned xb_xcc_id() { return (unsigned)__builtin_amdgcn_s_getreg((3 << 11) | 20) & 0xFu; }
#define XB_SPIN(cond, bar) do { unsigned _sp = 0; while (cond) { __builtin_amdgcn_s_sleep(1); \
    if ((++_sp & 255u) == 0u) { if (xb_ld(&(bar)[XB_TMO])) break; if (_sp > XB_SPIN_CAP) { atomicAdd(&(bar)[XB_TMO], 1u); break; } } } } while (0)

struct XcdBarrier {
    unsigned* bar; unsigned x;
    volatile LAS unsigned* st;
};

__device__ __forceinline__ XcdBarrier xcd_barrier_post(unsigned* bar, volatile LAS unsigned* st) {
    XcdBarrier b; b.bar = bar; b.x = xb_xcc_id(); b.st = st;
    if (threadIdx.x == 0) (void)xb_add(&bar[XB_XCNT(b.x)], 1u);
    return b;
}
__device__ __forceinline__ void xcd_barrier_complete(unsigned* bar, unsigned x, unsigned& nloc, unsigned& nx) {
    const unsigned G = gridDim.x * gridDim.y * gridDim.z;
    unsigned sum, cnt, mine, sp = 0u;
    for (;;) {
        sum = 0u; cnt = 0u; mine = 0u;
#pragma unroll
        for (unsigned j = 0; j < 16; ++j) { const unsigned c = xb_ld(&bar[XB_XCNT(j)]); sum += c; cnt += (c > 0u) ? 1u : 0u; mine = (j == x) ? c : mine; }
        if (sum == G) break;
        __builtin_amdgcn_s_sleep(1);
        if ((++sp & 255u) == 0u) { if (xb_ld(&bar[XB_TMO])) break; if (sp > XB_SPIN_CAP) { atomicAdd(&bar[XB_TMO], 1u); break; } }
    }
    nloc = mine > 0u ? mine : 1u; nx = cnt > 0u ? cnt : 1u;
}

__device__ __forceinline__ void xcd_barrier(const XcdBarrier& b) {
    asm volatile("s_waitcnt vmcnt(0)" ::: "memory");
    __syncthreads();
    if (threadIdx.x == 0) {
        unsigned* bar = b.bar;
        __builtin_amdgcn_s_waitcnt(0);
        unsigned nloc = b.st[0], nx = b.st[1];
        if (nloc == 0u) { xcd_barrier_complete(bar, b.x, nloc, nx); b.st[0] = nloc; b.st[1] = nx; }
        const unsigned old = xb_add(&bar[XB_XSUB(b.x)], 1u);
        const unsigned gen = old / nloc;
        if (old + 1u == (gen + 1u) * nloc) {
            __builtin_amdgcn_fence(__ATOMIC_RELEASE, "agent");
            asm volatile("s_waitcnt vmcnt(0)" ::: "memory");
            const unsigned og = xb_add(&bar[XB_TOP], 1u);
            const unsigned tg = og / nx;
            if (og + 1u == (tg + 1u) * nx) xb_add(&bar[XB_TOPGEN], 1u);
            else XB_SPIN(xb_ld(&bar[XB_TOPGEN]) == tg, bar);
            __builtin_amdgcn_fence(__ATOMIC_ACQUIRE, "agent");
            xb_add(&bar[XB_XGEN(b.x)], 1u);
            asm volatile("s_waitcnt vmcnt(0)" ::: "memory");
        } else {
            XB_SPIN(xb_ld(&bar[XB_XGEN(b.x)]) == gen, bar);
            __builtin_amdgcn_fence(__ATOMIC_ACQUIRE, "agent");
            asm volatile("s_waitcnt vmcnt(0)" ::: "memory");
        }
    }
    __syncthreads();
}

constexpr int NPHASE = 11;
template <int PH> __device__ __forceinline__ void run_phase(const Params& p, LAS unsigned char* lds) {
    unsigned char* ws = p.ws;
    pg8::StaticOrder S; pg8::Gemm g;
    if constexpr (PH == 0) { phase_prep(p, lds); }
    else if constexpr (PH == 1) {
        g.A = (const bf16_t*)(ws + OFF_U); g.Bt = (const bf16_t*)(ws + OFF_WIN) + (size_t)40 * 256 * DM; g.M = NTOK; g.N = 41 * 256; g.K = DM; S.init(g.M, g.N, gridDim.x, blockIdx.x);
        EpiRoute E{(bf16_t*)p.out, (bf16_t*)p.out + (size_t)NTOK * DM, (bf16_t*)(ws + OFF_BB), (bf16_t*)(ws + OFF_BC), (bf16_t*)(ws + OFF_BH), (bf16_t*)(ws + OFF_ZS), (bf16_t*)(ws + OFF_XBC), (float*)(ws + OFF_DT), p.dt_bias, 40};
        pg8::gemm_phase(lds, g, S, E); }
    else if constexpr (PH == 2) { phase_ssmconv(p); }
    else if constexpr (PH == 3) { phase_ssd_chunk(p, lds); }
    else if constexpr (PH == 4) {
        g.A = (const bf16_t*)(ws + OFF_U); g.Bt = (const bf16_t*)(ws + OFF_WIN); g.M = NTOK; g.N = 40 * 256; g.K = DM; S.init(g.M, g.N, gridDim.x, blockIdx.x);
        EpiRoute E{(bf16_t*)p.out, (bf16_t*)p.out + (size_t)NTOK * DM, (bf16_t*)(ws + OFF_BB), (bf16_t*)(ws + OFF_BC), (bf16_t*)(ws + OFF_BH), (bf16_t*)(ws + OFF_ZS), (bf16_t*)(ws + OFF_XBC), (float*)(ws + OFF_DT), p.dt_bias, 0};
        pg8::gemm_phase(lds, g, S, E);
        phase_gnorm(p); }
    else if constexpr (PH == 5) { phase_mixa(p); }
    else if constexpr (PH == 6) {
        g.A = (const bf16_t*)(ws + OFF_U); g.Bt = (const bf16_t*)(ws + OFF_WOA); g.M = NTOK; g.N = DM; g.K = DM; S.init(g.M, g.N, gridDim.x, blockIdx.x);
        EpiGate<false> Ea{(const bf16_t*)p.out, nullptr, (bf16_t*)(ws + OFF_BB)};
        pg8::gemm_phase(lds, g, S, Ea);
        g.A = (const bf16_t*)(ws + OFF_ZS); g.Bt = (const bf16_t*)(ws + OFF_WOS); g.K = DI;
        EpiGate<true> Eb{(const bf16_t*)p.out + (size_t)NTOK * DM, (const bf16_t*)(ws + OFF_BB), (bf16_t*)(ws + OFF_BC)};
        pg8::gemm_phase(lds, g, S, Eb); }
    else if constexpr (PH == 7) {
        g.A = (const bf16_t*)(ws + OFF_BC); g.Bt = (const bf16_t*)(ws + OFF_WO); g.M = NTOK; g.N = DM; g.K = DM; S.init(g.M, g.N, gridDim.x, blockIdx.x);
        EpiRes<false> E{p.x, (bf16_t*)(ws + OFF_BH), (float*)(ws + OFF_SSQ1)};
        pg8::gemm_phase(lds, g, S, E); }
    else if constexpr (PH == 8) {
        g.A = (const bf16_t*)(ws + OFF_BH); g.Bt = (const bf16_t*)(ws + OFF_WGU); g.M = NTOK; g.N = 2 * DFF; g.K = DM; S.init(g.M, g.N, gridDim.x, blockIdx.x);
        EpiSwiglu E{(const float*)(ws + OFF_SSQ1), (bf16_t*)(ws + OFF_ZS)};
        pg8::gemm_phase(lds, g, S, E); }
    else if constexpr (PH == 9) {
        g.A = (const bf16_t*)(ws + OFF_ZS); g.Bt = (const bf16_t*)(ws + OFF_WDN); g.M = NTOK; g.N = DM; g.K = DFF; S.init(g.M, g.N, gridDim.x, blockIdx.x);
        EpiRes<true> E{(const void*)(ws + OFF_BH), (bf16_t*)(ws + OFF_BB), (float*)(ws + OFF_SSQ2)};
        pg8::gemm_phase(lds, g, S, E); }
    else if constexpr (PH == 10) { phase_final(p); }
}

template <int PH> __global__ void __launch_bounds__(512, 2) k_one(Params p) {
    extern __shared__ __attribute__((aligned(16))) unsigned char lds_raw[];
    run_phase<PH>(p, (LAS unsigned char*)lds_raw);
}

#ifndef PROBE_MASK
#define PROBE_MASK 0
#endif
__global__ void __launch_bounds__(512, 2) k_mega(Params p) {
    extern __shared__ __attribute__((aligned(16))) unsigned char lds_raw[];
    LAS unsigned char* lds = (LAS unsigned char*)lds_raw;
    cg::grid_group grid = cg::this_grid();
    unsigned long long spin = 0, t0 = 0;
    volatile LAS unsigned* bst = (volatile LAS unsigned*)(lds + SS_END);
    if (threadIdx.x < 4) bst[threadIdx.x] = 0u;
    __syncthreads();
    const XcdBarrier xbar = xcd_barrier_post((unsigned*)(p.ws + OFF_BAR), bst);
#define PH_RUN(i, SYNC) do { if (PROBE_MASK) t0 = __builtin_amdgcn_s_memrealtime(); if (PROBE_KMASK && threadIdx.x == 0) *(LAS unsigned long long*)(lds + SS_END + 8) = 0ull; run_phase<i>(p, lds); if ((PROBE_KMASK & (1 << i)) && threadIdx.x == 0) spin += *(LAS unsigned long long*)(lds + SS_END + 8); if (SYNC == 1) grid.sync(); else if (SYNC == 2) xcd_barrier(xbar); \
        if (PROBE_MASK & (1 << i)) spin += __builtin_amdgcn_s_memrealtime() - t0; } while (0)
    PH_RUN(0, 1); PH_RUN(1, 2); PH_RUN(2, 2); PH_RUN(3, 2); PH_RUN(4, 2); PH_RUN(5, 2); PH_RUN(6, 2); PH_RUN(7, 2); PH_RUN(8, 2); PH_RUN(9, 2); PH_RUN(10, 0);
#ifdef PROBE_SYNCS
    for (int i = 0; i < PROBE_SYNCS; ++i) xcd_barrier(xbar);
#endif
    if ((PROBE_MASK || PROBE_KMASK) && blockIdx.x == 0) { t0 = __builtin_amdgcn_s_memrealtime(); while (__builtin_amdgcn_s_memrealtime() - t0 < spin) __builtin_amdgcn_s_sleep(8); }
}

constexpr int LDS_BYTES = SS_END + 16;

template <int PH> static void launch_one(const Params& p, int grid, hipStream_t stream) {
    static bool attr = false;
    if (!attr) { (void)hipFuncSetAttribute((const void*)k_one<PH>, hipFuncAttributeMaxDynamicSharedMemorySize, LDS_BYTES); attr = true; }
    hipLaunchKernelGGL(k_one<PH>, dim3(grid), dim3(512), LDS_BYTES, stream, p);
}

extern "C" void kernel_launch(void* const* d_in, const int* in_sizes, int n_in, void* d_out, int out_size, void* d_ws, size_t ws_size, hipStream_t stream) {
    static int grid = 0;
    if (grid == 0) {
        if (n_in != 18 || out_size != NTOK * DM || ws_size < WS_END) { fprintf(stderr, "kernel_launch: unexpected shapes: n_in %d out %d ws %zu (need %zu)\n", n_in, out_size, ws_size, (size_t)WS_END); grid = -1; return; }
        int dev = 0, cus = 0, per_cu = 0;
        (void)hipGetDevice(&dev); (void)hipDeviceGetAttribute(&cus, hipDeviceAttributeMultiprocessorCount, dev);
        (void)hipFuncSetAttribute((const void*)k_mega, hipFuncAttributeMaxDynamicSharedMemorySize, LDS_BYTES);
        (void)hipOccupancyMaxActiveBlocksPerMultiprocessor(&per_cu, (const void*)k_mega, 512, LDS_BYTES);
        if (per_cu < 1) { fprintf(stderr, "kernel_launch: occupancy query says %d blocks per CU\n", per_cu); per_cu = 1; }
        (void)hipGetLastError();
        grid = cus * per_cu;
        fprintf(stderr, "kernel_launch: cus %d per_cu %d grid %d ws %zu\n", cus, per_cu, grid, ws_size);
    }
    if (grid < 0) return;
    Params p{};
    const float** pp = (const float**)&p;
    for (int i = 0; i < 18; ++i) pp[i] = (const float*)d_in[i];
    p.out = (float*)d_out; p.ws = (unsigned char*)d_ws;
#if MEGA
    (void)hipMemsetAsync((unsigned char*)d_ws + OFF_BAR, 0, XCD_BAR_WORDS * 4, stream);
    void* args[] = {&p};
    hipError_t e = hipLaunchCooperativeKernel((const void*)k_mega, dim3(grid), dim3(512), args, LDS_BYTES, stream);
    if (e != hipSuccess) fprintf(stderr, "cooperative launch failed: %s (grid %d)\n", hipGetErrorString(e), grid);
#else
    launch_one<0>(p, grid, stream); launch_one<1>(p, grid, stream); launch_one<2>(p, grid, stream); launch_one<3>(p, grid, stream); launch_one<4>(p, grid, stream); launch_one<5>(p, grid, stream);
    launch_one<6>(p, grid, stream); launch_one<7>(p, grid, stream); launch_one<8>(p, grid, stream); launch_one<9>(p, grid, stream); launch_one<10>(p, grid, stream);
#endif
}
```

```cpp
#include <hip/hip_runtime.h>
#include <hip/hip_cooperative_groups.h>
#include <cstdio>
namespace cg = cooperative_groups;

#ifndef MEGA
#define MEGA 1
#endif

#define LAS __attribute__((address_space(3)))
typedef unsigned short bf16_t;
typedef short bf16x8 __attribute__((ext_vector_type(8)));
typedef float f32x4 __attribute__((ext_vector_type(4)));
typedef unsigned u32x4 __attribute__((ext_vector_type(4)));
typedef unsigned u32x2 __attribute__((ext_vector_type(2)));

constexpr int DM = 2048, NTOK = 16384, SEQ = 4096;
constexpr int IN_COLS = 20544, IN_TILES = 81;
constexpr int DI = 4096, NH = 64, HD = 64, NG = 8, NST = 128, CONVD = 6144;
constexpr int DFF = 5632;
constexpr float EPS = 1e-6f;

constexpr size_t MiB = 1024ull * 1024ull;
constexpr size_t OFF_WIN = 0;
constexpr size_t OFF_WOA = 81 * MiB;
constexpr size_t OFF_WOS = 89 * MiB;
constexpr size_t OFF_WO  = 105 * MiB;
constexpr size_t OFF_WGU = 113 * MiB;
constexpr size_t OFF_WDN = 157 * MiB;
constexpr size_t OFF_ZS  = 179 * MiB;
constexpr size_t OFF_U   = 307 * MiB;
constexpr size_t OFF_XBC = 371 * MiB;
constexpr size_t OFF_BB  = 371 * MiB, OFF_BC = 435 * MiB, OFF_BH = 499 * MiB;
constexpr size_t OFF_DT  = 563 * MiB;
constexpr size_t OFF_SSQH = 567 * MiB;
constexpr size_t OFF_SSQ1 = 571 * MiB;
constexpr size_t OFF_SSQ2 = 571 * MiB + 65536;
constexpr size_t OFF_BCS = 572 * MiB;
constexpr size_t OFF_BAR = 636 * MiB;
constexpr size_t WS_END = 637 * MiB;

struct Params {
    const float *x, *norm_mix_g, *w_in, *conv_a_w, *w_out_a, *ssm_conv_w, *ssm_conv_b, *dt_bias, *a_log, *d_skip, *ssm_norm_g, *w_out_ssm, *w_o, *norm_ffn_g, *w_ffn_gate, *w_ffn_up,
        *w_ffn_down, *norm_final_g;
    float* out; unsigned char* ws;
};

__device__ __forceinline__ unsigned f2bf(float f) { unsigned u = __builtin_bit_cast(unsigned, f); return (u + 0x7fffu + ((u >> 16) & 1u)) >> 16; }
__device__ __forceinline__ unsigned pk2(float lo, float hi) { unsigned r; asm("v_cvt_pk_bf16_f32 %0, %1, %2" : "=v"(r) : "v"(lo), "v"(hi)); return r; }
__device__ __forceinline__ float bflo(unsigned w) { return __builtin_bit_cast(float, w << 16); }
__device__ __forceinline__ float bfhi(unsigned w) { return __builtin_bit_cast(float, w & 0xffff0000u); }
__device__ __forceinline__ float bf2f(bf16_t v) { return __builtin_bit_cast(float, ((unsigned)v) << 16); }
__device__ __forceinline__ float sigmoidf_(float v) { return __builtin_amdgcn_rcpf(1.0f + __expf(-v)); }
__device__ __forceinline__ float siluf_(float v) { return v * sigmoidf_(v); }
__device__ __forceinline__ float softplusf_(float v) { return fmaxf(v, 0.f) + log1pf(__expf(-fabsf(v))); }
__device__ __forceinline__ u32x4 pack8(const f32x4& a, const f32x4& b) { u32x4 w; w.x = pk2(a[0], a[1]); w.y = pk2(a[2], a[3]); w.z = pk2(b[0], b[1]); w.w = pk2(b[2], b[3]); return w; }
__device__ __forceinline__ void unpack8(const u32x4& w, f32x4& a, f32x4& b) { a[0] = bflo(w.x); a[1] = bfhi(w.x); a[2] = bflo(w.y); a[3] = bfhi(w.y); b[0] = bflo(w.z); b[1] = bfhi(w.z); b[2] = bflo(w.w); b[3] = bfhi(w.w); }

#ifndef PROBE_KMASK
#define PROBE_KMASK 0
#endif
#ifndef STAGGER_TICKS
#define STAGGER_TICKS 0
#endif
namespace pg8 {
constexpr int BM = 256, BK = 64, HALF = 128, HTB = HALF * BK * 2, STAGE_BYTES = 8 * HTB, NXCD = 8, WGM = 8;
__host__ __device__ __forceinline__ int lds_byte(int r, int c) { const int st = (r >> 4) * 2 + (c >> 5), rr = r & 15, cc = c & 31, ob = rr * 64 + cc * 2; return st * 1024 + (ob ^ (((ob >> 9) & 1) << 5)); }
__host__ __device__ __forceinline__ void stage_rc(int b, int& R, int& C) { const int st = b / 1024, sb = b % 1024, swz = sb ^ (((sb >> 9) & 1) << 5); R = (st >> 1) * 16 + swz / 64; C = (st & 1) * 32 + (swz % 64) / 2; }
__host__ __device__ __forceinline__ int perm32(int rho) { const int n = rho >> 4, i = rho & 15; return 8 * (i >> 2) + 4 * n + (i & 3); }
struct Unit { int pm, pn; };
struct Gemm { const bf16_t* A; const bf16_t* Bt; int M, N, K; };
struct StaticOrder {
    int nM, nN, nwg, G, c;
    __host__ __device__ void init(int M, int N, int G_, int c_) { nM = M / BM; nN = N / BM; nwg = nM * nN; G = G_; c = c_; }
    __host__ __device__ bool next(int i, Unit& u) const {
        const long L = (long)i * G + c; if (L >= nwg) return false;
        int wgid = (int)L; { const int q = nwg / NXCD, r = nwg % NXCD, xcd = wgid % NXCD, off = wgid / NXCD; wgid = (xcd < r ? xcd * (q + 1) : r * (q + 1) + (xcd - r) * q) + off; }
        const int nig = WGM * nN, gid = wgid / nig, fm = gid * WGM, gsz = (nM - fm) < WGM ? (nM - fm) : WGM;
        u.pm = fm + ((wgid % nig) % gsz); u.pn = (wgid % nig) / gsz; return true;
    }
};

template <class Epi>
__device__ __forceinline__ void gemm_phase(LAS unsigned char* lds, const Gemm g, const StaticOrder& S, const Epi& E) {
    const int tid = threadIdx.x, wid = __builtin_amdgcn_readfirstlane(tid >> 6), lane = tid & 63, wr = wid >> 2, wc = wid & 3, fr = lane & 15, fq = lane >> 4;
    const int K = g.K, nt = K / BK;
    unsigned voffA[2];
#pragma unroll
    for (int i = 0; i < 2; ++i) { int R, C; stage_rc(tid * 16 + i * 8192, R, C); voffA[i] = (unsigned)(R * K + C) * 2u; }
    const size_t kstep = (size_t)(BK * 2);
    const size_t hstep = (size_t)HALF * K * 2;
    const size_t tstep = 2 * hstep;
    const unsigned ldsw = (unsigned)wid * 1024u;
    const int aoff = lds_byte(wr * 64 + fr, fq * 8), boff = lds_byte(wc * 32 + fr, fq * 8);
#define PG8_SA(b, h) (((b) * 2 + (h)) * HTB)
#define PG8_SB(b, h) ((4 + (b) * 2 + (h)) * HTB)
#define PG8_STAGE(bufoff, gbase, voff) do { _Pragma("unroll") for (int _i = 0; _i < 2; ++_i) \
        __builtin_amdgcn_global_load_lds((const unsigned*)((const char*)(gbase) + (voff)[_i]), (LAS unsigned*)(lds + (bufoff) + ldsw + _i * 8192), 16, 0, 0); } while (0)
#define PG8_LDA(dst, b, h) do { _Pragma("unroll") for (int m = 0; m < 4; ++m) _Pragma("unroll") for (int k = 0; k < 2; ++k) dst[m][k] = *(const LAS bf16x8*)(lds + PG8_SA(b, h) + aoff + m * 2048 + k * 1024); } while (0)
#define PG8_LDB(dst, b, h) do { _Pragma("unroll") for (int n = 0; n < 2; ++n) _Pragma("unroll") for (int k = 0; k < 2; ++k) dst[n][k] = *(const LAS bf16x8*)(lds + PG8_SB(b, h) + boff + n * 2048 + k * 1024); } while (0)
#define PG8_MMA(ai, bj, At, Bt) do { __builtin_amdgcn_s_setprio(1); _Pragma("unroll") for (int m = 0; m < 4; ++m) _Pragma("unroll") for (int n = 0; n < 2; ++n) _Pragma("unroll") for (int k = 0; k < 2; ++k) \
        acc[ai][bj][m][n] = __builtin_amdgcn_mfma_f32_16x16x32_bf16(Bt[n][k], At[m][k], acc[ai][bj][m][n], 0, 0, 0); __builtin_amdgcn_s_setprio(0); } while (0)
#define PG8_WAIT_V(n) asm volatile("s_waitcnt vmcnt(" #n ")" ::: "memory")
#define PG8_WAIT_L(n) asm volatile("s_waitcnt lgkmcnt(" #n ")" ::: "memory")
#define PG8_BAR __builtin_amdgcn_s_barrier()
#define PG8_SCHED __builtin_amdgcn_sched_barrier(0)
    Unit cur, nxt; int ui = 0;
    if (!S.next(0, cur)) return;
    if (STAGGER_TICKS) { const unsigned long long t0 = __builtin_amdgcn_s_memrealtime(), d = (unsigned long long)(blockIdx.x & 7) * STAGGER_TICKS; while (__builtin_amdgcn_s_memrealtime() - t0 < d) __builtin_amdgcn_s_sleep(4); }
    f32x4 acc[2][2][4][2];
#pragma unroll
    for (int a = 0; a < 2; ++a)
#pragma unroll
        for (int b = 0; b < 2; ++b)
#pragma unroll
            for (int m = 0; m < 4; ++m)
#pragma unroll
                for (int n = 0; n < 2; ++n) acc[a][b][m][n] = (f32x4){0.f, 0.f, 0.f, 0.f};
    bf16x8 At[4][2], B0[2][2], B1[2][2];
    const char* cA = (const char*)g.A + (size_t)cur.pm * tstep; const char* cB = (const char*)g.Bt + (size_t)cur.pn * tstep;
    PG8_STAGE(PG8_SB(0, 0), cB, voffA); PG8_STAGE(PG8_SA(0, 0), cA, voffA); PG8_STAGE(PG8_SB(0, 1), cB + hstep, voffA); PG8_STAGE(PG8_SA(0, 1), cA + hstep, voffA);
    if (wr == 1) PG8_BAR;
    PG8_WAIT_V(4); PG8_BAR;
    PG8_STAGE(PG8_SB(1, 0), cB + kstep, voffA); PG8_STAGE(PG8_SA(1, 0), cA + kstep, voffA); PG8_STAGE(PG8_SB(1, 1), cB + hstep + kstep, voffA);
    PG8_WAIT_V(6); PG8_BAR;
    for (;;) {
        const bool has_next = S.next(ui + 1, nxt);
        const char* nA = has_next ? (const char*)g.A + (size_t)nxt.pm * tstep : cA; const char* nB = has_next ? (const char*)g.Bt + (size_t)nxt.pn * tstep : cB;
        unsigned long long kt0_ = 0; if (PROBE_KMASK) kt0_ = __builtin_amdgcn_s_memrealtime();
        for (int t = 0; t < nt; t += 2) {
            const bool last = (t == nt - 2);
            const char* a1 = cA + (size_t)(t + 1) * kstep;
            const char* a2 = last ? nA : cA + (size_t)(t + 2) * kstep; const char* b2 = last ? nB : cB + (size_t)(t + 2) * kstep;
            const char* a3 = a2 + kstep; const char* b3 = b2 + kstep;
            PG8_LDB(B0, 0, 0); PG8_SCHED; PG8_LDA(At, 0, 0); PG8_STAGE(PG8_SA(1, 1), a1 + hstep, voffA);
            PG8_WAIT_L(8); PG8_BAR; PG8_WAIT_L(0); PG8_MMA(0, 0, At, B0); PG8_BAR; PG8_SCHED;
            PG8_LDB(B1, 0, 1); PG8_STAGE(PG8_SB(0, 0), b2, voffA);
            PG8_BAR; PG8_WAIT_L(0); PG8_MMA(0, 1, At, B1); PG8_BAR;
            PG8_LDA(At, 0, 1); PG8_STAGE(PG8_SA(0, 0), a2, voffA);
            PG8_BAR; PG8_WAIT_L(0); PG8_MMA(1, 0, At, B0); PG8_BAR; PG8_SCHED;
            PG8_STAGE(PG8_SB(0, 1), b2 + hstep, voffA);
            PG8_WAIT_V(6); PG8_BAR; PG8_MMA(1, 1, At, B1); PG8_BAR;
            PG8_LDB(B0, 1, 0); PG8_SCHED; PG8_LDA(At, 1, 0); PG8_STAGE(PG8_SA(0, 1), a2 + hstep, voffA);
            PG8_WAIT_L(8); PG8_BAR; PG8_WAIT_L(0); PG8_MMA(0, 0, At, B0); PG8_BAR; PG8_SCHED;
            PG8_LDB(B1, 1, 1); PG8_STAGE(PG8_SB(1, 0), b3, voffA);
            PG8_BAR; PG8_WAIT_L(0); PG8_MMA(0, 1, At, B1); PG8_BAR;
            PG8_LDA(At, 1, 1); PG8_STAGE(PG8_SA(1, 0), a3, voffA);
            PG8_BAR; PG8_WAIT_L(0); PG8_MMA(1, 0, At, B0); PG8_BAR; PG8_SCHED;
            PG8_STAGE(PG8_SB(1, 1), b3 + hstep, voffA);
            PG8_WAIT_V(6); PG8_BAR; PG8_MMA(1, 1, At, B1); PG8_BAR;
        }
        if (PROBE_KMASK && tid == 0) *(LAS unsigned long long*)(lds + 160768 + 8) += __builtin_amdgcn_s_memrealtime() - kt0_;
        E(acc, cur, wr, wc, fr, fq);
        if (!has_next) break;
#pragma unroll
        for (int a = 0; a < 2; ++a)
#pragma unroll
            for (int b = 0; b < 2; ++b)
#pragma unroll
                for (int m = 0; m < 4; ++m)
#pragma unroll
                    for (int n = 0; n < 2; ++n) acc[a][b][m][n] = (f32x4){0.f, 0.f, 0.f, 0.f};
        cur = nxt; cA = nA; cB = nB; ++ui;
    }
    PG8_WAIT_V(0);
    if (wr == 0) PG8_BAR;
    PG8_BAR;
#undef PG8_SA
#undef PG8_SB
#undef PG8_STAGE
#undef PG8_LDA
#undef PG8_LDB
#undef PG8_MMA
#undef PG8_WAIT_V
#undef PG8_WAIT_L
#undef PG8_BAR
#undef PG8_SCHED
}
}
using pg8::Unit;

struct EpiRoute {
    bf16_t *GA, *GB, *BB, *BC, *BH, *ZS, *XBC; float* DT; const float* dt_bias; int tile0;
    __device__ __forceinline__ void operator()(const f32x4 (&acc)[2][2][4][2], const Unit& u, int wr, int wc, int fr, int fq) const {
        const int gt = u.pn + tile0; const int row0 = u.pm * 256 + wr * 64 + fr;
        if (gt >= 24 && gt < 40) {
            const int ch0 = (gt - 24) * 128 + wc * 32 + 8 * fq;
#pragma unroll
            for (int ai = 0; ai < 2; ++ai)
#pragma unroll
                for (int m = 0; m < 4; ++m) *(u32x4*)(BC + (size_t)(row0 + ai * 128 + m * 16) * DM + ch0) = pack8(acc[ai][0][m][0] * acc[ai][1][m][0], acc[ai][0][m][1] * acc[ai][1][m][1]);
        } else if (gt < 80) {
            bf16_t* base; int ldc, cb, act;
            if (gt < 40) { const int r = gt >> 3; base = (r == 0 ? GA : r == 1 ? GB : r == 2 ? BB : r == 3 ? BC : BH); ldc = DM; cb = (gt & 7) * 256; act = r < 2 ? 1 : 0; }
            else if (gt < 56) { base = ZS; ldc = DI; cb = (gt - 40) * 256; act = 2; }
            else { base = XBC; ldc = CONVD; cb = (gt - 56) * 256; act = 0; }
            const int col0 = cb + wc * 32 + 8 * fq;
#pragma unroll
            for (int ai = 0; ai < 2; ++ai)
#pragma unroll
                for (int m = 0; m < 4; ++m) { bf16_t* rowp = base + (size_t)(row0 + ai * 128 + m * 16) * ldc + col0;
#pragma unroll
                    for (int bj = 0; bj < 2; ++bj) { f32x4 v0 = acc[ai][bj][m][0], v1 = acc[ai][bj][m][1];
                        if (act == 1) {
#pragma unroll
                            for (int j = 0; j < 4; ++j) { v0[j] = sigmoidf_(v0[j]); v1[j] = sigmoidf_(v1[j]); } }
                        else if (act == 2) {
#pragma unroll
                            for (int j = 0; j < 4; ++j) { v0[j] = siluf_(v0[j]); v1[j] = siluf_(v1[j]); } }
                        *(u32x4*)(rowp + bj * 128) = pack8(v0, v1); } }
        } else if (wc < 2) {
            const int c0 = wc * 32 + 8 * fq;
            f32x4 b0 = *(const f32x4*)(dt_bias + c0), b1 = *(const f32x4*)(dt_bias + c0 + 4);
#pragma unroll
            for (int ai = 0; ai < 2; ++ai)
#pragma unroll
                for (int m = 0; m < 4; ++m) { float* rowp = DT + (size_t)(row0 + ai * 128 + m * 16) * NH + c0;
                    f32x4 v0 = acc[ai][0][m][0] + b0, v1 = acc[ai][0][m][1] + b1;
#pragma unroll
                    for (int j = 0; j < 4; ++j) { v0[j] = softplusf_(v0[j]); v1[j] = softplusf_(v1[j]); }
                    *(f32x4*)rowp = v0; *(f32x4*)(rowp + 4) = v1; }
        }
    }
};
template <bool ADD> struct EpiGate {
    const bf16_t* GATE; const bf16_t* PREV; bf16_t* O;
    __device__ __forceinline__ void operator()(const f32x4 (&acc)[2][2][4][2], const Unit& u, int wr, int wc, int fr, int fq) const {
        const int row0 = u.pm * 256 + wr * 64 + fr, col0 = u.pn * 256 + wc * 32 + 8 * fq;
        constexpr int MB = ADD ? 2 : 4;
#pragma unroll
        for (int ai = 0; ai < 2; ++ai)
#pragma unroll
            for (int m0 = 0; m0 < 4; m0 += MB) {
                u32x4 gv[MB][2], pv[MB][2];
#pragma unroll
                for (int mm = 0; mm < MB; ++mm)
#pragma unroll
                    for (int bj = 0; bj < 2; ++bj) { const size_t idx = (size_t)(row0 + ai * 128 + (m0 + mm) * 16) * DM + col0 + bj * 128; gv[mm][bj] = *(const u32x4*)(GATE + idx); if (ADD) pv[mm][bj] = *(const u32x4*)(PREV + idx); }
#pragma unroll
                for (int mm = 0; mm < MB; ++mm)
#pragma unroll
                    for (int bj = 0; bj < 2; ++bj) { const size_t idx = (size_t)(row0 + ai * 128 + (m0 + mm) * 16) * DM + col0 + bj * 128;
                        f32x4 g0, g1; unpack8(gv[mm][bj], g0, g1);
                        f32x4 v0 = g0 * acc[ai][bj][m0 + mm][0], v1 = g1 * acc[ai][bj][m0 + mm][1];
                        if (ADD) { f32x4 p0, p1; unpack8(pv[mm][bj], p0, p1); v0 += p0; v1 += p1; }
                        *(u32x4*)(O + idx) = pack8(v0, v1); } }
    }
};
template <bool XBF> struct EpiRes {
    const void* X; bf16_t* HBF; float* ssq;
    __device__ __forceinline__ void operator()(const f32x4 (&acc)[2][2][4][2], const Unit& u, int wr, int wc, int fr, int fq) const {
        const int row0 = u.pm * 256 + wr * 64 + fr, col0 = u.pn * 256 + wc * 32 + 8 * fq;
#pragma unroll
        for (int ai = 0; ai < 2; ++ai) {
            f32x4 xv[4][2][2];
#pragma unroll
            for (int m = 0; m < 4; ++m)
#pragma unroll
                for (int bj = 0; bj < 2; ++bj) { const size_t idx = (size_t)(row0 + ai * 128 + m * 16) * DM + col0 + bj * 128;
                    if (XBF) { const u32x4 r = *(const u32x4*)((const bf16_t*)X + idx); unpack8(r, xv[m][bj][0], xv[m][bj][1]); }
                    else { xv[m][bj][0] = *(const f32x4*)((const float*)X + idx); xv[m][bj][1] = *(const f32x4*)((const float*)X + idx + 4); } }
#pragma unroll
            for (int m = 0; m < 4; ++m) { const int row = row0 + ai * 128 + m * 16; const size_t ro = (size_t)row * DM + col0; float s = 0.f;
#pragma unroll
                for (int bj = 0; bj < 2; ++bj) { const size_t idx = ro + bj * 128;
                    const f32x4 h0 = xv[m][bj][0] + acc[ai][bj][m][0], h1 = xv[m][bj][1] + acc[ai][bj][m][1];
                    *(u32x4*)(HBF + idx) = pack8(h0, h1);
#pragma unroll
                    for (int j = 0; j < 4; ++j) s += h0[j] * h0[j] + h1[j] * h1[j]; }
                s += __shfl_xor(s, 16); s += __shfl_xor(s, 32);
                if (fq == 0) atomicAdd(ssq + row, s); } }
    }
};
struct EpiSwiglu {
    const float* ssq; bf16_t* ACT;
    __device__ __forceinline__ void operator()(const f32x4 (&acc)[2][2][4][2], const Unit& u, int wr, int wc, int fr, int fq) const {
        const int row0 = u.pm * 256 + wr * 64 + fr, ch0 = u.pn * 128 + wc * 32 + 8 * fq;
        float rs[2][4];
#pragma unroll
        for (int ai = 0; ai < 2; ++ai)
#pragma unroll
            for (int m = 0; m < 4; ++m) rs[ai][m] = ssq[row0 + ai * 128 + m * 16];
#pragma unroll
        for (int ai = 0; ai < 2; ++ai)
#pragma unroll
            for (int m = 0; m < 4; ++m) rs[ai][m] = rsqrtf(rs[ai][m] * (1.0f / DM) + EPS);
#pragma unroll
        for (int ai = 0; ai < 2; ++ai)
#pragma unroll
            for (int m = 0; m < 4; ++m) { const int row = row0 + ai * 128 + m * 16; const float r = rs[ai][m];
                f32x4 v0, v1;
#pragma unroll
                for (int j = 0; j < 4; ++j) { v0[j] = siluf_(acc[ai][0][m][0][j] * r) * (acc[ai][1][m][0][j] * r); v1[j] = siluf_(acc[ai][0][m][1][j] * r) * (acc[ai][1][m][1][j] * r); }
                *(u32x4*)(ACT + (size_t)row * DFF + ch0) = pack8(v0, v1); }
    }
};

__device__ __forceinline__ int slot2lc(int slot) { return (slot & ~31) + pg8::perm32(slot & 31); }
__device__ __forceinline__ void conv_tile(LAS float* tile, const float* src0, const float* src1, int ldsrc, int nvalid, int K, bf16_t* dst, const float* kscale, int mode, int nt, int kt) {
    const int tid = threadIdx.x;
    { const int j = tid & 63, i0 = tid >> 6; const int nrow = nt * 64 + j, t256 = nrow >> 8, lc = slot2lc(nrow & 255);
      const float* s; int col; bool valid;
      if (mode == 0) { col = t256 * 256 + lc; s = src0; valid = col < nvalid; } else { col = t256 * 128 + (lc & 127); s = (lc >> 7) ? src1 : src0; valid = true; }
      if (!valid) col = 0;
      const float* sp = s + (size_t)(kt * 256 + i0) * ldsrc + col;
      float v[32];
#pragma unroll
      for (int ii = 0; ii < 32; ++ii) v[ii] = sp[(size_t)(8 * ii) * ldsrc];
#pragma unroll
      for (int ii = 0; ii < 32; ++ii) { const int kl = i0 + 8 * ii; float x = valid ? v[ii] : 0.f; if (kscale) x *= kscale[kt * 256 + kl]; tile[j * 257 + kl] = x; } }
    __syncthreads();
    { const int kk = (tid & 127) * 2, j0 = tid >> 7;
#pragma unroll
      for (int it = 0; it < 16; ++it) { const int j = j0 + 4 * it; *(unsigned*)(dst + (size_t)(nt * 64 + j) * K + kt * 256 + kk) = pk2(tile[j * 257 + kk], tile[j * 257 + kk + 1]); } }
    __syncthreads();
}

__device__ __forceinline__ void phase_prep(const Params& p, LAS unsigned char* lds) {
    LAS float* tile = (LAS float*)lds; unsigned char* ws = p.ws;
    constexpr int N0 = 324 * 8, N1 = N0 + 32 * 8, N2 = N1 + 32 * 16, N3 = N2 + 32 * 8, N4 = N3 + 176 * 8, N5 = N4 + 32 * 22;
    for (int it = blockIdx.x; it < N5; it += gridDim.x) {
        if (it < N0)      { const int i = it, nt = i / 8, kt = i % 8;
            if (nt < 96 || nt >= 160) conv_tile(tile, p.w_in, nullptr, IN_COLS, IN_COLS, DM, (bf16_t*)(ws + OFF_WIN), nullptr, 0, nt, kt);
            else conv_tile(tile, p.w_in + 6144, p.w_in + 8192, IN_COLS, IN_COLS, DM, (bf16_t*)(ws + OFF_WIN) + (size_t)24 * 256 * DM, nullptr, 1, nt - 96, kt); }
        else if (it < N1) { const int i = it - N0; conv_tile(tile, p.w_out_a, nullptr, DM, DM, DM, (bf16_t*)(ws + OFF_WOA), nullptr, 0, i / 8, i % 8); }
        else if (it < N2) { const int i = it - N1; conv_tile(tile, p.w_out_ssm, nullptr, DM, DM, DI, (bf16_t*)(ws + OFF_WOS), nullptr, 0, i / 16, i % 16); }
        else if (it < N3) { const int i = it - N2; conv_tile(tile, p.w_o, nullptr, DM, DM, DM, (bf16_t*)(ws + OFF_WO), nullptr, 0, i / 8, i % 8); }
        else if (it < N4) { const int i = it - N3; conv_tile(tile, p.w_ffn_gate, p.w_ffn_up, DFF, DFF, DM, (bf16_t*)(ws + OFF_WGU), p.norm_ffn_g, 1, i / 8, i % 8); }
        else              { const int i = it - N4; conv_tile(tile, p.w_ffn_down, nullptr, DM, DM, DFF, (bf16_t*)(ws + OFF_WDN), nullptr, 0, i / 22, i % 22); }
    }
    { float* s1 = (float*)(ws + OFF_SSQ1); for (int i = blockIdx.x * 512 + threadIdx.x; i < 2 * NTOK; i += gridDim.x * 512) s1[i] = 0.f; }
    { const int wave = threadIdx.x >> 6, lane = threadIdx.x & 63; bf16_t* U = (bf16_t*)(ws + OFF_U);
      for (int row = (blockIdx.x * 8 + wave) * 2; row < NTOK; row += gridDim.x * 16) {
          const f32x4* xr = (const f32x4*)(p.x + (size_t)row * DM); f32x4 v[16]; float ss0 = 0.f, ss1 = 0.f;
#pragma unroll
          for (int i = 0; i < 16; ++i) v[i] = xr[lane + 64 * i];
#pragma unroll
          for (int i = 0; i < 8; ++i) { ss0 += v[i][0] * v[i][0] + v[i][1] * v[i][1] + v[i][2] * v[i][2] + v[i][3] * v[i][3]; ss1 += v[8 + i][0] * v[8 + i][0] + v[8 + i][1] * v[8 + i][1] + v[8 + i][2] * v[8 + i][2] + v[8 + i][3] * v[8 + i][3]; }
#pragma unroll
          for (int o = 32; o >= 1; o >>= 1) { ss0 += __shfl_xor(ss0, o); ss1 += __shfl_xor(ss1, o); }
          const float r0 = rsqrtf(ss0 * (1.0f / DM) + EPS), r1 = rsqrtf(ss1 * (1.0f / DM) + EPS);
#pragma unroll
          for (int i = 0; i < 16; ++i) { const float r = i < 8 ? r0 : r1; const f32x4 gg = ((const f32x4*)p.norm_mix_g)[lane + 64 * (i & 7)]; u32x2 w; w.x = pk2(v[i][0] * r * gg[0], v[i][1] * r * gg[1]); w.y = pk2(v[i][2] * r * gg[2], v[i][3] * r * gg[3]);
              *(u32x2*)(U + (size_t)row * DM + (lane + 64 * i) * 4) = w; } } }
}

__device__ __forceinline__ void ssmconv_load(const bf16_t* XBC, int idx, u32x4 (&raw)[11]) {
    const int t0 = (idx / 768) * 8, c = (idx % 768) * 8; const bool first = (t0 & (SEQ - 1)) == 0;
#pragma unroll
    for (int r = 0; r < 11; ++r) raw[r] = (r < 3 && first) ? (u32x4){0u, 0u, 0u, 0u} : *(const u32x4*)(XBC + (size_t)(t0 - 3 + r) * CONVD + c);
}
__device__ __forceinline__ void ssmconv_compute(const Params& p, bf16_t* XS, bf16_t* BCS, int idx, const u32x4 (&raw)[11]) {
    const int t0 = (idx / 768) * 8, c = (idx % 768) * 8;
    f32x4 w0[4], w1[4];
#pragma unroll
    for (int j = 0; j < 4; ++j) { w0[j] = *(const f32x4*)(p.ssm_conv_w + j * CONVD + c); w1[j] = *(const f32x4*)(p.ssm_conv_w + j * CONVD + c + 4); }
    const f32x4 b0 = *(const f32x4*)(p.ssm_conv_b + c), b1 = *(const f32x4*)(p.ssm_conv_b + c + 4);
    bf16_t* dst = (c < DI) ? XS + (size_t)t0 * DI + c : BCS + (size_t)t0 * 2048 + (c - DI); const int ldd = (c < DI) ? DI : 2048;
#pragma unroll
    for (int i = 0; i < 8; ++i) { f32x4 a0 = b0, a1 = b1;
#pragma unroll
        for (int j = 0; j < 4; ++j) { f32x4 r0, r1; unpack8(raw[i + j], r0, r1); a0 += w0[j] * r0; a1 += w1[j] * r1; }
#pragma unroll
        for (int j = 0; j < 4; ++j) { a0[j] = siluf_(a0[j]); a1[j] = siluf_(a1[j]); }
        *(u32x4*)(dst + (size_t)i * ldd) = pack8(a0, a1); }
}
__device__ __forceinline__ void phase_ssmconv(const Params& p) {
    const bf16_t* XBC = (const bf16_t*)(p.ws + OFF_XBC); bf16_t* XS = (bf16_t*)p.out; bf16_t* BCS = (bf16_t*)(p.ws + OFF_BCS);
    const int total = (NTOK / 8) * 768, stride = gridDim.x * 512;
    int idx = blockIdx.x * 512 + threadIdx.x;
    u32x4 ra[11], rb[11];
    if (idx < total) ssmconv_load(XBC, idx, ra);
    while (idx < total) {
        const int i1 = idx + stride, i2 = idx + 2 * stride;
        if (i1 < total) ssmconv_load(XBC, i1, rb);
        ssmconv_compute(p, XS, BCS, idx, ra);
        if (i1 >= total) break;
        if (i2 < total) ssmconv_load(XBC, i2, ra);
        ssmconv_compute(p, XS, BCS, i1, rb);
        idx = i2;
    }
}

__device__ __forceinline__ void phase_ssd_seq(const Params& p, LAS unsigned char* lds) {
    LAS float* part = (LAS float*)lds;
    const int tid = threadIdx.x, pp = tid >> 3, ng = tid & 7, wave = tid >> 6, lane = tid & 63;
    const bf16_t* XS = (const bf16_t*)p.out; const bf16_t* BCS = (const bf16_t*)(p.ws + OFF_BCS); bf16_t* ZS = (bf16_t*)(p.ws + OFF_ZS);
    const float* DT = (const float*)(p.ws + OFF_DT); float* SSQH = (float*)(p.ws + OFF_SSQH);
    for (int item = blockIdx.x; item < 256; item += gridDim.x) {
        const int b = item >> 6, h = item & 63, g = h >> 3;
        const float a = -__expf(p.a_log[h]), Dk = p.d_skip[h];
        const bf16_t* xs = XS + (size_t)b * SEQ * DI + h * 64 + pp;
        const bf16_t* Bs = BCS + (size_t)b * SEQ * 2048 + g * 128 + ng * 16;
        const bf16_t* Cs = Bs + 1024;
        bf16_t* zs = ZS + (size_t)b * SEQ * DI + h * 64 + pp;
        const float* dt = DT + (size_t)b * SEQ * NH + h;
        float st[16];
#pragma unroll
        for (int i = 0; i < 16; ++i) st[i] = 0.f;
        for (int t0 = 0; t0 < SEQ; t0 += 64) {
#pragma unroll 4
            for (int tt = 0; tt < 64; ++tt) {
                const int t = t0 + tt;
                const float dtv = dt[(size_t)t * NH], xv = bf2f(xs[(size_t)t * DI]), zv = bf2f(zs[(size_t)t * DI]);
                f32x4 B0, B1, B2, B3, C0, C1, C2, C3;
                unpack8(*(const u32x4*)(Bs + (size_t)t * 2048), B0, B1); unpack8(*(const u32x4*)(Bs + (size_t)t * 2048 + 8), B2, B3);
                unpack8(*(const u32x4*)(Cs + (size_t)t * 2048), C0, C1); unpack8(*(const u32x4*)(Cs + (size_t)t * 2048 + 8), C2, C3);
                const float dA = __expf(dtv * a), xdt = xv * dtv; float y = 0.f;
#pragma unroll
                for (int i = 0; i < 4; ++i) {
                    st[i] = dA * st[i] + xdt * B0[i]; y += C0[i] * st[i];
                    st[4 + i] = dA * st[4 + i] + xdt * B1[i]; y += C1[i] * st[4 + i];
                    st[8 + i] = dA * st[8 + i] + xdt * B2[i]; y += C2[i] * st[8 + i];
                    st[12 + i] = dA * st[12 + i] + xdt * B3[i]; y += C3[i] * st[12 + i]; }
                y += __shfl_xor(y, 1); y += __shfl_xor(y, 2); y += __shfl_xor(y, 4);
                y += Dk * xv;
                const float yz = y * zv;
                if (ng == 0) zs[(size_t)t * DI] = (bf16_t)f2bf(yz);
                float sq = (ng == 0) ? yz * yz : 0.f;
                sq += __shfl_xor(sq, 8); sq += __shfl_xor(sq, 16); sq += __shfl_xor(sq, 32);
                if (lane == 0) part[tt * 8 + wave] = sq;
            }
            __syncthreads();
            if (tid < 64) { float s = 0.f;
#pragma unroll
                for (int w = 0; w < 8; ++w) s += part[tid * 8 + w];
                SSQH[(size_t)(b * SEQ + t0 + tid) * NH + h] = s; }
            __syncthreads();
        }
    }
}

typedef short s16x4 __attribute__((ext_vector_type(4)));
constexpr int SS_RSB = 272, SS_RSX = 144;
constexpr int SS_C = 0, SS_B = 34816, SS_X = 69632, SS_XW = 88064, SS_S = 106496, SS_SC = 123904, SS_M = 125952, SS_END = 160768;
__device__ __forceinline__ bf16x8 tr_frag(LAS unsigned char* lds, int addr, int step) {
    const s16x4 lo = __builtin_amdgcn_ds_read_tr16_b64_v4i16((LAS s16x4*)(lds + addr));
    const s16x4 hi = __builtin_amdgcn_ds_read_tr16_b64_v4i16((LAS s16x4*)(lds + addr + step));
    return __builtin_shufflevector(lo, hi, 0, 1, 2, 3, 4, 5, 6, 7);
}
#define MFMA16(a, b, c) __builtin_amdgcn_mfma_f32_16x16x32_bf16(a, b, c, 0, 0, 0)
#define WG_BAR() do { asm volatile("s_waitcnt lgkmcnt(0)" ::: "memory"); __builtin_amdgcn_s_barrier(); asm volatile("" ::: "memory"); } while (0)
__device__ __forceinline__ void phase_ssd_chunk(const Params& p, LAS unsigned char* lds) {
    const int tid = threadIdx.x, w = __builtin_amdgcn_readfirstlane(tid >> 6), lane = tid & 63, fr = lane & 15, g4 = lane >> 4, q = fr >> 2, pq = fr & 3;
    const bf16_t* XS = (const bf16_t*)p.out; const bf16_t* BCS = (const bf16_t*)(p.ws + OFF_BCS); bf16_t* ZS = (bf16_t*)(p.ws + OFF_ZS);
    const float* DT = (const float*)(p.ws + OFF_DT); float* SSQH = (float*)(p.ws + OFF_SSQH);
    LAS float* scal = (LAS float*)(lds + SS_SC);
    const int l = 16 * w + fr;
    for (int item = blockIdx.x; item < 256; item += gridDim.x) {
        const int b = item >> 6, grp = item & 7, h = grp * 8 + ((item >> 3) & 7);
        const float a = -__expf(p.a_log[h]), Dk = p.d_skip[h];
        f32x4 accS[4];
#pragma unroll
        for (int i = 0; i < 4; ++i) accS[i] = (f32x4){0.f, 0.f, 0.f, 0.f};
        u32x4 pb[4], pc[4], px[2]; float d0 = 0.f, d1 = 0.f;
        const bf16_t* bsrc = BCS + (size_t)(b * SEQ + (tid >> 4)) * 2048 + grp * 128 + (tid & 15) * 8;
        const bf16_t* xsrc = XS + (size_t)(b * SEQ + (tid >> 3)) * DI + h * 64 + (tid & 7) * 8;
        const float* dsrc = DT + (size_t)(b * SEQ + lane) * NH + h;
#define SSD_PREFETCH(c_) do { const size_t ro_ = (size_t)(c_) * 128; \
            _Pragma("unroll") for (int i = 0; i < 4; ++i) { pb[i] = *(const u32x4*)(bsrc + (ro_ + 32 * i) * 2048); pc[i] = *(const u32x4*)(bsrc + (ro_ + 32 * i) * 2048 + 1024); } \
            _Pragma("unroll") for (int i = 0; i < 2; ++i) px[i] = *(const u32x4*)(xsrc + (ro_ + 64 * i) * DI); \
            if (w == 0) { d0 = dsrc[ro_ * NH]; d1 = dsrc[(ro_ + 64) * NH]; } } while (0)
#define SSD_SCAN(buf_) do { if (w == 0) { float s0 = d0 * a, s1 = d1 * a; \
            _Pragma("unroll") for (int o = 1; o < 64; o <<= 1) { const float t0 = __shfl_up(s0, o), t1 = __shfl_up(s1, o); if (lane >= o) { s0 += t0; s1 += t1; } } \
            s1 += __shfl(s0, 63); LAS float* cs_ = scal + (buf_) * 256; cs_[lane] = s0; cs_[64 + lane] = s1; cs_[128 + lane] = d0; cs_[192 + lane] = d1; } } while (0)
        SSD_PREFETCH(0);
        for (int i = tid; i < 64 * SS_RSB / 16; i += 512) *(LAS u32x4*)(lds + SS_S + i * 16) = (u32x4){0u, 0u, 0u, 0u};
        SSD_SCAN(0);
        WG_BAR();
        for (int c = 0; c < 32; ++c) {
            const int tok0 = b * SEQ + c * 128;
            LAS float* csA = scal + (c & 1) * 256; LAS float* dtA = csA + 128;
            const float csend = csA[127];
#pragma unroll
            for (int i = 0; i < 4; ++i) { const int row = (tid >> 4) + 32 * i, ch = tid & 15; *(LAS u32x4*)(lds + SS_B + row * SS_RSB + ch * 16) = pb[i]; *(LAS u32x4*)(lds + SS_C + row * SS_RSB + ch * 16) = pc[i]; }
#pragma unroll
            for (int i = 0; i < 2; ++i) { const int row = (tid >> 3) + 64 * i, ch = tid & 7; *(LAS u32x4*)(lds + SS_X + row * SS_RSX + ch * 16) = px[i];
                const float wl = __expf(csend - csA[row]) * dtA[row]; f32x4 v0, v1; unpack8(px[i], v0, v1); v0 *= wl; v1 *= wl; *(LAS u32x4*)(lds + SS_XW + row * SS_RSX + ch * 16) = pack8(v0, v1); }
            WG_BAR();
            if (c + 1 < 32) SSD_PREFETCH(c + 1);
            const size_t tok = (size_t)(tok0 + l);
            bf16_t* zp = ZS + tok * DI + h * 64 + 4 * g4;
            u32x2 z2[4];
#pragma unroll
            for (int pt = 0; pt < 4; ++pt) z2[pt] = *(const u32x2*)(zp + 16 * pt);
            const float csl = csA[l];
            bf16x8 cf[4];
#pragma unroll
            for (int ks = 0; ks < 4; ++ks) cf[ks] = *(const LAS bf16x8*)(lds + SS_C + l * SS_RSB + (4 * ks + g4) * 16);
            f32x4 accY[4];
            { bf16x8 sf[4][4];
#pragma unroll
              for (int pt = 0; pt < 4; ++pt)
#pragma unroll
                  for (int ks = 0; ks < 4; ++ks) sf[pt][ks] = *(const LAS bf16x8*)(lds + SS_S + (16 * pt + fr) * SS_RSB + (4 * ks + g4) * 16);
#pragma unroll
              for (int pt = 0; pt < 4; ++pt) accY[pt] = (f32x4){0.f, 0.f, 0.f, 0.f};
#pragma unroll
              for (int ks = 0; ks < 4; ++ks)
#pragma unroll
                  for (int pt = 0; pt < 4; ++pt) accY[pt] = MFMA16(sf[pt][ks], cf[ks], accY[pt]);
              const float el = __expf(csl);
#pragma unroll
              for (int pt = 0; pt < 4; ++pt) accY[pt] *= el; }
#pragma unroll
            for (int sp = 0; sp < 4; ++sp) {
                if (2 * sp <= w) {
                    bf16x8 bfr[2][4];
#pragma unroll
                    for (int e = 0; e < 2; ++e)
#pragma unroll
                        for (int ks = 0; ks < 4; ++ks) bfr[e][ks] = *(const LAS bf16x8*)(lds + SS_B + (16 * (2 * sp + e) + fr) * SS_RSB + (4 * ks + g4) * 16);
                    f32x4 cs4[2], dt4[2];
#pragma unroll
                    for (int e = 0; e < 2; ++e) { cs4[e] = *(const LAS f32x4*)(csA + 16 * (2 * sp + e) + 4 * g4); dt4[e] = *(const LAS f32x4*)(dtA + 16 * (2 * sp + e) + 4 * g4); }
                    f32x4 a1[2] = {(f32x4){0.f, 0.f, 0.f, 0.f}, (f32x4){0.f, 0.f, 0.f, 0.f}};
#pragma unroll
                    for (int ks = 0; ks < 4; ++ks)
#pragma unroll
                        for (int e = 0; e < 2; ++e) a1[e] = MFMA16(bfr[e][ks], cf[ks], a1[e]);
#pragma unroll
                    for (int e = 0; e < 2; ++e) { float v[4];
#pragma unroll
                        for (int r = 0; r < 4; ++r) { const int s = 16 * (2 * sp + e) + 4 * g4 + r; const float t = a1[e][r] * __expf(fminf(csl - cs4[e][r], 0.f)) * dt4[e][r]; v[r] = (s <= l) ? t : 0.f; }
                        u32x2 pk; pk.x = pk2(v[0], v[1]); pk.y = pk2(v[2], v[3]); *(LAS u32x2*)(lds + SS_M + l * SS_RSB + (16 * (2 * sp + e) + 4 * g4) * 2) = pk; } } }
            { const float dec = __expf(csend);
#pragma unroll
              for (int pt = 0; pt < 4; ++pt) accS[pt] *= dec;
#pragma unroll
              for (int kp = 0; kp < 2; ++kp) { bf16x8 btf[2], xwf[2][4];
#pragma unroll
                  for (int e = 0; e < 2; ++e) { const int ks = 2 * kp + e; btf[e] = tr_frag(lds, SS_B + (32 * ks + 8 * g4 + q) * SS_RSB + (16 * w + 4 * pq) * 2, 4 * SS_RSB);
#pragma unroll
                      for (int pt = 0; pt < 4; ++pt) xwf[e][pt] = tr_frag(lds, SS_XW + (32 * ks + 8 * g4 + q) * SS_RSX + (16 * pt + 4 * pq) * 2, 4 * SS_RSX); }
#pragma unroll
                  for (int e = 0; e < 2; ++e)
#pragma unroll
                      for (int pt = 0; pt < 4; ++pt) accS[pt] = MFMA16(btf[e], xwf[e][pt], accS[pt]); } }
            if (c + 1 < 32) SSD_SCAN((c + 1) & 1);
#pragma unroll
            for (int ks = 0; ks < 4; ++ks) { if (2 * ks <= w) { const bf16x8 mf = *(const LAS bf16x8*)(lds + SS_M + l * SS_RSB + (4 * ks + g4) * 16); bf16x8 xf[4];
#pragma unroll
                for (int pt = 0; pt < 4; ++pt) xf[pt] = tr_frag(lds, SS_X + (32 * ks + 8 * g4 + q) * SS_RSX + (16 * pt + 4 * pq) * 2, 4 * SS_RSX);
#pragma unroll
                for (int pt = 0; pt < 4; ++pt) accY[pt] = MFMA16(xf[pt], mf, accY[pt]); } }
            { float sq = 0.f;
#pragma unroll
              for (int pt = 0; pt < 4; ++pt) { const u32x2 x2 = *(const LAS u32x2*)(lds + SS_X + l * SS_RSX + (16 * pt + 4 * g4) * 2);
                  const float y0 = (accY[pt][0] + Dk * bflo(x2.x)) * bflo(z2[pt].x), y1 = (accY[pt][1] + Dk * bfhi(x2.x)) * bfhi(z2[pt].x), y2 = (accY[pt][2] + Dk * bflo(x2.y)) * bflo(z2[pt].y), y3 = (accY[pt][3] + Dk * bfhi(x2.y)) * bfhi(z2[pt].y);
                  sq += y0 * y0 + y1 * y1 + y2 * y2 + y3 * y3; u32x2 o; o.x = pk2(y0, y1); o.y = pk2(y2, y3); *(u32x2*)(zp + 16 * pt) = o; }
              sq += __shfl_xor(sq, 16); sq += __shfl_xor(sq, 32);
              if (g4 == 0) SSQH[tok * NH + h] = sq; }
            WG_BAR();
#pragma unroll
            for (int pt = 0; pt < 4; ++pt) { u32x2 pk; pk.x = pk2(accS[pt][0], accS[pt][1]); pk.y = pk2(accS[pt][2], accS[pt][3]); *(LAS u32x2*)(lds + SS_S + (16 * pt + fr) * SS_RSB + (16 * w + 4 * g4) * 2) = pk; }
        }
        WG_BAR();
#undef SSD_PREFETCH
#undef SSD_SCAN
    }
}

__device__ __forceinline__ void phase_gnorm(const Params& p) {
    bf16_t* ZS = (bf16_t*)(p.ws + OFF_ZS); const float* SSQH = (const float*)(p.ws + OFF_SSQH);
    const int total = NTOK * 512 / 4;
    for (int idx = blockIdx.x * 512 + threadIdx.x; idx < total; idx += gridDim.x * 512) {
        const int t0 = (idx >> 9) * 4, cg8 = idx & 511, c = cg8 * 8, g = cg8 >> 6;
        u32x4 raw[4]; f32x4 s0[4], s1[4];
#pragma unroll
        for (int i = 0; i < 4; ++i) { raw[i] = *(const u32x4*)(ZS + (size_t)(t0 + i) * DI + c); s0[i] = *(const f32x4*)(SSQH + (size_t)(t0 + i) * NH + g * 8); s1[i] = *(const f32x4*)(SSQH + (size_t)(t0 + i) * NH + g * 8 + 4); }
        const f32x4 g0 = *(const f32x4*)(p.ssm_norm_g + c), g1 = *(const f32x4*)(p.ssm_norm_g + c + 4);
#pragma unroll
        for (int i = 0; i < 4; ++i) { const float ss = s0[i][0] + s0[i][1] + s0[i][2] + s0[i][3] + s1[i][0] + s1[i][1] + s1[i][2] + s1[i][3]; const float r = rsqrtf(ss * (1.0f / 512.0f) + EPS);
            f32x4 v0, v1; unpack8(raw[i], v0, v1); v0 = v0 * r * g0; v1 = v1 * r * g1; *(u32x4*)(ZS + (size_t)(t0 + i) * DI + c) = pack8(v0, v1); }
    }
}

struct MixaBuf { u32x4 rq[10], rb[8]; };
__device__ __forceinline__ void mixa_load(const bf16_t* BB, const bf16_t* CH, int idx, MixaBuf& m) {
    const int t0 = (idx >> 8) * 8, c = (idx & 255) * 8; const bool first = (t0 & (SEQ - 1)) == 0;
#pragma unroll
    for (int r = 0; r < 10; ++r) m.rq[r] = (r < 2 && first) ? (u32x4){0u, 0u, 0u, 0u} : *(const u32x4*)(CH + (size_t)(t0 - 2 + r) * DM + c);
#pragma unroll
    for (int i = 0; i < 8; ++i) m.rb[i] = *(const u32x4*)(BB + (size_t)(t0 + i) * DM + c);
}
__device__ __forceinline__ void mixa_compute(const Params& p, bf16_t* YA, int idx, const MixaBuf& m) {
    const int t0 = (idx >> 8) * 8, c = (idx & 255) * 8;
    f32x4 w0[3], w1[3];
#pragma unroll
    for (int j = 0; j < 3; ++j) { w0[j] = *(const f32x4*)(p.conv_a_w + j * DM + c); w1[j] = *(const f32x4*)(p.conv_a_w + j * DM + c + 4); }
    f32x4 q0[3], q1[3];
#pragma unroll
    for (int r = 0; r < 2; ++r) unpack8(m.rq[r], q0[r], q1[r]);
#pragma unroll
    for (int i = 0; i < 8; ++i) { unpack8(m.rq[i + 2], q0[2], q1[2]);
        const f32x4 a0 = w0[0] * q0[0] + w0[1] * q0[1] + w0[2] * q0[2], a1 = w1[0] * q1[0] + w1[1] * q1[1] + w1[2] * q1[2];
        f32x4 b0, b1; unpack8(m.rb[i], b0, b1);
        *(u32x4*)(YA + (size_t)(t0 + i) * DM + c) = pack8(a0 * b0, a1 * b1);
        q0[0] = q0[1]; q0[1] = q0[2]; q1[0] = q1[1]; q1[1] = q1[2]; }
}
__device__ __forceinline__ void phase_mixa(const Params& p) {
    const bf16_t* BB = (const bf16_t*)(p.ws + OFF_BB); const bf16_t* CH = (const bf16_t*)(p.ws + OFF_BC); bf16_t* YA = (bf16_t*)(p.ws + OFF_U);
    const int total = (NTOK / 8) * 256, stride = gridDim.x * 512;
    int idx = blockIdx.x * 512 + threadIdx.x;
    MixaBuf ma, mb;
    if (idx < total) mixa_load(BB, CH, idx, ma);
    while (idx < total) {
        const int i1 = idx + stride, i2 = idx + 2 * stride;
        if (i1 < total) mixa_load(BB, CH, i1, mb);
        mixa_compute(p, YA, idx, ma);
        if (i1 >= total) break;
        if (i2 < total) mixa_load(BB, CH, i2, ma);
        mixa_compute(p, YA, i1, mb);
        idx = i2;
    }
}

__device__ __forceinline__ void phase_final(const Params& p) {
    const float* SSQ2 = (const float*)(p.ws + OFF_SSQ2); const bf16_t* H2 = (const bf16_t*)(p.ws + OFF_BB);
    const int total = NTOK * 256 / 4;
    for (int idx = blockIdx.x * 512 + threadIdx.x; idx < total; idx += gridDim.x * 512) {
        const int t0 = (idx >> 8) * 4, c = (idx & 255) * 8;
        u32x4 v[4]; float r[4];
#pragma unroll
        for (int i = 0; i < 4; ++i) { v[i] = *(const u32x4*)(H2 + (size_t)(t0 + i) * DM + c); r[i] = SSQ2[t0 + i]; }
        const f32x4 g0 = *(const f32x4*)(p.norm_final_g + c), g1 = *(const f32x4*)(p.norm_final_g + c + 4);
#pragma unroll
        for (int i = 0; i < 4; ++i) { const float rr = rsqrtf(r[i] * (1.0f / DM) + EPS); f32x4 a0, a1; unpack8(v[i], a0, a1);
            *(f32x4*)(p.out + (size_t)(t0 + i) * DM + c) = a0 * rr * g0; *(f32x4*)(p.out + (size_t)(t0 + i) * DM + c + 4) = a1 * rr * g1; }
    }
}

#define XB_TMO      128
#define XB_XCNT(j)  (256  + 64 * (j))
#define XB_XSUB(j)  (1280 + 64 * (j))
#define XB_XGEN(j)  (2304 + 64 * (j))
#define XB_TOP      3328
#define XB_TOPGEN   3392
#define XCD_BAR_WORDS 3456
#define XB_SPIN_CAP (1u << 18)

__device__ __forceinline__ unsigned xb_ld(unsigned* p)              { return __hip_atomic_load(p, __ATOMIC_RELAXED, __HIP_MEMORY_SCOPE_AGENT); }
__device__ __forceinline__ unsigned xb_add(unsigned* p, unsigned v) { return __hip_atomic_fetch_add(p, v, __ATOMIC_RELAXED, __HIP_MEMORY_SCOPE_AGENT); }
__device__ __forceinline__ unsigned xb_xcc_id() { return (unsigned)__builtin_amdgcn_s_getreg((3 << 11) | 20) & 0xFu; }
#define XB_SPIN(cond, bar) do { unsigned _sp = 0; while (cond) { __builtin_amdgcn_s_sleep(1); \
    if ((++_sp & 255u) == 0u) { if (xb_ld(&(bar)[XB_TMO])) break; if (_sp > XB_SPIN_CAP) { atomicAdd(&(bar)[XB_TMO], 1u); break; } } } } while (0)

struct XcdBarrier {
    unsigned* bar; unsigned x;
    volatile LAS unsigned* st;
};

__device__ __forceinline__ XcdBarrier xcd_barrier_post(unsigned* bar, volatile LAS unsigned* st) {
    XcdBarrier b; b.bar = bar; b.x = xb_xcc_id(); b.st = st;
    if (threadIdx.x == 0) (void)xb_add(&bar[XB_XCNT(b.x)], 1u);
    return b;
}
__device__ __forceinline__ void xcd_barrier_complete(unsigned* bar, unsigned x, unsigned& nloc, unsigned& nx) {
    const unsigned G = gridDim.x * gridDim.y * gridDim.z;
    unsigned sum, cnt, mine, sp = 0u;
    for (;;) {
        sum = 0u; cnt = 0u; mine = 0u;
#pragma unroll
        for (unsigned j = 0; j < 16; ++j) { const unsigned c = xb_ld(&bar[XB_XCNT(j)]); sum += c; cnt += (c > 0u) ? 1u : 0u; mine = (j == x) ? c : mine; }
        if (sum == G) break;
        __builtin_amdgcn_s_sleep(1);
        if ((++sp & 255u) == 0u) { if (xb_ld(&bar[XB_TMO])) break; if (sp > XB_SPIN_CAP) { atomicAdd(&bar[XB_TMO], 1u); break; } }
    }
    nloc = mine > 0u ? mine : 1u; nx = cnt > 0u ? cnt : 1u;
}

__device__ __forceinline__ void xcd_barrier(const XcdBarrier& b) {
    asm volatile("s_waitcnt vmcnt(0)" ::: "memory");
    __syncthreads();
    if (threadIdx.x == 0) {
        unsigned* bar = b.bar;
        __builtin_amdgcn_s_waitcnt(0);
        unsigned nloc = b.st[0], nx = b.st[1];
        if (nloc == 0u) { xcd_barrier_complete(bar, b.x, nloc, nx); b.st[0] = nloc; b.st[1] = nx; }
        const unsigned old = xb_add(&bar[XB_XSUB(b.x)], 1u);
        const unsigned gen = old / nloc;
        if (old + 1u == (gen + 1u) * nloc) {
            __builtin_amdgcn_fence(__ATOMIC_RELEASE, "agent");
            asm volatile("s_waitcnt vmcnt(0)" ::: "memory");
            const unsigned og = xb_add(&bar[XB_TOP], 1u);
            const unsigned tg = og / nx;
            if (og + 1u == (tg + 1u) * nx) xb_add(&bar[XB_TOPGEN], 1u);
            else XB_SPIN(xb_ld(&bar[XB_TOPGEN]) == tg, bar);
            __builtin_amdgcn_fence(__ATOMIC_ACQUIRE, "agent");
            xb_add(&bar[XB_XGEN(b.x)], 1u);
            asm volatile("s_waitcnt vmcnt(0)" ::: "memory");
        } else {
            XB_SPIN(xb_ld(&bar[XB_XGEN(b.x)]) == gen, bar);
            __builtin_amdgcn_fence(__ATOMIC_ACQUIRE, "agent");
            asm volatile("s_waitcnt vmcnt(0)" ::: "memory");
        }
    }
    __syncthreads();
}

constexpr int NPHASE = 11;
template <int PH> __device__ __forceinline__ void run_phase(const Params& p, LAS unsigned char* lds) {
    unsigned char* ws = p.ws;
    pg8::StaticOrder S; pg8::Gemm g;
    if constexpr (PH == 0) { phase_prep(p, lds); }
    else if constexpr (PH == 1) {
        g.A = (const bf16_t*)(ws + OFF_U); g.Bt = (const bf16_t*)(ws + OFF_WIN) + (size_t)40 * 256 * DM; g.M = NTOK; g.N = 41 * 256; g.K = DM; S.init(g.M, g.N, gridDim.x, blockIdx.x);
        EpiRoute E{(bf16_t*)p.out, (bf16_t*)p.out + (size_t)NTOK * DM, (bf16_t*)(ws + OFF_BB), (bf16_t*)(ws + OFF_BC), (bf16_t*)(ws + OFF_BH), (bf16_t*)(ws + OFF_ZS), (bf16_t*)(ws + OFF_XBC), (float*)(ws + OFF_DT), p.dt_bias, 40};
        pg8::gemm_phase(lds, g, S, E); }
    else if constexpr (PH == 2) { phase_ssmconv(p); }
    else if constexpr (PH == 3) { phase_ssd_chunk(p, lds); }
    else if constexpr (PH == 4) {
        g.A = (const bf16_t*)(ws + OFF_U); g.Bt = (const bf16_t*)(ws + OFF_WIN); g.M = NTOK; g.N = 40 * 256; g.K = DM; S.init(g.M, g.N, gridDim.x, blockIdx.x);
        EpiRoute E{(bf16_t*)p.out, (bf16_t*)p.out + (size_t)NTOK * DM, (bf16_t*)(ws + OFF_BB), (bf16_t*)(ws + OFF_BC), (bf16_t*)(ws + OFF_BH), (bf16_t*)(ws + OFF_ZS), (bf16_t*)(ws + OFF_XBC), (float*)(ws + OFF_DT), p.dt_bias, 0};
        pg8::gemm_phase(lds, g, S, E);
        phase_gnorm(p); }
    else if constexpr (PH == 5) { phase_mixa(p); }
    else if constexpr (PH == 6) {
        g.A = (const bf16_t*)(ws + OFF_U); g.Bt = (const bf16_t*)(ws + OFF_WOA); g.M = NTOK; g.N = DM; g.K = DM; S.init(g.M, g.N, gridDim.x, blockIdx.x);
        EpiGate<false> Ea{(const bf16_t*)p.out, nullptr, (bf16_t*)(ws + OFF_BB)};
        pg8::gemm_phase(lds, g, S, Ea);
        g.A = (const bf16_t*)(ws + OFF_ZS); g.Bt = (const bf16_t*)(ws + OFF_WOS); g.K = DI;
        EpiGate<true> Eb{(const bf16_t*)p.out + (size_t)NTOK * DM, (const bf16_t*)(ws + OFF_BB), (bf16_t*)(ws + OFF_BC)};
        pg8::gemm_phase(lds, g, S, Eb); }
    else if constexpr (PH == 7) {
        g.A = (const bf16_t*)(ws + OFF_BC); g.Bt = (const bf16_t*)(ws + OFF_WO); g.M = NTOK; g.N = DM; g.K = DM; S.init(g.M, g.N, gridDim.x, blockIdx.x);
        EpiRes<false> E{p.x, (bf16_t*)(ws + OFF_BH), (float*)(ws + OFF_SSQ1)};
        pg8::gemm_phase(lds, g, S, E); }
    else if constexpr (PH == 8) {
        g.A = (const bf16_t*)(ws + OFF_BH); g.Bt = (const bf16_t*)(ws + OFF_WGU); g.M = NTOK; g.N = 2 * DFF; g.K = DM; S.init(g.M, g.N, gridDim.x, blockIdx.x);
        EpiSwiglu E{(const float*)(ws + OFF_SSQ1), (bf16_t*)(ws + OFF_ZS)};
        pg8::gemm_phase(lds, g, S, E); }
    else if constexpr (PH == 9) {
        g.A = (const bf16_t*)(ws + OFF_ZS); g.Bt = (const bf16_t*)(ws + OFF_WDN); g.M = NTOK; g.N = DM; g.K = DFF; S.init(g.M, g.N, gridDim.x, blockIdx.x);
        EpiRes<true> E{(const void*)(ws + OFF_BH), (bf16_t*)(ws + OFF_BB), (float*)(ws + OFF_SSQ2)};
        pg8::gemm_phase(lds, g, S, E); }
    else if constexpr (PH == 10) { phase_final(p); }
}

template <int PH> __global__ void __launch_bounds__(512, 2) k_one(Params p) {
    extern __shared__ __attribute__((aligned(16))) unsigned char lds_raw[];
    run_phase<PH>(p, (LAS unsigned char*)lds_raw);
}

#ifndef PROBE_MASK
#define PROBE_MASK 0
#endif
__global__ void __launch_bounds__(512, 2) k_mega(Params p) {
    extern __shared__ __attribute__((aligned(16))) unsigned char lds_raw[];
    LAS unsigned char* lds = (LAS unsigned char*)lds_raw;
    cg::grid_group grid = cg::this_grid();
    unsigned long long spin = 0, t0 = 0;
    volatile LAS unsigned* bst = (volatile LAS unsigned*)(lds + SS_END);
    if (threadIdx.x < 4) bst[threadIdx.x] = 0u;
    __syncthreads();
    const XcdBarrier xbar = xcd_barrier_post((unsigned*)(p.ws + OFF_BAR), bst);
#define PH_RUN(i, SYNC) do { if (PROBE_MASK) t0 = __builtin_amdgcn_s_memrealtime(); if (PROBE_KMASK && threadIdx.x == 0) *(LAS unsigned long long*)(lds + SS_END + 8) = 0ull; run_phase<i>(p, lds); if ((PROBE_KMASK & (1 << i)) && threadIdx.x == 0) spin += *(LAS unsigned long long*)(lds + SS_END + 8); if (SYNC == 1) grid.sync(); else if (SYNC == 2) xcd_barrier(xbar); \
        if (PROBE_MASK & (1 << i)) spin += __builtin_amdgcn_s_memrealtime() - t0; } while (0)
    PH_RUN(0, 1); PH_RUN(1, 2); PH_RUN(2, 2); PH_RUN(3, 2); PH_RUN(4, 2); PH_RUN(5, 2); PH_RUN(6, 2); PH_RUN(7, 2); PH_RUN(8, 2); PH_RUN(9, 2); PH_RUN(10, 0);
#ifdef PROBE_SYNCS
    for (int i = 0; i < PROBE_SYNCS; ++i) xcd_barrier(xbar);
#endif
    if ((PROBE_MASK || PROBE_KMASK) && blockIdx.x == 0) { t0 = __builtin_amdgcn_s_memrealtime(); while (__builtin_amdgcn_s_memrealtime() - t0 < spin) __builtin_amdgcn_s_sleep(8); }
}

constexpr int LDS_BYTES = SS_END + 16;

template <int PH> static void launch_one(const Params& p, int grid, hipStream_t stream) {
    static bool attr = false;
    if (!attr) { (void)hipFuncSetAttribute((const void*)k_one<PH>, hipFuncAttributeMaxDynamicSharedMemorySize, LDS_BYTES); attr = true; }
    hipLaunchKernelGGL(k_one<PH>, dim3(grid), dim3(512), LDS_BYTES, stream, p);
}

extern "C" void kernel_launch(void* const* d_in, const int* in_sizes, int n_in, void* d_out, int out_size, void* d_ws, size_t ws_size, hipStream_t stream) {
    static int grid = 0;
    if (grid == 0) {
        if (n_in != 18 || out_size != NTOK * DM || ws_size < WS_END) { fprintf(stderr, "kernel_launch: unexpected shapes: n_in %d out %d ws %zu (need %zu)\n", n_in, out_size, ws_size, (size_t)WS_END); grid = -1; return; }
        int dev = 0, cus = 0, per_cu = 0;
        (void)hipGetDevice(&dev); (void)hipDeviceGetAttribute(&cus, hipDeviceAttributeMultiprocessorCount, dev);
        (void)hipFuncSetAttribute((const void*)k_mega, hipFuncAttributeMaxDynamicSharedMemorySize, LDS_BYTES);
        (void)hipOccupancyMaxActiveBlocksPerMultiprocessor(&per_cu, (const void*)k_mega, 512, LDS_BYTES);
        if (per_cu < 1) { fprintf(stderr, "kernel_launch: occupancy query says %d blocks per CU\n", per_cu); per_cu = 1; }
        (void)hipGetLastError();
        grid = cus * per_cu;
        fprintf(stderr, "kernel_launch: cus %d per_cu %d grid %d ws %zu\n", cus, per_cu, grid, ws_size);
    }
    if (grid < 0) return;
    Params p{};
    const float** pp = (const float**)&p;
    for (int i = 0; i < 18; ++i) pp[i] = (const float*)d_in[i];
    p.out = (float*)d_out; p.ws = (unsigned char*)d_ws;
#if MEGA
    (void)hipMemsetAsync((unsigned char*)d_ws + OFF_BAR, 0, XCD_BAR_WORDS * 4, stream);
    void* args[] = {&p};
    hipError_t e = hipLaunchCooperativeKernel((const void*)k_mega, dim3(grid), dim3(512), args, LDS_BYTES, stream);
    if (e != hipSuccess) fprintf(stderr, "cooperative launch failed: %s (grid %d)\n", hipGetErrorString(e), grid);
#else
    launch_one<0>(p, grid, stream); launch_one<1>(p, grid, stream); launch_one<2>(p, grid, stream); launch_one<3>(p, grid, stream); launch_one<4>(p, grid, stream); launch_one<5>(p, grid, stream);
    launch_one<6>(p, grid, stream); launch_one<7>(p, grid, stream); launch_one<8>(p, grid, stream); launch_one<9>(p, grid, stream); launch_one<10>(p, grid, stream);
#endif
}
```

```cpp
#include <hip/hip_runtime.h>
#include <hip/hip_cooperative_groups.h>
#include <cstdio>
namespace cg = cooperative_groups;

#ifndef MEGA
#define MEGA 1
#endif

#define LAS __attribute__((address_space(3)))
typedef unsigned short bf16_t;
typedef short bf16x8 __attribute__((ext_vector_type(8)));
typedef float f32x4 __attribute__((ext_vector_type(4)));
typedef unsigned u32x4 __attribute__((ext_vector_type(4)));
typedef unsigned u32x2 __attribute__((ext_vector_type(2)));

constexpr int DM = 2048, NTOK = 16384, SEQ = 4096;
constexpr int IN_COLS = 20544, IN_TILES = 81;
constexpr int DI = 4096, NH = 64, HD = 64, NG = 8, NST = 128, CONVD = 6144;
constexpr int DFF = 5632;
constexpr float EPS = 1e-6f;

constexpr size_t MiB = 1024ull * 1024ull;
constexpr size_t OFF_WIN = 0;
constexpr size_t OFF_WOA = 81 * MiB;
constexpr size_t OFF_WOS = 89 * MiB;
constexpr size_t OFF_WO  = 105 * MiB;
constexpr size_t OFF_WGU = 113 * MiB;
constexpr size_t OFF_WDN = 157 * MiB;
constexpr size_t OFF_ZS  = 179 * MiB;
constexpr size_t OFF_U   = 307 * MiB;
constexpr size_t OFF_XBC = 371 * MiB;
constexpr size_t OFF_BB  = 371 * MiB, OFF_BC = 435 * MiB, OFF_BH = 499 * MiB;
constexpr size_t OFF_DT  = 563 * MiB;
constexpr size_t OFF_SSQH = 567 * MiB;
constexpr size_t OFF_SSQ1 = 571 * MiB;
constexpr size_t OFF_SSQ2 = 571 * MiB + 65536;
constexpr size_t OFF_BCS = 572 * MiB;
constexpr size_t OFF_BAR = 636 * MiB;
constexpr size_t WS_END = 637 * MiB;

struct Params {
    const float *x, *norm_mix_g, *w_in, *conv_a_w, *w_out_a, *ssm_conv_w, *ssm_conv_b, *dt_bias, *a_log, *d_skip, *ssm_norm_g, *w_out_ssm, *w_o, *norm_ffn_g, *w_ffn_gate, *w_ffn_up,
        *w_ffn_down, *norm_final_g;
    float* out; unsigned char* ws;
};

__device__ __forceinline__ unsigned f2bf(float f) { unsigned u = __builtin_bit_cast(unsigned, f); return (u + 0x7fffu + ((u >> 16) & 1u)) >> 16; }
__device__ __forceinline__ unsigned pk2(float lo, float hi) { unsigned r; asm("v_cvt_pk_bf16_f32 %0, %1, %2" : "=v"(r) : "v"(lo), "v"(hi)); return r; }
__device__ __forceinline__ float bflo(unsigned w) { return __builtin_bit_cast(float, w << 16); }
__device__ __forceinline__ float bfhi(unsigned w) { return __builtin_bit_cast(float, w & 0xffff0000u); }
__device__ __forceinline__ float bf2f(bf16_t v) { return __builtin_bit_cast(float, ((unsigned)v) << 16); }
__device__ __forceinline__ float sigmoidf_(float v) { return __builtin_amdgcn_rcpf(1.0f + __expf(-v)); }
__device__ __forceinline__ float siluf_(float v) { return v * sigmoidf_(v); }
__device__ __forceinline__ float softplusf_(float v) { return fmaxf(v, 0.f) + log1pf(__expf(-fabsf(v))); }
__device__ __forceinline__ u32x4 pack8(const f32x4& a, const f32x4& b) { u32x4 w; w.x = pk2(a[0], a[1]); w.y = pk2(a[2], a[3]); w.z = pk2(b[0], b[1]); w.w = pk2(b[2], b[3]); return w; }
__device__ __forceinline__ void unpack8(const u32x4& w, f32x4& a, f32x4& b) { a[0] = bflo(w.x); a[1] = bfhi(w.x); a[2] = bflo(w.y); a[3] = bfhi(w.y); b[0] = bflo(w.z); b[1] = bfhi(w.z); b[2] = bflo(w.w); b[3] = bfhi(w.w); }

#ifndef PROBE_KMASK
#define PROBE_KMASK 0
#endif
#ifndef STAGGER_TICKS
#define STAGGER_TICKS 0
#endif
namespace pg8 {
constexpr int BM = 256, BK = 64, HALF = 128, HTB = HALF * BK * 2, STAGE_BYTES = 8 * HTB, NXCD = 8, WGM = 8;
__host__ __device__ __forceinline__ int lds_byte(int r, int c) { const int st = (r >> 4) * 2 + (c >> 5), rr = r & 15, cc = c & 31, ob = rr * 64 + cc * 2; return st * 1024 + (ob ^ (((ob >> 9) & 1) << 5)); }
__host__ __device__ __forceinline__ void stage_rc(int b, int& R, int& C) { const int st = b / 1024, sb = b % 1024, swz = sb ^ (((sb >> 9) & 1) << 5); R = (st >> 1) * 16 + swz / 64; C = (st & 1) * 32 + (swz % 64) / 2; }
__host__ __device__ __forceinline__ int perm32(int rho) { const int n = rho >> 4, i = rho & 15; return 8 * (i >> 2) + 4 * n + (i & 3); }
struct Unit { int pm, pn; };
struct Gemm { const bf16_t* A; const bf16_t* Bt; int M, N, K; };
struct StaticOrder {
    int nM, nN, nwg, G, c;
    __host__ __device__ void init(int M, int N, int G_, int c_) { nM = M / BM; nN = N / BM; nwg = nM * nN; G = G_; c = c_; }
    __host__ __device__ bool next(int i, Unit& u) const {
        const long L = (long)i * G + c; if (L >= nwg) return false;
        int wgid = (int)L; { const int q = nwg / NXCD, r = nwg % NXCD, xcd = wgid % NXCD, off = wgid / NXCD; wgid = (xcd < r ? xcd * (q + 1) : r * (q + 1) + (xcd - r) * q) + off; }
        const int nig = WGM * nN, gid = wgid / nig, fm = gid * WGM, gsz = (nM - fm) < WGM ? (nM - fm) : WGM;
        u.pm = fm + ((wgid % nig) % gsz); u.pn = (wgid % nig) / gsz; return true;
    }
};

template <class Epi>
__device__ __forceinline__ void gemm_phase(LAS unsigned char* lds, const Gemm g, const StaticOrder& S, const Epi& E) {
    const int tid = threadIdx.x, wid = __builtin_amdgcn_readfirstlane(tid >> 6), lane = tid & 63, wr = wid >> 2, wc = wid & 3, fr = lane & 15, fq = lane >> 4;
    const int K = g.K, nt = K / BK;
    unsigned voffA[2];
#pragma unroll
    for (int i = 0; i < 2; ++i) { int R, C; stage_rc(tid * 16 + i * 8192, R, C); voffA[i] = (unsigned)(R * K + C) * 2u; }
    const size_t kstep = (size_t)(BK * 2);
    const size_t hstep = (size_t)HALF * K * 2;
    const size_t tstep = 2 * hstep;
    const unsigned ldsw = (unsigned)wid * 1024u;
    const int aoff = lds_byte(wr * 64 + fr, fq * 8), boff = lds_byte(wc * 32 + fr, fq * 8);
#define PG8_SA(b, h) (((b) * 2 + (h)) * HTB)
#define PG8_SB(b, h) ((4 + (b) * 2 + (h)) * HTB)
#define PG8_STAGE(bufoff, gbase, voff) do { _Pragma("unroll") for (int _i = 0; _i < 2; ++_i) \
        __builtin_amdgcn_global_load_lds((const unsigned*)((const char*)(gbase) + (voff)[_i]), (LAS unsigned*)(lds + (bufoff) + ldsw + _i * 8192), 16, 0, 0); } while (0)
#define PG8_LDA(dst, b, h) do { _Pragma("unroll") for (int m = 0; m < 4; ++m) _Pragma("unroll") for (int k = 0; k < 2; ++k) dst[m][k] = *(const LAS bf16x8*)(lds + PG8_SA(b, h) + aoff + m * 2048 + k * 1024); } while (0)
#define PG8_LDB(dst, b, h) do { _Pragma("unroll") for (int n = 0; n < 2; ++n) _Pragma("unroll") for (int k = 0; k < 2; ++k) dst[n][k] = *(const LAS bf16x8*)(lds + PG8_SB(b, h) + boff + n * 2048 + k * 1024); } while (0)
#define PG8_MMA(ai, bj, At, Bt) do { __builtin_amdgcn_s_setprio(1); _Pragma("unroll") for (int m = 0; m < 4; ++m) _Pragma("unroll") for (int n = 0; n < 2; ++n) _Pragma("unroll") for (int k = 0; k < 2; ++k) \
        acc[ai][bj][m][n] = __builtin_amdgcn_mfma_f32_16x16x32_bf16(Bt[n][k], At[m][k], acc[ai][bj][m][n], 0, 0, 0); __builtin_amdgcn_s_setprio(0); } while (0)
#define PG8_WAIT_V(n) asm volatile("s_waitcnt vmcnt(" #n ")" ::: "memory")
#define PG8_WAIT_L(n) asm volatile("s_waitcnt lgkmcnt(" #n ")" ::: "memory")
#define PG8_BAR __builtin_amdgcn_s_barrier()
#define PG8_SCHED __builtin_amdgcn_sched_barrier(0)
    Unit cur, nxt; int ui = 0;
    if (!S.next(0, cur)) return;
    if (STAGGER_TICKS) { const unsigned long long t0 = __builtin_amdgcn_s_memrealtime(), d = (unsigned long long)(blockIdx.x & 7) * STAGGER_TICKS; while (__builtin_amdgcn_s_memrealtime() - t0 < d) __builtin_amdgcn_s_sleep(4); }
    f32x4 acc[2][2][4][2];
#pragma unroll
    for (int a = 0; a < 2; ++a)
#pragma unroll
        for (int b = 0; b < 2; ++b)
#pragma unroll
            for (int m = 0; m < 4; ++m)
#pragma unroll
                for (int n = 0; n < 2; ++n) acc[a][b][m][n] = (f32x4){0.f, 0.f, 0.f, 0.f};
    bf16x8 At[4][2], B0[2][2], B1[2][2];
    const char* cA = (const char*)g.A + (size_t)cur.pm * tstep; const char* cB = (const char*)g.Bt + (size_t)cur.pn * tstep;
    PG8_STAGE(PG8_SB(0, 0), cB, voffA); PG8_STAGE(PG8_SA(0, 0), cA, voffA); PG8_STAGE(PG8_SB(0, 1), cB + hstep, voffA); PG8_STAGE(PG8_SA(0, 1), cA + hstep, voffA);
    if (wr == 1) PG8_BAR;
    PG8_WAIT_V(4); PG8_BAR;
    PG8_STAGE(PG8_SB(1, 0), cB + kstep, voffA); PG8_STAGE(PG8_SA(1, 0), cA + kstep, voffA); PG8_STAGE(PG8_SB(1, 1), cB + hstep + kstep, voffA);
    PG8_WAIT_V(6); PG8_BAR;
    for (;;) {
        const bool has_next = S.next(ui + 1, nxt);
        const char* nA = has_next ? (const char*)g.A + (size_t)nxt.pm * tstep : cA; const char* nB = has_next ? (const char*)g.Bt + (size_t)nxt.pn * tstep : cB;
        unsigned long long kt0_ = 0; if (PROBE_KMASK) kt0_ = __builtin_amdgcn_s_memrealtime();
        for (int t = 0; t < nt; t += 2) {
            const bool last = (t == nt - 2);
            const char* a1 = cA + (size_t)(t + 1) * kstep;
            const char* a2 = last ? nA : cA + (size_t)(t + 2) * kstep; const char* b2 = last ? nB : cB + (size_t)(t + 2) * kstep;
            const char* a3 = a2 + kstep; const char* b3 = b2 + kstep;
            PG8_LDB(B0, 0, 0); PG8_SCHED; PG8_LDA(At, 0, 0); PG8_STAGE(PG8_SA(1, 1), a1 + hstep, voffA);
            PG8_WAIT_L(8); PG8_BAR; PG8_WAIT_L(0); PG8_MMA(0, 0, At, B0); PG8_BAR; PG8_SCHED;
            PG8_LDB(B1, 0, 1); PG8_STAGE(PG8_SB(0, 0), b2, voffA);
            PG8_BAR; PG8_WAIT_L(0); PG8_MMA(0, 1, At, B1); PG8_BAR;
            PG8_LDA(At, 0, 1); PG8_STAGE(PG8_SA(0, 0), a2, voffA);
            PG8_BAR; PG8_WAIT_L(0); PG8_MMA(1, 0, At, B0); PG8_BAR; PG8_SCHED;
            PG8_STAGE(PG8_SB(0, 1), b2 + hstep, voffA);
            PG8_WAIT_V(6); PG8_BAR; PG8_MMA(1, 1, At, B1); PG8_BAR;
            PG8_LDB(B0, 1, 0); PG8_SCHED; PG8_LDA(At, 1, 0); PG8_STAGE(PG8_SA(0, 1), a2 + hstep, voffA);
            PG8_WAIT_L(8); PG8_BAR; PG8_WAIT_L(0); PG8_MMA(0, 0, At, B0); PG8_BAR; PG8_SCHED;
            PG8_LDB(B1, 1, 1); PG8_STAGE(PG8_SB(1, 0), b3, voffA);
            PG8_BAR; PG8_WAIT_L(0); PG8_MMA(0, 1, At, B1); PG8_BAR;
            PG8_LDA(At, 1, 1); PG8_STAGE(PG8_SA(1, 0), a3, voffA);
            PG8_BAR; PG8_WAIT_L(0); PG8_MMA(1, 0, At, B0); PG8_BAR; PG8_SCHED;
            PG8_STAGE(PG8_SB(1, 1), b3 + hstep, voffA);
            PG8_WAIT_V(6); PG8_BAR; PG8_MMA(1, 1, At, B1); PG8_BAR;
        }
        if (PROBE_KMASK && tid == 0) *(LAS unsigned long long*)(lds + 160768 + 8) += __builtin_amdgcn_s_memrealtime() - kt0_;
        E(acc, cur, wr, wc, fr, fq);
        if (!has_next) break;
#pragma unroll
        for (int a = 0; a < 2; ++a)
#pragma unroll
            for (int b = 0; b < 2; ++b)
#pragma unroll
                for (int m = 0; m < 4; ++m)
#pragma unroll
                    for (int n = 0; n < 2; ++n) acc[a][b][m][n] = (f32x4){0.f, 0.f, 0.f, 0.f};
        cur = nxt; cA = nA; cB = nB; ++ui;
    }
    PG8_WAIT_V(0);
    if (wr == 0) PG8_BAR;
    PG8_BAR;
#undef PG8_SA
#undef PG8_SB
#undef PG8_STAGE
#undef PG8_LDA
#undef PG8_LDB
#undef PG8_MMA
#undef PG8_WAIT_V
#undef PG8_WAIT_L
#undef PG8_BAR
#undef PG8_SCHED
}
}
using pg8::Unit;

struct EpiRoute {
    bf16_t *GA, *GB, *BB, *BC, *BH, *ZS, *XBC; float* DT; const float* dt_bias; int tile0;
    __device__ __forceinline__ void operator()(const f32x4 (&acc)[2][2][4][2], const Unit& u, int wr, int wc, int fr, int fq) const {
        const int gt = u.pn + tile0; const int row0 = u.pm * 256 + wr * 64 + fr;
        if (gt >= 24 && gt < 40) {
            const int ch0 = (gt - 24) * 128 + wc * 32 + 8 * fq;
#pragma unroll
            for (int ai = 0; ai < 2; ++ai)
#pragma unroll
                for (int m = 0; m < 4; ++m) *(u32x4*)(BC + (size_t)(row0 + ai * 128 + m * 16) * DM + ch0) = pack8(acc[ai][0][m][0] * acc[ai][1][m][0], acc[ai][0][m][1] * acc[ai][1][m][1]);
        } else if (gt < 80) {
            bf16_t* base; int ldc, cb, act;
            if (gt < 40) { const int r = gt >> 3; base = (r == 0 ? GA : r == 1 ? GB : r == 2 ? BB : r == 3 ? BC : BH); ldc = DM; cb = (gt & 7) * 256; act = r < 2 ? 1 : 0; }
            else if (gt < 56) { base = ZS; ldc = DI; cb = (gt - 40) * 256; act = 2; }
            else { base = XBC; ldc = CONVD; cb = (gt - 56) * 256; act = 0; }
            const int col0 = cb + wc * 32 + 8 * fq;
#pragma unroll
            for (int ai = 0; ai < 2; ++ai)
#pragma unroll
                for (int m = 0; m < 4; ++m) { bf16_t* rowp = base + (size_t)(row0 + ai * 128 + m * 16) * ldc + col0;
#pragma unroll
                    for (int bj = 0; bj < 2; ++bj) { f32x4 v0 = acc[ai][bj][m][0], v1 = acc[ai][bj][m][1];
                        if (act == 1) {
#pragma unroll
                            for (int j = 0; j < 4; ++j) { v0[j] = sigmoidf_(v0[j]); v1[j] = sigmoidf_(v1[j]); } }
                        else if (act == 2) {
#pragma unroll
                            for (int j = 0; j < 4; ++j) { v0[j] = siluf_(v0[j]); v1[j] = siluf_(v1[j]); } }
                        *(u32x4*)(rowp + bj * 128) = pack8(v0, v1); } }
        } else if (wc < 2) {
            const int c0 = wc * 32 + 8 * fq;
            f32x4 b0 = *(const f32x4*)(dt_bias + c0), b1 = *(const f32x4*)(dt_bias + c0 + 4);
#pragma unroll
            for (int ai = 0; ai < 2; ++ai)
#pragma unroll
                for (int m = 0; m < 4; ++m) { float* rowp = DT + (size_t)(row0 + ai * 128 + m * 16) * NH + c0;
                    f32x4 v0 = acc[ai][0][m][0] + b0, v1 = acc[ai][0][m][1] + b1;
#pragma unroll
                    for (int j = 0; j < 4; ++j) { v0[j] = softplusf_(v0[j]); v1[j] = softplusf_(v1[j]); }
                    *(f32x4*)rowp = v0; *(f32x4*)(rowp + 4) = v1; }
        }
    }
};
template <bool ADD> struct EpiGate {
    const bf16_t* GATE; const bf16_t* PREV; bf16_t* O;
    __device__ __forceinline__ void operator()(const f32x4 (&acc)[2][2][4][2], const Unit& u, int wr, int wc, int fr, int fq) const {
        const int row0 = u.pm * 256 + wr * 64 + fr, col0 = u.pn * 256 + wc * 32 + 8 * fq;
        constexpr int MB = ADD ? 2 : 4;
#pragma unroll
        for (int ai = 0; ai < 2; ++ai)
#pragma unroll
            for (int m0 = 0; m0 < 4; m0 += MB) {
                u32x4 gv[MB][2], pv[MB][2];
#pragma unroll
                for (int mm = 0; mm < MB; ++mm)
#pragma unroll
                    for (int bj = 0; bj < 2; ++bj) { const size_t idx = (size_t)(row0 + ai * 128 + (m0 + mm) * 16) * DM + col0 + bj * 128; gv[mm][bj] = *(const u32x4*)(GATE + idx); if (ADD) pv[mm][bj] = *(const u32x4*)(PREV + idx); }
#pragma unroll
                for (int mm = 0; mm < MB; ++mm)
#pragma unroll
                    for (int bj = 0; bj < 2; ++bj) { const size_t idx = (size_t)(row0 + ai * 128 + (m0 + mm) * 16) * DM + col0 + bj * 128;
                        f32x4 g0, g1; unpack8(gv[mm][bj], g0, g1);
                        f32x4 v0 = g0 * acc[ai][bj][m0 + mm][0], v1 = g1 * acc[ai][bj][m0 + mm][1];
                        if (ADD) { f32x4 p0, p1; unpack8(pv[mm][bj], p0, p1); v0 += p0; v1 += p1; }
                        *(u32x4*)(O + idx) = pack8(v0, v1); } }
    }
};
template <bool XBF> struct EpiRes {
    const void* X; bf16_t* HBF; float* ssq;
    __device__ __forceinline__ void operator()(const f32x4 (&acc)[2][2][4][2], const Unit& u, int wr, int wc, int fr, int fq) const {
        const int row0 = u.pm * 256 + wr * 64 + fr, col0 = u.pn * 256 + wc * 32 + 8 * fq;
#pragma unroll
        for (int ai = 0; ai < 2; ++ai) {
            f32x4 xv[4][2][2];
#pragma unroll
            for (int m = 0; m < 4; ++m)
#pragma unroll
                for (int bj = 0; bj < 2; ++bj) { const size_t idx = (size_t)(row0 + ai * 128 + m * 16) * DM + col0 + bj * 128;
                    if (XBF) { const u32x4 r = *(const u32x4*)((const bf16_t*)X + idx); unpack8(r, xv[m][bj][0], xv[m][bj][1]); }
                    else { xv[m][bj][0] = *(const f32x4*)((const float*)X + idx); xv[m][bj][1] = *(const f32x4*)((const float*)X + idx + 4); } }
#pragma unroll
            for (int m = 0; m < 4; ++m) { const int row = row0 + ai * 128 + m * 16; const size_t ro = (size_t)row * DM + col0; float s = 0.f;
#pragma unroll
                for (int bj = 0; bj < 2; ++bj) { const size_t idx = ro + bj * 128;
                    const f32x4 h0 = xv[m][bj][0] + acc[ai][bj][m][0], h1 = xv[m][bj][1] + acc[ai][bj][m][1];
                    *(u32x4*)(HBF + idx) = pack8(h0, h1);
#pragma unroll
                    for (int j = 0; j < 4; ++j) s += h0[j] * h0[j] + h1[j] * h1[j]; }
                s += __shfl_xor(s, 16); s += __shfl_xor(s, 32);
                if (fq == 0) atomicAdd(ssq + row, s); } }
    }
};
struct EpiSwiglu {
    const float* ssq; bf16_t* ACT;
    __device__ __forceinline__ void operator()(const f32x4 (&acc)[2][2][4][2], const Unit& u, int wr, int wc, int fr, int fq) const {
        const int row0 = u.pm * 256 + wr * 64 + fr, ch0 = u.pn * 128 + wc * 32 + 8 * fq;
        float rs[2][4];
#pragma unroll
        for (int ai = 0; ai < 2; ++ai)
#pragma unroll
            for (int m = 0; m < 4; ++m) rs[ai][m] = ssq[row0 + ai * 128 + m * 16];
#pragma unroll
        for (int ai = 0; ai < 2; ++ai)
#pragma unroll
            for (int m = 0; m < 4; ++m) rs[ai][m] = rsqrtf(rs[ai][m] * (1.0f / DM) + EPS);
#pragma unroll
        for (int ai = 0; ai < 2; ++ai)
#pragma unroll
            for (int m = 0; m < 4; ++m) { const int row = row0 + ai * 128 + m * 16; const float r = rs[ai][m];
                f32x4 v0, v1;
#pragma unroll
                for (int j = 0; j < 4; ++j) { v0[j] = siluf_(acc[ai][0][m][0][j] * r) * (acc[ai][1][m][0][j] * r); v1[j] = siluf_(acc[ai][0][m][1][j] * r) * (acc[ai][1][m][1][j] * r); }
                *(u32x4*)(ACT + (size_t)row * DFF + ch0) = pack8(v0, v1); }
    }
};

__device__ __forceinline__ int slot2lc(int slot) { return (slot & ~31) + pg8::perm32(slot & 31); }
__device__ __forceinline__ void conv_tile(LAS float* tile, const float* src0, const float* src1, int ldsrc, int nvalid, int K, bf16_t* dst, const float* kscale, int mode, int nt, int kt) {
    const int tid = threadIdx.x;
    { const int j = tid & 63, i0 = tid >> 6; const int nrow = nt * 64 + j, t256 = nrow >> 8, lc = slot2lc(nrow & 255);
      const float* s; int col; bool valid;
      if (mode == 0) { col = t256 * 256 + lc; s = src0; valid = col < nvalid; } else { col = t256 * 128 + (lc & 127); s = (lc >> 7) ? src1 : src0; valid = true; }
      if (!valid) col = 0;
      const float* sp = s + (size_t)(kt * 256 + i0) * ldsrc + col;
      float v[32];
#pragma unroll
      for (int ii = 0; ii < 32; ++ii) v[ii] = __builtin_nontemporal_load(sp + (size_t)(8 * ii) * ldsrc);
#pragma unroll
      for (int ii = 0; ii < 32; ++ii) { const int kl = i0 + 8 * ii; float x = valid ? v[ii] : 0.f; if (kscale) x *= kscale[kt * 256 + kl]; tile[j * 257 + kl] = x; } }
    __syncthreads();
    { const int kk = (tid & 127) * 2, j0 = tid >> 7;
#pragma unroll
      for (int it = 0; it < 16; ++it) { const int j = j0 + 4 * it; *(unsigned*)(dst + (size_t)(nt * 64 + j) * K + kt * 256 + kk) = pk2(tile[j * 257 + kk], tile[j * 257 + kk + 1]); } }
    __syncthreads();
}

__device__ __forceinline__ void phase_prep(const Params& p, LAS unsigned char* lds) {
    LAS float* tile = (LAS float*)lds; unsigned char* ws = p.ws;
    constexpr int N0 = 324 * 8, N1 = N0 + 32 * 8, N2 = N1 + 32 * 16, N3 = N2 + 32 * 8, N4 = N3 + 176 * 8, N5 = N4 + 32 * 22;
    for (int it = blockIdx.x; it < N5; it += gridDim.x) {
        if (it < N0)      { const int i = it, nt = i / 8, kt = i % 8;
            if (nt < 96 || nt >= 160) conv_tile(tile, p.w_in, nullptr, IN_COLS, IN_COLS, DM, (bf16_t*)(ws + OFF_WIN), nullptr, 0, nt, kt);
            else conv_tile(tile, p.w_in + 6144, p.w_in + 8192, IN_COLS, IN_COLS, DM, (bf16_t*)(ws + OFF_WIN) + (size_t)24 * 256 * DM, nullptr, 1, nt - 96, kt); }
        else if (it < N1) { const int i = it - N0; conv_tile(tile, p.w_out_a, nullptr, DM, DM, DM, (bf16_t*)(ws + OFF_WOA), nullptr, 0, i / 8, i % 8); }
        else if (it < N2) { const int i = it - N1; conv_tile(tile, p.w_out_ssm, nullptr, DM, DM, DI, (bf16_t*)(ws + OFF_WOS), nullptr, 0, i / 16, i % 16); }
        else if (it < N3) { const int i = it - N2; conv_tile(tile, p.w_o, nullptr, DM, DM, DM, (bf16_t*)(ws + OFF_WO), nullptr, 0, i / 8, i % 8); }
        else if (it < N4) { const int i = it - N3; conv_tile(tile, p.w_ffn_gate, p.w_ffn_up, DFF, DFF, DM, (bf16_t*)(ws + OFF_WGU), p.norm_ffn_g, 1, i / 8, i % 8); }
        else              { const int i = it - N4; conv_tile(tile, p.w_ffn_down, nullptr, DM, DM, DFF, (bf16_t*)(ws + OFF_WDN), nullptr, 0, i / 22, i % 22); }
    }
    { float* s1 = (float*)(ws + OFF_SSQ1); for (int i = blockIdx.x * 512 + threadIdx.x; i < 2 * NTOK; i += gridDim.x * 512) s1[i] = 0.f; }
    { const int wave = threadIdx.x >> 6, lane = threadIdx.x & 63; bf16_t* U = (bf16_t*)(ws + OFF_U);
      for (int row = (blockIdx.x * 8 + wave) * 2; row < NTOK; row += gridDim.x * 16) {
          const f32x4* xr = (const f32x4*)(p.x + (size_t)row * DM); f32x4 v[16]; float ss0 = 0.f, ss1 = 0.f;
#pragma unroll
          for (int i = 0; i < 16; ++i) v[i] = __builtin_nontemporal_load(xr + lane + 64 * i);
#pragma unroll
          for (int i = 0; i < 8; ++i) { ss0 += v[i][0] * v[i][0] + v[i][1] * v[i][1] + v[i][2] * v[i][2] + v[i][3] * v[i][3]; ss1 += v[8 + i][0] * v[8 + i][0] + v[8 + i][1] * v[8 + i][1] + v[8 + i][2] * v[8 + i][2] + v[8 + i][3] * v[8 + i][3]; }
#pragma unroll
          for (int o = 32; o >= 1; o >>= 1) { ss0 += __shfl_xor(ss0, o); ss1 += __shfl_xor(ss1, o); }
          const float r0 = rsqrtf(ss0 * (1.0f / DM) + EPS), r1 = rsqrtf(ss1 * (1.0f / DM) + EPS);
#pragma unroll
          for (int i = 0; i < 16; ++i) { const float r = i < 8 ? r0 : r1; const f32x4 gg = ((const f32x4*)p.norm_mix_g)[lane + 64 * (i & 7)]; u32x2 w; w.x = pk2(v[i][0] * r * gg[0], v[i][1] * r * gg[1]); w.y = pk2(v[i][2] * r * gg[2], v[i][3] * r * gg[3]);
              *(u32x2*)(U + (size_t)row * DM + (lane + 64 * i) * 4) = w; } } }
}

__device__ __forceinline__ void ssmconv_load(const bf16_t* XBC, int idx, u32x4 (&raw)[11]) {
    const int t0 = (idx / 768) * 8, c = (idx % 768) * 8; const bool first = (t0 & (SEQ - 1)) == 0;
#pragma unroll
    for (int r = 0; r < 11; ++r) raw[r] = (r < 3 && first) ? (u32x4){0u, 0u, 0u, 0u} : *(const u32x4*)(XBC + (size_t)(t0 - 3 + r) * CONVD + c);
}
__device__ __forceinline__ void ssmconv_compute(const Params& p, bf16_t* XS, bf16_t* BCS, int idx, const u32x4 (&raw)[11]) {
    const int t0 = (idx / 768) * 8, c = (idx % 768) * 8;
    f32x4 w0[4], w1[4];
#pragma unroll
    for (int j = 0; j < 4; ++j) { w0[j] = *(const f32x4*)(p.ssm_conv_w + j * CONVD + c); w1[j] = *(const f32x4*)(p.ssm_conv_w + j * CONVD + c + 4); }
    const f32x4 b0 = *(const f32x4*)(p.ssm_conv_b + c), b1 = *(const f32x4*)(p.ssm_conv_b + c + 4);
    bf16_t* dst = (c < DI) ? XS + (size_t)t0 * DI + c : BCS + (size_t)t0 * 2048 + (c - DI); const int ldd = (c < DI) ? DI : 2048;
#pragma unroll
    for (int i = 0; i < 8; ++i) { f32x4 a0 = b0, a1 = b1;
#pragma unroll
        for (int j = 0; j < 4; ++j) { f32x4 r0, r1; unpack8(raw[i + j], r0, r1); a0 += w0[j] * r0; a1 += w1[j] * r1; }
#pragma unroll
        for (int j = 0; j < 4; ++j) { a0[j] = siluf_(a0[j]); a1[j] = siluf_(a1[j]); }
        *(u32x4*)(dst + (size_t)i * ldd) = pack8(a0, a1); }
}
__device__ __forceinline__ void phase_ssmconv(const Params& p) {
    const bf16_t* XBC = (const bf16_t*)(p.ws + OFF_XBC); bf16_t* XS = (bf16_t*)p.out; bf16_t* BCS = (bf16_t*)(p.ws + OFF_BCS);
    const int total = (NTOK / 8) * 768, stride = gridDim.x * 512;
    int idx = blockIdx.x * 512 + threadIdx.x;
    u32x4 ra[11], rb[11];
    if (idx < total) ssmconv_load(XBC, idx, ra);
    while (idx < total) {
        const int i1 = idx + stride, i2 = idx + 2 * stride;
        if (i1 < total) ssmconv_load(XBC, i1, rb);
        ssmconv_compute(p, XS, BCS, idx, ra);
        if (i1 >= total) break;
        if (i2 < total) ssmconv_load(XBC, i2, ra);
        ssmconv_compute(p, XS, BCS, i1, rb);
        idx = i2;
    }
}

__device__ __forceinline__ void phase_ssd_seq(const Params& p, LAS unsigned char* lds) {
    LAS float* part = (LAS float*)lds;
    const int tid = threadIdx.x, pp = tid >> 3, ng = tid & 7, wave = tid >> 6, lane = tid & 63;
    const bf16_t* XS = (const bf16_t*)p.out; const bf16_t* BCS = (const bf16_t*)(p.ws + OFF_BCS); bf16_t* ZS = (bf16_t*)(p.ws + OFF_ZS);
    const float* DT = (const float*)(p.ws + OFF_DT); float* SSQH = (float*)(p.ws + OFF_SSQH);
    for (int item = blockIdx.x; item < 256; item += gridDim.x) {
        const int b = item >> 6, h = item & 63, g = h >> 3;
        const float a = -__expf(p.a_log[h]), Dk = p.d_skip[h];
        const bf16_t* xs = XS + (size_t)b * SEQ * DI + h * 64 + pp;
        const bf16_t* Bs = BCS + (size_t)b * SEQ * 2048 + g * 128 + ng * 16;
        const bf16_t* Cs = Bs + 1024;
        bf16_t* zs = ZS + (size_t)b * SEQ * DI + h * 64 + pp;
        const float* dt = DT + (size_t)b * SEQ * NH + h;
        float st[16];
#pragma unroll
        for (int i = 0; i < 16; ++i) st[i] = 0.f;
        for (int t0 = 0; t0 < SEQ; t0 += 64) {
#pragma unroll 4
            for (int tt = 0; tt < 64; ++tt) {
                const int t = t0 + tt;
                const float dtv = dt[(size_t)t * NH], xv = bf2f(xs[(size_t)t * DI]), zv = bf2f(zs[(size_t)t * DI]);
                f32x4 B0, B1, B2, B3, C0, C1, C2, C3;
                unpack8(*(const u32x4*)(Bs + (size_t)t * 2048), B0, B1); unpack8(*(const u32x4*)(Bs + (size_t)t * 2048 + 8), B2, B3);
                unpack8(*(const u32x4*)(Cs + (size_t)t * 2048), C0, C1); unpack8(*(const u32x4*)(Cs + (size_t)t * 2048 + 8), C2, C3);
                const float dA = __expf(dtv * a), xdt = xv * dtv; float y = 0.f;
#pragma unroll
                for (int i = 0; i < 4; ++i) {
                    st[i] = dA * st[i] + xdt * B0[i]; y += C0[i] * st[i];
                    st[4 + i] = dA * st[4 + i] + xdt * B1[i]; y += C1[i] * st[4 + i];
                    st[8 + i] = dA * st[8 + i] + xdt * B2[i]; y += C2[i] * st[8 + i];
                    st[12 + i] = dA * st[12 + i] + xdt * B3[i]; y += C3[i] * st[12 + i]; }
                y += __shfl_xor(y, 1); y += __shfl_xor(y, 2); y += __shfl_xor(y, 4);
                y += Dk * xv;
                const float yz = y * zv;
                if (ng == 0) zs[(size_t)t * DI] = (bf16_t)f2bf(yz);
                float sq = (ng == 0) ? yz * yz : 0.f;
                sq += __shfl_xor(sq, 8); sq += __shfl_xor(sq, 16); sq += __shfl_xor(sq, 32);
                if (lane == 0) part[tt * 8 + wave] = sq;
            }
            __syncthreads();
            if (tid < 64) { float s = 0.f;
#pragma unroll
                for (int w = 0; w < 8; ++w) s += part[tid * 8 + w];
                SSQH[(size_t)(b * SEQ + t0 + tid) * NH + h] = s; }
            __syncthreads();
        }
    }
}

typedef short s16x4 __attribute__((ext_vector_type(4)));
constexpr int SS_RSB = 272, SS_RSX = 144;
constexpr int SS_C = 0, SS_B = 34816, SS_X = 69632, SS_XW = 88064, SS_S = 106496, SS_SC = 123904, SS_M = 125952, SS_END = 160768;
__device__ __forceinline__ bf16x8 tr_frag(LAS unsigned char* lds, int addr, int step) {
    const s16x4 lo = __builtin_amdgcn_ds_read_tr16_b64_v4i16((LAS s16x4*)(lds + addr));
    const s16x4 hi = __builtin_amdgcn_ds_read_tr16_b64_v4i16((LAS s16x4*)(lds + addr + step));
    return __builtin_shufflevector(lo, hi, 0, 1, 2, 3, 4, 5, 6, 7);
}
#define MFMA16(a, b, c) __builtin_amdgcn_mfma_f32_16x16x32_bf16(a, b, c, 0, 0, 0)
#define WG_BAR() do { asm volatile("s_waitcnt lgkmcnt(0)" ::: "memory"); __builtin_amdgcn_s_barrier(); asm volatile("" ::: "memory"); } while (0)
__device__ __forceinline__ void phase_ssd_chunk(const Params& p, LAS unsigned char* lds) {
    const int tid = threadIdx.x, w = __builtin_amdgcn_readfirstlane(tid >> 6), lane = tid & 63, fr = lane & 15, g4 = lane >> 4, q = fr >> 2, pq = fr & 3;
    const bf16_t* XS = (const bf16_t*)p.out; const bf16_t* BCS = (const bf16_t*)(p.ws + OFF_BCS); bf16_t* ZS = (bf16_t*)(p.ws + OFF_ZS);
    const float* DT = (const float*)(p.ws + OFF_DT); float* SSQH = (float*)(p.ws + OFF_SSQH);
    LAS float* scal = (LAS float*)(lds + SS_SC);
    const int l = 16 * w + fr;
    for (int item = blockIdx.x; item < 256; item += gridDim.x) {
        const int b = item >> 6, grp = item & 7, h = grp * 8 + ((item >> 3) & 7);
        const float a = -__expf(p.a_log[h]), Dk = p.d_skip[h];
        f32x4 accS[4];
#pragma unroll
        for (int i = 0; i < 4; ++i) accS[i] = (f32x4){0.f, 0.f, 0.f, 0.f};
        u32x4 pb[4], pc[4], px[2]; float d0 = 0.f, d1 = 0.f;
        const bf16_t* bsrc = BCS + (size_t)(b * SEQ + (tid >> 4)) * 2048 + grp * 128 + (tid & 15) * 8;
        const bf16_t* xsrc = XS + (size_t)(b * SEQ + (tid >> 3)) * DI + h * 64 + (tid & 7) * 8;
        const float* dsrc = DT + (size_t)(b * SEQ + lane) * NH + h;
#define SSD_PREFETCH(c_) do { const size_t ro_ = (size_t)(c_) * 128; \
            _Pragma("unroll") for (int i = 0; i < 4; ++i) { pb[i] = *(const u32x4*)(bsrc + (ro_ + 32 * i) * 2048); pc[i] = *(const u32x4*)(bsrc + (ro_ + 32 * i) * 2048 + 1024); } \
            _Pragma("unroll") for (int i = 0; i < 2; ++i) px[i] = *(const u32x4*)(xsrc + (ro_ + 64 * i) * DI); \
            if (w == 0) { d0 = dsrc[ro_ * NH]; d1 = dsrc[(ro_ + 64) * NH]; } } while (0)
#define SSD_SCAN(buf_) do { if (w == 0) { float s0 = d0 * a, s1 = d1 * a; \
            _Pragma("unroll") for (int o = 1; o < 64; o <<= 1) { const float t0 = __shfl_up(s0, o), t1 = __shfl_up(s1, o); if (lane >= o) { s0 += t0; s1 += t1; } } \
            s1 += __shfl(s0, 63); LAS float* cs_ = scal + (buf_) * 256; cs_[lane] = s0; cs_[64 + lane] = s1; cs_[128 + lane] = d0; cs_[192 + lane] = d1; } } while (0)
        SSD_PREFETCH(0);
        for (int i = tid; i < 64 * SS_RSB / 16; i += 512) *(LAS u32x4*)(lds + SS_S + i * 16) = (u32x4){0u, 0u, 0u, 0u};
        SSD_SCAN(0);
        WG_BAR();
        for (int c = 0; c < 32; ++c) {
            const int tok0 = b * SEQ + c * 128;
            LAS float* csA = scal + (c & 1) * 256; LAS float* dtA = csA + 128;
            const float csend = csA[127];
#pragma unroll
            for (int i = 0; i < 4; ++i) { const int row = (tid >> 4) + 32 * i, ch = tid & 15; *(LAS u32x4*)(lds + SS_B + row * SS_RSB + ch * 16) = pb[i]; *(LAS u32x4*)(lds + SS_C + row * SS_RSB + ch * 16) = pc[i]; }
#pragma unroll
            for (int i = 0; i < 2; ++i) { const int row = (tid >> 3) + 64 * i, ch = tid & 7; *(LAS u32x4*)(lds + SS_X + row * SS_RSX + ch * 16) = px[i];
                const float wl = __expf(csend - csA[row]) * dtA[row]; f32x4 v0, v1; unpack8(px[i], v0, v1); v0 *= wl; v1 *= wl; *(LAS u32x4*)(lds + SS_XW + row * SS_RSX + ch * 16) = pack8(v0, v1); }
            WG_BAR();
            if (c + 1 < 32) SSD_PREFETCH(c + 1);
            const size_t tok = (size_t)(tok0 + l);
            bf16_t* zp = ZS + tok * DI + h * 64 + 4 * g4;
            u32x2 z2[4];
#pragma unroll
            for (int pt = 0; pt < 4; ++pt) z2[pt] = *(const u32x2*)(zp + 16 * pt);
            const float csl = csA[l];
            bf16x8 cf[4];
#pragma unroll
            for (int ks = 0; ks < 4; ++ks) cf[ks] = *(const LAS bf16x8*)(lds + SS_C + l * SS_RSB + (4 * ks + g4) * 16);
            f32x4 accY[4];
            { bf16x8 sf[4][4];
#pragma unroll
              for (int pt = 0; pt < 4; ++pt)
#pragma unroll
                  for (int ks = 0; ks < 4; ++ks) sf[pt][ks] = *(const LAS bf16x8*)(lds + SS_S + (16 * pt + fr) * SS_RSB + (4 * ks + g4) * 16);
#pragma unroll
              for (int pt = 0; pt < 4; ++pt) accY[pt] = (f32x4){0.f, 0.f, 0.f, 0.f};
#pragma unroll
              for (int ks = 0; ks < 4; ++ks)
#pragma unroll
                  for (int pt = 0; pt < 4; ++pt) accY[pt] = MFMA16(sf[pt][ks], cf[ks], accY[pt]);
              const float el = __expf(csl);
#pragma unroll
              for (int pt = 0; pt < 4; ++pt) accY[pt] *= el; }
#pragma unroll
            for (int sp = 0; sp < 4; ++sp) {
                if (2 * sp <= w) {
                    bf16x8 bfr[2][4];
#pragma unroll
                    for (int e = 0; e < 2; ++e)
#pragma unroll
                        for (int ks = 0; ks < 4; ++ks) bfr[e][ks] = *(const LAS bf16x8*)(lds + SS_B + (16 * (2 * sp + e) + fr) * SS_RSB + (4 * ks + g4) * 16);
                    f32x4 cs4[2], dt4[2];
#pragma unroll
                    for (int e = 0; e < 2; ++e) { cs4[e] = *(const LAS f32x4*)(csA + 16 * (2 * sp + e) + 4 * g4); dt4[e] = *(const LAS f32x4*)(dtA + 16 * (2 * sp + e) + 4 * g4); }
                    f32x4 a1[2] = {(f32x4){0.f, 0.f, 0.f, 0.f}, (f32x4){0.f, 0.f, 0.f, 0.f}};
#pragma unroll
                    for (int ks = 0; ks < 4; ++ks)
#pragma unroll
                        for (int e = 0; e < 2; ++e) a1[e] = MFMA16(bfr[e][ks], cf[ks], a1[e]);
#pragma unroll
                    for (int e = 0; e < 2; ++e) { float v[4];
#pragma unroll
                        for (int r = 0; r < 4; ++r) { const int s = 16 * (2 * sp + e) + 4 * g4 + r; const float t = a1[e][r] * __expf(fminf(csl - cs4[e][r], 0.f)) * dt4[e][r]; v[r] = (s <= l) ? t : 0.f; }
                        u32x2 pk; pk.x = pk2(v[0], v[1]); pk.y = pk2(v[2], v[3]); *(LAS u32x2*)(lds + SS_M + l * SS_RSB + (16 * (2 * sp + e) + 4 * g4) * 2) = pk; } } }
            { const float dec = __expf(csend);
#pragma unroll
              for (int pt = 0; pt < 4; ++pt) accS[pt] *= dec;
#pragma unroll
              for (int kp = 0; kp < 2; ++kp) { bf16x8 btf[2], xwf[2][4];
#pragma unroll
                  for (int e = 0; e < 2; ++e) { const int ks = 2 * kp + e; btf[e] = tr_frag(lds, SS_B + (32 * ks + 8 * g4 + q) * SS_RSB + (16 * w + 4 * pq) * 2, 4 * SS_RSB);
#pragma unroll
                      for (int pt = 0; pt < 4; ++pt) xwf[e][pt] = tr_frag(lds, SS_XW + (32 * ks + 8 * g4 + q) * SS_RSX + (16 * pt + 4 * pq) * 2, 4 * SS_RSX); }
#pragma unroll
                  for (int e = 0; e < 2; ++e)
#pragma unroll
                      for (int pt = 0; pt < 4; ++pt) accS[pt] = MFMA16(btf[e], xwf[e][pt], accS[pt]); } }
            if (c + 1 < 32) SSD_SCAN((c + 1) & 1);
#pragma unroll
            for (int ks = 0; ks < 4; ++ks) { if (2 * ks <= w) { const bf16x8 mf = *(const LAS bf16x8*)(lds + SS_M + l * SS_RSB + (4 * ks + g4) * 16); bf16x8 xf[4];
#pragma unroll
                for (int pt = 0; pt < 4; ++pt) xf[pt] = tr_frag(lds, SS_X + (32 * ks + 8 * g4 + q) * SS_RSX + (16 * pt + 4 * pq) * 2, 4 * SS_RSX);
#pragma unroll
                for (int pt = 0; pt < 4; ++pt) accY[pt] = MFMA16(xf[pt], mf, accY[pt]); } }
            { float sq = 0.f;
#pragma unroll
              for (int pt = 0; pt < 4; ++pt) { const u32x2 x2 = *(const LAS u32x2*)(lds + SS_X + l * SS_RSX + (16 * pt + 4 * g4) * 2);
                  const float y0 = (accY[pt][0] + Dk * bflo(x2.x)) * bflo(z2[pt].x), y1 = (accY[pt][1] + Dk * bfhi(x2.x)) * bfhi(z2[pt].x), y2 = (accY[pt][2] + Dk * bflo(x2.y)) * bflo(z2[pt].y), y3 = (accY[pt][3] + Dk * bfhi(x2.y)) * bfhi(z2[pt].y);
                  sq += y0 * y0 + y1 * y1 + y2 * y2 + y3 * y3; u32x2 o; o.x = pk2(y0, y1); o.y = pk2(y2, y3); *(u32x2*)(zp + 16 * pt) = o; }
              sq += __shfl_xor(sq, 16); sq += __shfl_xor(sq, 32);
              if (g4 == 0) SSQH[tok * NH + h] = sq; }
            WG_BAR();
#pragma unroll
            for (int pt = 0; pt < 4; ++pt) { u32x2 pk; pk.x = pk2(accS[pt][0], accS[pt][1]); pk.y = pk2(accS[pt][2], accS[pt][3]); *(LAS u32x2*)(lds + SS_S + (16 * pt + fr) * SS_RSB + (16 * w + 4 * g4) * 2) = pk; }
        }
        WG_BAR();
#undef SSD_PREFETCH
#undef SSD_SCAN
    }
}

__device__ __forceinline__ void phase_gnorm(const Params& p) {
    bf16_t* ZS = (bf16_t*)(p.ws + OFF_ZS); const float* SSQH = (const float*)(p.ws + OFF_SSQH);
    const int total = NTOK * 512 / 4;
    for (int idx = blockIdx.x * 512 + threadIdx.x; idx < total; idx += gridDim.x * 512) {
        const int t0 = (idx >> 9) * 4, cg8 = idx & 511, c = cg8 * 8, g = cg8 >> 6;
        u32x4 raw[4]; f32x4 s0[4], s1[4];
#pragma unroll
        for (int i = 0; i < 4; ++i) { raw[i] = *(const u32x4*)(ZS + (size_t)(t0 + i) * DI + c); s0[i] = *(const f32x4*)(SSQH + (size_t)(t0 + i) * NH + g * 8); s1[i] = *(const f32x4*)(SSQH + (size_t)(t0 + i) * NH + g * 8 + 4); }
        const f32x4 g0 = *(const f32x4*)(p.ssm_norm_g + c), g1 = *(const f32x4*)(p.ssm_norm_g + c + 4);
#pragma unroll
        for (int i = 0; i < 4; ++i) { const float ss = s0[i][0] + s0[i][1] + s0[i][2] + s0[i][3] + s1[i][0] + s1[i][1] + s1[i][2] + s1[i][3]; const float r = rsqrtf(ss * (1.0f / 512.0f) + EPS);
            f32x4 v0, v1; unpack8(raw[i], v0, v1); v0 = v0 * r * g0; v1 = v1 * r * g1; *(u32x4*)(ZS + (size_t)(t0 + i) * DI + c) = pack8(v0, v1); }
    }
}

struct MixaBuf { u32x4 rq[10], rb[8]; };
__device__ __forceinline__ void mixa_load(const bf16_t* BB, const bf16_t* CH, int idx, MixaBuf& m) {
    const int t0 = (idx >> 8) * 8, c = (idx & 255) * 8; const bool first = (t0 & (SEQ - 1)) == 0;
#pragma unroll
    for (int r = 0; r < 10; ++r) m.rq[r] = (r < 2 && first) ? (u32x4){0u, 0u, 0u, 0u} : *(const u32x4*)(CH + (size_t)(t0 - 2 + r) * DM + c);
#pragma unroll
    for (int i = 0; i < 8; ++i) m.rb[i] = *(const u32x4*)(BB + (size_t)(t0 + i) * DM + c);
}
__device__ __forceinline__ void mixa_compute(const Params& p, bf16_t* YA, int idx, const MixaBuf& m) {
    const int t0 = (idx >> 8) * 8, c = (idx & 255) * 8;
    f32x4 w0[3], w1[3];
#pragma unroll
    for (int j = 0; j < 3; ++j) { w0[j] = *(const f32x4*)(p.conv_a_w + j * DM + c); w1[j] = *(const f32x4*)(p.conv_a_w + j * DM + c + 4); }
    f32x4 q0[3], q1[3];
#pragma unroll
    for (int r = 0; r < 2; ++r) unpack8(m.rq[r], q0[r], q1[r]);
#pragma unroll
    for (int i = 0; i < 8; ++i) { unpack8(m.rq[i + 2], q0[2], q1[2]);
        const f32x4 a0 = w0[0] * q0[0] + w0[1] * q0[1] + w0[2] * q0[2], a1 = w1[0] * q1[0] + w1[1] * q1[1] + w1[2] * q1[2];
        f32x4 b0, b1; unpack8(m.rb[i], b0, b1);
        *(u32x4*)(YA + (size_t)(t0 + i) * DM + c) = pack8(a0 * b0, a1 * b1);
        q0[0] = q0[1]; q0[1] = q0[2]; q1[0] = q1[1]; q1[1] = q1[2]; }
}
__device__ __forceinline__ void phase_mixa(const Params& p) {
    const bf16_t* BB = (const bf16_t*)(p.ws + OFF_BB); const bf16_t* CH = (const bf16_t*)(p.ws + OFF_BC); bf16_t* YA = (bf16_t*)(p.ws + OFF_U);
    const int total = (NTOK / 8) * 256, stride = gridDim.x * 512;
    int idx = blockIdx.x * 512 + threadIdx.x;
    MixaBuf ma, mb;
    if (idx < total) mixa_load(BB, CH, idx, ma);
    while (idx < total) {
        const int i1 = idx + stride, i2 = idx + 2 * stride;
        if (i1 < total) mixa_load(BB, CH, i1, mb);
        mixa_compute(p, YA, idx, ma);
        if (i1 >= total) break;
        if (i2 < total) mixa_load(BB, CH, i2, ma);
        mixa_compute(p, YA, i1, mb);
        idx = i2;
    }
}

__device__ __forceinline__ void phase_final(const Params& p) {
    const float* SSQ2 = (const float*)(p.ws + OFF_SSQ2); const bf16_t* H2 = (const bf16_t*)(p.ws + OFF_BB);
    const int total = NTOK * 256 / 4;
    for (int idx = blockIdx.x * 512 + threadIdx.x; idx < total; idx += gridDim.x * 512) {
        const int t0 = (idx >> 8) * 4, c = (idx & 255) * 8;
        u32x4 v[4]; float r[4];
#pragma unroll
        for (int i = 0; i < 4; ++i) { v[i] = *(const u32x4*)(H2 + (size_t)(t0 + i) * DM + c); r[i] = SSQ2[t0 + i]; }
        const f32x4 g0 = *(const f32x4*)(p.norm_final_g + c), g1 = *(const f32x4*)(p.norm_final_g + c + 4);
#pragma unroll
        for (int i = 0; i < 4; ++i) { const float rr = rsqrtf(r[i] * (1.0f / DM) + EPS); f32x4 a0, a1; unpack8(v[i], a0, a1);
            *(f32x4*)(p.out + (size_t)(t0 + i) * DM + c) = a0 * rr * g0; *(f32x4*)(p.out + (size_t)(t0 + i) * DM + c + 4) = a1 * rr * g1; }
    }
}

#define XB_TMO      128
#define XB_XCNT(j)  (256  + 64 * (j))
#define XB_XSUB(j)  (1280 + 64 * (j))
#define XB_XGEN(j)  (2304 + 64 * (j))
#define XB_TOP      3328
#define XB_TOPGEN   3392
#define XCD_BAR_WORDS 3456
#define XB_SPIN_CAP (1u << 18)

__device__ __forceinline__ unsigned xb_ld(unsigned* p)              { return __hip_atomic_load(p, __ATOMIC_RELAXED, __HIP_MEMORY_SCOPE_AGENT); }
__device__ __forceinline__ unsigned xb_add(unsigned* p, unsigned v) { return __hip_atomic_fetch_add(p, v, __ATOMIC_RELAXED, __HIP_MEMORY_SCOPE_AGENT); }
__device__ __forceinline__ unsigned xb_xcc_id() { return (unsigned)__builtin_amdgcn_s_getreg((3 << 11) | 20) & 0xFu; }
#define XB_SPIN(cond, bar) do { unsigned _sp = 0; while (cond) { __builtin_amdgcn_s_sleep(1); \
    if ((++_sp & 255u) == 0u) { if (xb_ld(&(bar)[XB_TMO])) break; if (_sp > XB_SPIN_CAP) { atomicAdd(&(bar)[XB_TMO], 1u); break; } } } } while (0)

struct XcdBarrier {
    unsigned* bar; unsigned x;
    volatile LAS unsigned* st;
};

__device__ __forceinline__ XcdBarrier xcd_barrier_post(unsigned* bar, volatile LAS unsigned* st) {
    XcdBarrier b; b.bar = bar; b.x = xb_xcc_id(); b.st = st;
    if (threadIdx.x == 0) (void)xb_add(&bar[XB_XCNT(b.x)], 1u);
    return b;
}
__device__ __forceinline__ void xcd_barrier_complete(unsigned* bar, unsigned x, unsigned& nloc, unsigned& nx) {
    const unsigned G = gridDim.x * gridDim.y * gridDim.z;
    unsigned sum, cnt, mine, sp = 0u;
    for (;;) {
        sum = 0u; cnt = 0u; mine = 0u;
#pragma unroll
        for (unsigned j = 0; j < 16; ++j) { const unsigned c = xb_ld(&bar[XB_XCNT(j)]); sum += c; cnt += (c > 0u) ? 1u : 0u; mine = (j == x) ? c : mine; }
        if (sum == G) break;
        __builtin_amdgcn_s_sleep(1);
        if ((++sp & 255u) == 0u) { if (xb_ld(&bar[XB_TMO])) break; if (sp > XB_SPIN_CAP) { atomicAdd(&bar[XB_TMO], 1u); break; } }
    }
    nloc = mine > 0u ? mine : 1u; nx = cnt > 0u ? cnt : 1u;
}

__device__ __forceinline__ void xcd_barrier(const XcdBarrier& b) {
    asm volatile("s_waitcnt vmcnt(0)" ::: "memory");
    __syncthreads();
    if (threadIdx.x == 0) {
        unsigned* bar = b.bar;
        __builtin_amdgcn_s_waitcnt(0);
        unsigned nloc = b.st[0], nx = b.st[1];
        if (nloc == 0u) { xcd_barrier_complete(bar, b.x, nloc, nx); b.st[0] = nloc; b.st[1] = nx; }
        const unsigned old = xb_add(&bar[XB_XSUB(b.x)], 1u);
        const unsigned gen = old / nloc;
        if (old + 1u == (gen + 1u) * nloc) {
            __builtin_amdgcn_fence(__ATOMIC_RELEASE, "agent");
            asm volatile("s_waitcnt vmcnt(0)" ::: "memory");
            const unsigned og = xb_add(&bar[XB_TOP], 1u);
            const unsigned tg = og / nx;
            if (og + 1u == (tg + 1u) * nx) xb_add(&bar[XB_TOPGEN], 1u);
            else XB_SPIN(xb_ld(&bar[XB_TOPGEN]) == tg, bar);
            __builtin_amdgcn_fence(__ATOMIC_ACQUIRE, "agent");
            xb_add(&bar[XB_XGEN(b.x)], 1u);
            asm volatile("s_waitcnt vmcnt(0)" ::: "memory");
        } else {
            XB_SPIN(xb_ld(&bar[XB_XGEN(b.x)]) == gen, bar);
            __builtin_amdgcn_fence(__ATOMIC_ACQUIRE, "agent");
            asm volatile("s_waitcnt vmcnt(0)" ::: "memory");
        }
    }
    __syncthreads();
}

constexpr int NPHASE = 11;
template <int PH> __device__ __forceinline__ void run_phase(const Params& p, LAS unsigned char* lds) {
    unsigned char* ws = p.ws;
    pg8::StaticOrder S; pg8::Gemm g;
    if constexpr (PH == 0) { phase_prep(p, lds); }
    else if constexpr (PH == 1) {
        g.A = (const bf16_t*)(ws + OFF_U); g.Bt = (const bf16_t*)(ws + OFF_WIN) + (size_t)40 * 256 * DM; g.M = NTOK; g.N = 41 * 256; g.K = DM; S.init(g.M, g.N, gridDim.x, blockIdx.x);
        EpiRoute E{(bf16_t*)p.out, (bf16_t*)p.out + (size_t)NTOK * DM, (bf16_t*)(ws + OFF_BB), (bf16_t*)(ws + OFF_BC), (bf16_t*)(ws + OFF_BH), (bf16_t*)(ws + OFF_ZS), (bf16_t*)(ws + OFF_XBC), (float*)(ws + OFF_DT), p.dt_bias, 40};
        pg8::gemm_phase(lds, g, S, E); }
    else if constexpr (PH == 2) { phase_ssmconv(p); }
    else if constexpr (PH == 3) { phase_ssd_chunk(p, lds); }
    else if constexpr (PH == 4) {
        g.A = (const bf16_t*)(ws + OFF_U); g.Bt = (const bf16_t*)(ws + OFF_WIN); g.M = NTOK; g.N = 40 * 256; g.K = DM; S.init(g.M, g.N, gridDim.x, blockIdx.x);
        EpiRoute E{(bf16_t*)p.out, (bf16_t*)p.out + (size_t)NTOK * DM, (bf16_t*)(ws + OFF_BB), (bf16_t*)(ws + OFF_BC), (bf16_t*)(ws + OFF_BH), (bf16_t*)(ws + OFF_ZS), (bf16_t*)(ws + OFF_XBC), (float*)(ws + OFF_DT), p.dt_bias, 0};
        pg8::gemm_phase(lds, g, S, E);
        phase_gnorm(p); }
    else if constexpr (PH == 5) { phase_mixa(p); }
    else if constexpr (PH == 6) {
        g.A = (const bf16_t*)(ws + OFF_U); g.Bt = (const bf16_t*)(ws + OFF_WOA); g.M = NTOK; g.N = DM; g.K = DM; S.init(g.M, g.N, gridDim.x, blockIdx.x);
        EpiGate<false> Ea{(const bf16_t*)p.out, nullptr, (bf16_t*)(ws + OFF_BB)};
        pg8::gemm_phase(lds, g, S, Ea);
        g.A = (const bf16_t*)(ws + OFF_ZS); g.Bt = (const bf16_t*)(ws + OFF_WOS); g.K = DI;
        EpiGate<true> Eb{(const bf16_t*)p.out + (size_t)NTOK * DM, (const bf16_t*)(ws + OFF_BB), (bf16_t*)(ws + OFF_BC)};
        pg8::gemm_phase(lds, g, S, Eb); }
    else if constexpr (PH == 7) {
        g.A = (const bf16_t*)(ws + OFF_BC); g.Bt = (const bf16_t*)(ws + OFF_WO); g.M = NTOK; g.N = DM; g.K = DM; S.init(g.M, g.N, gridDim.x, blockIdx.x);
        EpiRes<false> E{p.x, (bf16_t*)(ws + OFF_BH), (float*)(ws + OFF_SSQ1)};
        pg8::gemm_phase(lds, g, S, E); }
    else if constexpr (PH == 8) {
        g.A = (const bf16_t*)(ws + OFF_BH); g.Bt = (const bf16_t*)(ws + OFF_WGU); g.M = NTOK; g.N = 2 * DFF; g.K = DM; S.init(g.M, g.N, gridDim.x, blockIdx.x);
        EpiSwiglu E{(const float*)(ws + OFF_SSQ1), (bf16_t*)(ws + OFF_ZS)};
        pg8::gemm_phase(lds, g, S, E); }
    else if constexpr (PH == 9) {
        g.A = (const bf16_t*)(ws + OFF_ZS); g.Bt = (const bf16_t*)(ws + OFF_WDN); g.M = NTOK; g.N = DM; g.K = DFF; S.init(g.M, g.N, gridDim.x, blockIdx.x);
        EpiRes<true> E{(const void*)(ws + OFF_BH), (bf16_t*)(ws + OFF_BB), (float*)(ws + OFF_SSQ2)};
        pg8::gemm_phase(lds, g, S, E); }
    else if constexpr (PH == 10) { phase_final(p); }
}

template <int PH> __global__ void __launch_bounds__(512, 2) k_one(Params p) {
    extern __shared__ __attribute__((aligned(16))) unsigned char lds_raw[];
    run_phase<PH>(p, (LAS unsigned char*)lds_raw);
}

#ifndef PROBE_MASK
#define PROBE_MASK 0
#endif
__global__ void __launch_bounds__(512, 2) k_mega(Params p) {
    extern __shared__ __attribute__((aligned(16))) unsigned char lds_raw[];
    LAS unsigned char* lds = (LAS unsigned char*)lds_raw;
    cg::grid_group grid = cg::this_grid();
    unsigned long long spin = 0, t0 = 0;
    volatile LAS unsigned* bst = (volatile LAS unsigned*)(lds + SS_END);
    if (threadIdx.x < 4) bst[threadIdx.x] = 0u;
    __syncthreads();
    const XcdBarrier xbar = xcd_barrier_post((unsigned*)(p.ws + OFF_BAR), bst);
#define PH_RUN(i, SYNC) do { if (PROBE_MASK) t0 = __builtin_amdgcn_s_memrealtime(); if (PROBE_KMASK && threadIdx.x == 0) *(LAS unsigned long long*)(lds + SS_END + 8) = 0ull; run_phase<i>(p, lds); if ((PROBE_KMASK & (1 << i)) && threadIdx.x == 0) spin += *(LAS unsigned long long*)(lds + SS_END + 8); if (SYNC == 1) grid.sync(); else if (SYNC == 2) xcd_barrier(xbar); \
        if (PROBE_MASK & (1 << i)) spin += __builtin_amdgcn_s_memrealtime() - t0; } while (0)
    PH_RUN(0, 1); PH_RUN(1, 2); PH_RUN(2, 2); PH_RUN(3, 2); PH_RUN(4, 2); PH_RUN(5, 2); PH_RUN(6, 2); PH_RUN(7, 2); PH_RUN(8, 2); PH_RUN(9, 2); PH_RUN(10, 0);
#ifdef PROBE_SYNCS
    for (int i = 0; i < PROBE_SYNCS; ++i) xcd_barrier(xbar);
#endif
    if ((PROBE_MASK || PROBE_KMASK) && blockIdx.x == 0) { t0 = __builtin_amdgcn_s_memrealtime(); while (__builtin_amdgcn_s_memrealtime() - t0 < spin) __builtin_amdgcn_s_sleep(8); }
}

constexpr int LDS_BYTES = SS_END + 16;

template <int PH> static void launch_one(const Params& p, int grid, hipStream_t stream) {
    static bool attr = false;
    if (!attr) { (void)hipFuncSetAttribute((const void*)k_one<PH>, hipFuncAttributeMaxDynamicSharedMemorySize, LDS_BYTES); attr = true; }
    hipLaunchKernelGGL(k_one<PH>, dim3(grid), dim3(512), LDS_BYTES, stream, p);
}

extern "C" void kernel_launch(void* const* d_in, const int* in_sizes, int n_in, void* d_out, int out_size, void* d_ws, size_t ws_size, hipStream_t stream) {
    static int grid = 0;
    if (grid == 0) {
        if (n_in != 18 || out_size != NTOK * DM || ws_size < WS_END) { fprintf(stderr, "kernel_launch: unexpected shapes: n_in %d out %d ws %zu (need %zu)\n", n_in, out_size, ws_size, (size_t)WS_END); grid = -1; return; }
        int dev = 0, cus = 0, per_cu = 0;
        (void)hipGetDevice(&dev); (void)hipDeviceGetAttribute(&cus, hipDeviceAttributeMultiprocessorCount, dev);
        (void)hipFuncSetAttribute((const void*)k_mega, hipFuncAttributeMaxDynamicSharedMemorySize, LDS_BYTES);
        (void)hipOccupancyMaxActiveBlocksPerMultiprocessor(&per_cu, (const void*)k_mega, 512, LDS_BYTES);
        if (per_cu < 1) { fprintf(stderr, "kernel_launch: occupancy query says %d blocks per CU\n", per_cu); per_cu = 1; }
        (void)hipGetLastError();
        grid = cus * per_cu;
        fprintf(stderr, "kernel_launch: cus %d per_cu %d grid %d ws %zu\n", cus, per_cu, grid, ws_size);
    }
    if (grid < 0) return;
    Params p{};
    const float** pp = (const float**)&p;
    for (int i = 0; i < 18; ++i) pp[i] = (const float*)d_in[i];
    p.out = (float*)d_out; p.ws = (unsigned char*)d_ws;
#if MEGA
    (void)hipMemsetAsync((unsigned char*)d_ws + OFF_BAR, 0, XCD_BAR_WORDS * 4, stream);
    void* args[] = {&p};
    hipError_t e = hipLaunchCooperativeKernel((const void*)k_mega, dim3(grid), dim3(512), args, LDS_BYTES, stream);
    if (e != hipSuccess) fprintf(stderr, "cooperative launch failed: %s (grid %d)\n", hipGetErrorString(e), grid);
#else
    launch_one<0>(p, grid, stream); launch_one<1>(p, grid, stream); launch_one<2>(p, grid, stream); launch_one<3>(p, grid, stream); launch_one<4>(p, grid, stream); launch_one<5>(p, grid, stream);
    launch_one<6>(p, grid, stream); launch_one<7>(p, grid, stream); launch_one<8>(p, grid, stream); launch_one<9>(p, grid, stream); launch_one<10>(p, grid, stream);
#endif
}
```
